# Optimizing an MI355X kernel written in HIP

```python
import jax, jax.numpy as jnp
from jax import lax
import numpy as np

D_MODEL = 2048
BATCH = 4
SEQ = 2048
DEPTH = 1
DEC_BATCH = 128
DEC_SEQ = 1
PAST_LEN = 16384
PAGE_SIZE = 128

POOL_WIDTH = D_MODEL // 2
POOL_WINDOWS = (2, 4, 8, 16)
N_POOL_GROUPS = len(POOL_WINDOWS)
POOL_GROUP = POOL_WIDTH // N_POOL_GROUPS
POOL_HIST = max(POOL_WINDOWS) - 1
CONV_WIDTH = D_MODEL // 2
CONV_K = 3
CONV_HIST = CONV_K - 1
D_FF = 4 * D_MODEL
IN_WIDTH = POOL_WIDTH + 3 * CONV_WIDTH + 2 * D_MODEL
N_ADA = 6
ALPHA = (2 * DEPTH) ** 0.25
BETA = (8 * DEPTH) ** -0.25
LN_EPS = 1e-5

kernel_name = "gated_pool_shortconv_deepnorm_adaln_step"


def _layernorm(x, g, b):
    xf = x.astype(jnp.float32)
    mu = jnp.mean(xf, axis=-1, keepdims=True)
    var = jnp.mean(jnp.square(xf - mu), axis=-1, keepdims=True)
    y = (xf - mu) * lax.rsqrt(var + LN_EPS)
    return (y * g.astype(jnp.float32) + b.astype(jnp.float32)).astype(x.dtype)


def _pool_mixer(z, hist, pos, grp_w, scale):
    L = z.shape[1]
    zz = jnp.concatenate([hist.astype(z.dtype), z], axis=1)
    zf = zz.astype(jnp.float32)
    cs = jnp.concatenate([jnp.zeros_like(zf[:, :1]), jnp.cumsum(zf, axis=1)], axis=1)
    upper = cs[:, POOL_HIST + 1:]
    means = []
    for g, w in enumerate(POOL_WINDOWS):
        sl = slice(g * POOL_GROUP, (g + 1) * POOL_GROUP)
        lower = cs[:, POOL_HIST + 1 - w: POOL_HIST + 1 - w + L, sl]
        cnt = jnp.minimum(w, pos + 1).astype(jnp.float32)
        means.append((upper[..., sl] - lower) / cnt[None, :, None])
    pooled = (jnp.concatenate(means, axis=-1) - z.astype(jnp.float32)).astype(z.dtype)
    B = z.shape[0]
    pg = pooled.reshape(B, L, N_POOL_GROUPS, POOL_GROUP)
    out = jnp.einsum('blgi,gio->blgo', pg, grp_w).reshape(B, L, POOL_WIDTH) * scale
    return out, zz[:, -POOL_HIST:]


def _short_conv(v, hist, conv_w):
    L = v.shape[1]
    vv = jnp.concatenate([hist.astype(v.dtype), v], axis=1)
    out = conv_w[0] * vv[:, 0:L]
    for k in range(1, CONV_K):
        out = out + conv_w[k] * vv[:, k:k + L]
    return out, vv[:, -CONV_HIST:]


def _layer(x, c, pool_hist, conv_hist, pos, w_ada, b_ada, w_in, pool_grp_w, pool_scale, conv_w,
           w_pool_up, w_conv_up, w_o, ln1_g, ln1_b, w_ff1, b_ff1, w_ff2, b_ff2, ln2_g, ln2_b):
    ada = (c @ w_ada + b_ada)[:, None, :]
    sh1, sc1, g1, sh2, sc2, g2 = jnp.split(ada, N_ADA, axis=-1)
    u = x * (1 + sc1) + sh1
    proj = u @ w_in
    o1 = POOL_WIDTH
    o2 = o1 + CONV_WIDTH
    o3 = o2 + CONV_WIDTH
    o4 = o3 + CONV_WIDTH
    o5 = o4 + D_MODEL
    z_p, x_c, b_c, c_c, gate_p, gate_c = jnp.split(proj, [o1, o2, o3, o4, o5], axis=-1)
    y_p, new_pool = _pool_mixer(z_p, pool_hist, pos, pool_grp_w, pool_scale)
    y_p = y_p @ w_pool_up
    y_c, new_conv = _short_conv(c_c * x_c, conv_hist, conv_w)
    y_c = (b_c * y_c) @ w_conv_up
    mixed = (jax.nn.sigmoid(gate_p) * y_p + jax.nn.sigmoid(gate_c) * y_c) @ w_o
    x = _layernorm(ALPHA * x + g1 * mixed, ln1_g, ln1_b)
    u2 = x * (1 + sc2) + sh2
    h = jnp.square(jax.nn.relu(u2 @ w_ff1 + b_ff1))
    x = _layernorm(ALPHA * x + g2 * (h @ w_ff2 + b_ff2), ln2_g, ln2_b)
    return x, new_pool, new_conv


def setup_inputs(seed: int = 0) -> dict:
    key = jax.random.key(seed)
    ks = jax.random.split(key, 32)
    f32 = jnp.float32

    def nrm(k, shape, s):
        return jax.random.normal(k, shape, f32) * s

    d = {}
    d["x_prompt"] = nrm(ks[0], (BATCH, SEQ, D_MODEL), 1.0)
    d["x_sample"] = nrm(ks[1], (DEC_BATCH, DEC_SEQ, D_MODEL), 1.0)
    d["state_pool"] = nrm(ks[2], (DEPTH, DEC_BATCH, POOL_HIST, POOL_WIDTH), 1.0)
    d["state_conv"] = nrm(ks[3], (DEPTH, DEC_BATCH, CONV_HIST, CONV_WIDTH), 1.0)
    d["c_prompt"] = nrm(ks[4], (BATCH, D_MODEL), 1.0)
    d["c_sample"] = nrm(ks[5], (DEC_BATCH, D_MODEL), 1.0)
    d["w_ada"] = nrm(ks[6], (DEPTH, D_MODEL, N_ADA * D_MODEL), 0.3 * D_MODEL ** -0.5)
    d["b_ada"] = nrm(ks[7], (DEPTH, N_ADA * D_MODEL), 0.02)
    d["w_in"] = nrm(ks[8], (DEPTH, D_MODEL, IN_WIDTH), D_MODEL ** -0.5)
    d["pool_grp_w"] = nrm(ks[9], (DEPTH, N_POOL_GROUPS, POOL_GROUP, POOL_GROUP), POOL_GROUP ** -0.5)
    d["pool_scale"] = 1.0 + nrm(ks[10], (DEPTH, POOL_WIDTH), 0.1)
    d["conv_w"] = nrm(ks[11], (DEPTH, CONV_K, CONV_WIDTH), CONV_K ** -0.5)
    d["w_pool_up"] = nrm(ks[12], (DEPTH, POOL_WIDTH, D_MODEL), POOL_WIDTH ** -0.5)
    d["w_conv_up"] = nrm(ks[13], (DEPTH, CONV_WIDTH, D_MODEL), CONV_WIDTH ** -0.5)
    d["w_o"] = nrm(ks[14], (DEPTH, D_MODEL, D_MODEL), BETA * D_MODEL ** -0.5)
    d["ln1_g"] = 1.0 + nrm(ks[15], (DEPTH, D_MODEL), 0.05)
    d["ln1_b"] = nrm(ks[16], (DEPTH, D_MODEL), 0.02)
    d["w_ff1"] = nrm(ks[17], (DEPTH, D_MODEL, D_FF), D_MODEL ** -0.5)
    d["b_ff1"] = nrm(ks[18], (DEPTH, D_FF), 0.02)
    d["w_ff2"] = nrm(ks[19], (DEPTH, D_FF, D_MODEL), BETA * D_FF ** -0.5)
    d["b_ff2"] = nrm(ks[20], (DEPTH, D_MODEL), 0.02)
    d["ln2_g"] = 1.0 + nrm(ks[21], (DEPTH, D_MODEL), 0.05)
    d["ln2_b"] = nrm(ks[22], (DEPTH, D_MODEL), 0.02)
    return d


def reference(x_prompt, x_sample, state_pool, state_conv, c_prompt, c_sample,
              w_ada, b_ada, w_in, pool_grp_w, pool_scale, conv_w, w_pool_up, w_conv_up, w_o,
              ln1_g, ln1_b, w_ff1, b_ff1, w_ff2, b_ff2, ln2_g, ln2_b):
    pos_prompt = jnp.arange(SEQ, dtype=jnp.int32)
    pos_sample = PAST_LEN + jnp.arange(x_sample.shape[1], dtype=jnp.int32)
    nb = x_prompt.shape[0]
    zero_pool = jnp.zeros((nb, POOL_HIST, POOL_WIDTH), x_prompt.dtype)
    zero_conv = jnp.zeros((nb, CONV_HIST, CONV_WIDTH), x_prompt.dtype)
    xp, xs = x_prompt, x_sample
    pool_p, conv_p, pool_s, conv_s = [], [], [], []
    for l in range(DEPTH):
        lw = (w_ada[l], b_ada[l], w_in[l], pool_grp_w[l], pool_scale[l], conv_w[l],
              w_pool_up[l], w_conv_up[l], w_o[l], ln1_g[l], ln1_b[l],
              w_ff1[l], b_ff1[l], w_ff2[l], b_ff2[l], ln2_g[l], ln2_b[l])
        xp, npp, ncp = _layer(xp, c_prompt, zero_pool, zero_conv, pos_prompt, *lw)
        xs, nps, ncs = _layer(xs, c_sample, state_pool[l], state_conv[l], pos_sample, *lw)
        pool_p.append(npp)
        conv_p.append(ncp)
        pool_s.append(nps)
        conv_s.append(ncs)
    return (xp, xs, jnp.stack(pool_p), jnp.stack(conv_p), jnp.stack(pool_s), jnp.stack(conv_s))
```

```cpp
#include <hip/hip_runtime.h>
#include <cstdio>
#include <cstdint>

#define LAS __attribute__((address_space(3)))
typedef unsigned short bf16_t;
typedef short bf16x8 __attribute__((ext_vector_type(8)));
typedef float f32x4 __attribute__((ext_vector_type(4)));
typedef float f32x2 __attribute__((ext_vector_type(2)));
typedef unsigned u32x4 __attribute__((ext_vector_type(4)));
typedef unsigned u32x2 __attribute__((ext_vector_type(2)));

constexpr int D = 2048, NB = 4, SEQ = 2048, NS = 128;
constexpr int MP = NB * SEQ;
constexpr int MV = MP + NS;
constexpr int MPAD = 8448;
constexpr int PW = 1024, CW = 1024, DFF = 8192, INW = 8192, NADA = 6 * D, NCOND = NB + NS;
constexpr float ALPHA = 1.18920711500272f;
constexpr float LN_EPS = 1e-5f;
constexpr int NADAP = 256 * 64;
__device__ __forceinline__ int adac(int n) { return n + 16 * (n / 48); }

constexpr size_t MiB = 1u << 20;
constexpr size_t WS_CTL = 0;
constexpr size_t WS_ADA = 352 * MiB;
constexpr size_t WS_WIN = 8 * MiB, WS_WFF1 = 40 * MiB, WS_WFF2 = 72 * MiB, WS_WO = 104 * MiB, WS_WUPP = 112 * MiB, WS_WUPC = 116 * MiB;
constexpr size_t WS_U = 120 * MiB;
constexpr size_t WS_PROJ = 153 * MiB;
constexpr size_t WS_RES = 285 * MiB;
constexpr size_t WS_PART = 362 * MiB;
constexpr size_t WS_END = 378 * MiB;
constexpr size_t WS_CIN_OFF = (size_t)MPAD * 1024 * 2;

constexpr size_t O_YP = 0, O_YS = (size_t)MP * D, O_NPP = O_YS + (size_t)NS * D, O_NCP = O_NPP + (size_t)NB * 15 * PW, O_NPS = O_NCP + (size_t)NB * 2 * CW, O_NCS = O_NPS + (size_t)NS * 15 * PW;

constexpr int LDS_BYTES = 131072 + 256, MISC_OFF = 131072;

__device__ __forceinline__ unsigned f2bf(float f) { unsigned u = __builtin_bit_cast(unsigned, f); return (u + 0x7fffu + ((u >> 16) & 1u)) >> 16; }
__device__ __forceinline__ unsigned pk2(float lo, float hi) { return f2bf(lo) | (f2bf(hi) << 16); }
__device__ __forceinline__ unsigned cvt_pk_bf16(float lo, float hi) { unsigned r; asm volatile("v_cvt_pk_bf16_f32 %0, %1, %2" : "=v"(r) : "v"(lo), "v"(hi)); return r; }
__device__ __forceinline__ float bflo(unsigned w) { return __builtin_bit_cast(float, w << 16); }
__device__ __forceinline__ float bfhi(unsigned w) { return __builtin_bit_cast(float, w & 0xffff0000u); }
__device__ __forceinline__ int cond_row(int r) { int s = r - MP; s = s < 0 ? 0 : (s > NS - 1 ? NS - 1 : s); return r < MP ? (r >> 11) : NB + s; }
__device__ __forceinline__ const float* x_rowp(const float* xp, const float* xs, int r) { int s = r - MP; s = s < 0 ? 0 : (s > NS - 1 ? NS - 1 : s); return r < MP ? xp + (size_t)r * D : xs + (size_t)s * D; }

namespace pg8 {
constexpr int BM = 256, BK = 64, HALF = 128, HTB = HALF * BK * 2, NXCD = 8, WGM = 8;
__device__ __forceinline__ int lds_byte(int r, int c) { const int st = (r >> 4) * 2 + (c >> 5), rr = r & 15, cc = c & 31, ob = rr * 64 + cc * 2; return st * 1024 + (ob ^ (((ob >> 9) & 1) << 5)); }
__device__ __forceinline__ void stage_rc(int b, int& R, int& C) { const int st = b / 1024, sb = b % 1024, swz = sb ^ (((sb >> 9) & 1) << 5); R = (st >> 1) * 16 + swz / 64; C = (st & 1) * 32 + (swz % 64) / 2; }
__device__ __forceinline__ int perm32(int rho) { const int n = rho >> 4, i = rho & 15; return 8 * (i >> 2) + 4 * n + (i & 3); }

struct Unit { int pm, pn, grp; };
struct Order {
    int nM, nN, nwg, G, c, rep;
    const char* A0; const char* B0; const char* A1; const char* B1;
    __device__ __forceinline__ void init(int M, int N, int G_, int c_, int rep_, const void* a0, const void* b0, const void* a1, const void* b1) {
        nM = M / BM; nN = N / BM; nwg = nM * nN; G = G_; c = c_; rep = rep_; A0 = (const char*)a0; B0 = (const char*)b0; A1 = (const char*)a1; B1 = (const char*)b1; }
    __device__ __forceinline__ bool next(int i, Unit& u) const {
        const int ti = (rep == 2) ? (i >> 1) : i; u.grp = (rep == 2) ? (i & 1) : 0;
        const long L = (long)ti * G + c; if (L >= nwg) return false;
        int wgid = (int)L; { const int q = nwg / NXCD, r = nwg % NXCD, xcd = wgid % NXCD, off = wgid / NXCD; wgid = (xcd < r ? xcd * (q + 1) : r * (q + 1) + (xcd - r) * q) + off; }
        const int nig = WGM * nN, gid = wgid / nig, fm = gid * WGM, gsz = (nM - fm) < WGM ? (nM - fm) : WGM;
        u.pm = fm + ((wgid % nig) % gsz); u.pn = (wgid % nig) / gsz; return true;
    }
    __device__ __forceinline__ const char* baseA(const Unit& u, size_t tstep) const { return (u.grp ? A1 : A0) + (size_t)u.pm * tstep; }
    __device__ __forceinline__ const char* baseB(const Unit& u, size_t tstep) const { return (u.grp ? B1 : B0) + (size_t)u.pn * tstep; }
};

typedef f32x4 Acc[2][2][4][2];

template <int ACT> struct EpiBf16 {
    static constexpr bool PERM = true;
    bf16_t* O; int ldc; const float* bias;
    __device__ __forceinline__ bool keep(const Unit&) const { return false; }
    __device__ __forceinline__ void operator()(Acc& acc, const Unit& u, int wr, int wc, int fr, int fq) const {
        const int row0 = u.pm * BM + wr * 64 + fr, col0 = u.pn * BM + wc * 32 + 8 * fq;
        f32x4 bv[2][2];
#pragma unroll
        for (int bj = 0; bj < 2; ++bj)
#pragma unroll
            for (int n = 0; n < 2; ++n) bv[bj][n] = bias ? *(const f32x4*)(bias + col0 + bj * HALF + 4 * n) : (f32x4){0.f, 0.f, 0.f, 0.f};
#pragma unroll
        for (int ai = 0; ai < 2; ++ai)
#pragma unroll
            for (int m = 0; m < 4; ++m) { bf16_t* rowp = O + (size_t)(row0 + ai * HALF + m * 16) * ldc + col0;
#pragma unroll
                for (int bj = 0; bj < 2; ++bj) { f32x4 v0 = acc[ai][bj][m][0] + bv[bj][0], v1 = acc[ai][bj][m][1] + bv[bj][1];
                    if (ACT == 1) {
#pragma unroll
                        for (int j = 0; j < 4; ++j) { const float a = fmaxf(v0[j], 0.f), b = fmaxf(v1[j], 0.f); v0[j] = a * a; v1[j] = b * b; } }
                    u32x4 w; w.x = cvt_pk_bf16(v0[0], v0[1]); w.y = cvt_pk_bf16(v0[2], v0[3]); w.z = cvt_pk_bf16(v1[0], v1[1]); w.w = cvt_pk_bf16(v1[2], v1[3]);
                    *(u32x4*)(rowp + bj * HALF) = w; } }
    }
};
__device__ __forceinline__ void unpack8(const u32x4 w, float (&e)[8]) { e[0] = bflo(w.x); e[1] = bfhi(w.x); e[2] = bflo(w.y); e[3] = bfhi(w.y); e[4] = bflo(w.z); e[5] = bfhi(w.z); e[6] = bflo(w.w); e[7] = bfhi(w.w); }
struct EpiGate {
    static constexpr bool PERM = true;
    const bf16_t* proj; bf16_t* O;
    __device__ __forceinline__ bool keep(const Unit& u) const { return u.grp == 0; }
    __device__ __forceinline__ void operator()(Acc& acc, const Unit& u, int wr, int wc, int fr, int fq) const {
        const int row0 = u.pm * BM + wr * 64 + fr, col0 = u.pn * BM + wc * 32 + 8 * fq;
        const bool g0 = (u.grp == 0);
        u32x4 gcw[2], gpw[2];
        { const bf16_t* p = proj + (size_t)row0 * INW + col0; gcw[0] = *(const u32x4*)(p + 6144); gpw[0] = g0 ? *(const u32x4*)(p + 4096) : gcw[0]; }
#pragma unroll
        for (int it = 0; it < 16; ++it) { const int ai = it >> 3, m = (it >> 1) & 3, bj = it & 1;
            const size_t row = (size_t)(row0 + ai * HALF + m * 16); const int col = col0 + bj * HALF;
            if (it < 15) { const int ai2 = (it + 1) >> 3, m2 = ((it + 1) >> 1) & 3, bj2 = (it + 1) & 1;
                const bf16_t* p = proj + (size_t)(row0 + ai2 * HALF + m2 * 16) * INW + col0 + bj2 * HALF;
                gcw[(it + 1) & 1] = *(const u32x4*)(p + 6144); gpw[(it + 1) & 1] = g0 ? *(const u32x4*)(p + 4096) : gcw[(it + 1) & 1]; }
            float ec[8]; unpack8(gcw[it & 1], ec);
#pragma unroll
            for (int j = 0; j < 8; ++j) ec[j] = 1.f + __expf(-fmaxf(ec[j], -30.f));
            if (g0) {
                float ep[8]; unpack8(gpw[it & 1], ep);
#pragma unroll
                for (int j = 0; j < 8; ++j) ep[j] = ec[j] * __builtin_amdgcn_rcpf(1.f + __expf(-ep[j]));
#pragma unroll
                for (int j = 0; j < 4; ++j) { acc[ai][bj][m][0][j] *= ep[j]; acc[ai][bj][m][1][j] *= ep[4 + j]; }
            } else {
                f32x4 v0, v1;
#pragma unroll
                for (int j = 0; j < 4; ++j) { v0[j] = acc[ai][bj][m][0][j] * __builtin_amdgcn_rcpf(ec[j]); v1[j] = acc[ai][bj][m][1][j] * __builtin_amdgcn_rcpf(ec[4 + j]); }
                u32x4 w; w.x = cvt_pk_bf16(v0[0], v0[1]); w.y = cvt_pk_bf16(v0[2], v0[3]); w.z = cvt_pk_bf16(v1[0], v1[1]); w.w = cvt_pk_bf16(v1[2], v1[3]);
                *(u32x4*)(O + row * D + col) = w;
            } }
    }
};
struct EpiRes {
    static constexpr bool PERM = false;
    float* res; const float* base; const float* ada; int gate_off; const float* bias;
    __device__ __forceinline__ bool keep(const Unit&) const { return false; }
    __device__ __forceinline__ void operator()(Acc& acc, const Unit& u, int wr, int wc, int fr, int fq) const {
        const int row0 = u.pm * BM + wr * 64 + fr, col0 = u.pn * BM + wc * 32 + 4 * fq;
        const float* gp = ada + (size_t)(u.pm >> 3) * NADAP;
        f32x4 bv[2][2], gv[2][2], xb[2][2][2];
#pragma unroll
        for (int bj = 0; bj < 2; ++bj)
#pragma unroll
            for (int n = 0; n < 2; ++n) { bv[bj][n] = bias ? *(const f32x4*)(bias + col0 + bj * HALF + n * 16) : (f32x4){0.f, 0.f, 0.f, 0.f}; gv[bj][n] = *(const f32x4*)(gp + adac(gate_off + col0 + bj * HALF + n * 16)); }
#pragma unroll
        for (int bj = 0; bj < 2; ++bj)
#pragma unroll
            for (int n = 0; n < 2; ++n) xb[0][bj][n] = *(const f32x4*)(base + (size_t)row0 * D + col0 + bj * HALF + n * 16);
#pragma unroll
        for (int it = 0; it < 8; ++it) { const int ai = it >> 2, m = it & 3;
            if (it < 7) { const float* bp = base + (size_t)(row0 + ((it + 1) >> 2) * HALF + ((it + 1) & 3) * 16) * D + col0;
#pragma unroll
                for (int bj = 0; bj < 2; ++bj)
#pragma unroll
                    for (int n = 0; n < 2; ++n) xb[(it + 1) & 1][bj][n] = *(const f32x4*)(bp + bj * HALF + n * 16); }
            float* rp = res + (size_t)(row0 + ai * HALF + m * 16) * D + col0;
#pragma unroll
            for (int bj = 0; bj < 2; ++bj)
#pragma unroll
                for (int n = 0; n < 2; ++n) *(f32x4*)(rp + bj * HALF + n * 16) = xb[it & 1][bj][n] * ALPHA + gv[bj][n] * (acc[ai][bj][m][n] + bv[bj][n]); }
    }
};

template <class Epi>
__device__ __forceinline__ void gemm_phase(LAS unsigned char* lds, const int K, const Order& S, const Epi& E) {
    const int tid = threadIdx.x, wid = __builtin_amdgcn_readfirstlane(tid >> 6), lane = tid & 63, wr = wid >> 2, wc = wid & 3, fr = lane & 15, fq = lane >> 4;
    const int nt = K / BK;
    unsigned voffA[2], voffB[2];
#pragma unroll
    for (int i = 0; i < 2; ++i) { int R, C; stage_rc(tid * 16 + i * 8192, R, C); const int Rb = Epi::PERM ? ((R & ~31) + perm32(R & 31)) : R;
        voffA[i] = (unsigned)(R * K + C) * 2u; voffB[i] = (unsigned)(Rb * K + C) * 2u; }
    const size_t kstep = (size_t)(BK * 2);
    const size_t hstep = (size_t)HALF * K * 2;
    const size_t tstep = 2 * hstep;
    const unsigned ldsw = (unsigned)wid * 1024u;
    const int aoff = lds_byte(wr * 64 + fr, fq * 8), boff = lds_byte(wc * 32 + fr, fq * 8);
#define PG8_SA(b, h) (((b) * 2 + (h)) * HTB)
#define PG8_SB(b, h) ((4 + (b) * 2 + (h)) * HTB)
#define PG8_STAGE(bufoff, gbase, voff) do { _Pragma("unroll") for (int _i = 0; _i < 2; ++_i) \
        __builtin_amdgcn_global_load_lds((const unsigned*)((const char*)(gbase) + (voff)[_i]), (LAS unsigned*)(lds + (bufoff) + ldsw + _i * 8192), 16, 0, 0); } while (0)
#define PG8_LDA(dst, b, h) do { _Pragma("unroll") for (int m = 0; m < 4; ++m) _Pragma("unroll") for (int k = 0; k < 2; ++k) dst[m][k] = *(const LAS bf16x8*)(lds + PG8_SA(b, h) + aoff + m * 2048 + k * 1024); } while (0)
#define PG8_LDB(dst, b, h) do { _Pragma("unroll") for (int n = 0; n < 2; ++n) _Pragma("unroll") for (int k = 0; k < 2; ++k) dst[n][k] = *(const LAS bf16x8*)(lds + PG8_SB(b, h) + boff + n * 2048 + k * 1024); } while (0)
#define PG8_MMA(ai, bj, At, Bt) do { __builtin_amdgcn_s_setprio(1); _Pragma("unroll") for (int m = 0; m < 4; ++m) _Pragma("unroll") for (int n = 0; n < 2; ++n) _Pragma("unroll") for (int k = 0; k < 2; ++k) \
        acc[ai][bj][m][n] = __builtin_amdgcn_mfma_f32_16x16x32_bf16(Bt[n][k], At[m][k], acc[ai][bj][m][n], 0, 0, 0); __builtin_amdgcn_s_setprio(0); } while (0)
#define PG8_WAIT_V(n) asm volatile("s_waitcnt vmcnt(" #n ")" ::: "memory")
#define PG8_WAIT_L(n) asm volatile("s_waitcnt lgkmcnt(" #n ")" ::: "memory")
#define PG8_BAR __builtin_amdgcn_s_barrier()
#define PG8_SCHED __builtin_amdgcn_sched_barrier(0)
    Unit cur, nxt; int ui = 0;
    if (!S.next(0, cur)) return;
    Acc acc;
#pragma unroll
    for (int a = 0; a < 2; ++a)
#pragma unroll
        for (int b = 0; b < 2; ++b)
#pragma unroll
            for (int m = 0; m < 4; ++m)
#pragma unroll
                for (int n = 0; n < 2; ++n) acc[a][b][m][n] = (f32x4){0.f, 0.f, 0.f, 0.f};
    bf16x8 At[4][2], B0[2][2], B1[2][2];
    const char* cA = S.baseA(cur, tstep); const char* cB = S.baseB(cur, tstep);
    PG8_STAGE(PG8_SB(0, 0), cB, voffB); PG8_STAGE(PG8_SB(0, 1), cB + hstep, voffB); PG8_STAGE(PG8_SA(0, 0), cA, voffA); PG8_STAGE(PG8_SA(0, 1), cA + hstep, voffA);
    if (wr == 1) PG8_BAR;
    PG8_WAIT_V(2); PG8_BAR;
    PG8_STAGE(PG8_SB(1, 0), cB + kstep, voffB); PG8_STAGE(PG8_SA(1, 0), cA + kstep, voffA); PG8_STAGE(PG8_SB(1, 1), cB + hstep + kstep, voffB);
    PG8_WAIT_V(6); PG8_BAR;
    for (;;) {
        const bool has_next = S.next(ui + 1, nxt);
        const char* nA = has_next ? S.baseA(nxt, tstep) : cA; const char* nB = has_next ? S.baseB(nxt, tstep) : cB;
        for (int t = 0; t < nt; t += 2) {
            const bool last = (t == nt - 2);
            const char* a1 = cA + (size_t)(t + 1) * kstep;
            const char* a2 = last ? nA : cA + (size_t)(t + 2) * kstep; const char* b2 = last ? nB : cB + (size_t)(t + 2) * kstep;
            const char* a3 = a2 + kstep; const char* b3 = b2 + kstep;
            PG8_LDB(B0, 0, 0); PG8_LDB(B1, 0, 1); PG8_SCHED; PG8_LDA(At, 0, 0); PG8_STAGE(PG8_SA(1, 1), a1 + hstep, voffA);
            PG8_WAIT_V(8); PG8_WAIT_L(0); PG8_BAR; PG8_MMA(0, 0, At, B0); PG8_MMA(0, 1, At, B1); PG8_BAR; PG8_SCHED;
            PG8_LDA(At, 0, 1); PG8_STAGE(PG8_SB(0, 0), b2, voffB); PG8_STAGE(PG8_SB(0, 1), b2 + hstep, voffB); PG8_STAGE(PG8_SA(0, 0), a2, voffA);
            PG8_WAIT_V(8); PG8_WAIT_L(0); PG8_BAR; PG8_MMA(1, 0, At, B0); PG8_MMA(1, 1, At, B1); PG8_BAR; PG8_SCHED;
            PG8_LDB(B0, 1, 0); PG8_LDB(B1, 1, 1); PG8_SCHED; PG8_LDA(At, 1, 0); PG8_STAGE(PG8_SA(0, 1), a2 + hstep, voffA);
            PG8_WAIT_V(8); PG8_WAIT_L(0); PG8_BAR; PG8_MMA(0, 0, At, B0); PG8_MMA(0, 1, At, B1); PG8_BAR; PG8_SCHED;
            PG8_LDA(At, 1, 1); PG8_STAGE(PG8_SB(1, 0), b3, voffB); PG8_STAGE(PG8_SB(1, 1), b3 + hstep, voffB); PG8_STAGE(PG8_SA(1, 0), a3, voffA);
            PG8_WAIT_V(8); PG8_WAIT_L(0); PG8_BAR; PG8_MMA(1, 0, At, B0); PG8_MMA(1, 1, At, B1); PG8_BAR; PG8_SCHED;
        }
        if (wr == 0) PG8_BAR;
        E(acc, cur, wr, wc, fr, fq);
        if (!has_next) break;
        if (!E.keep(cur)) {
#pragma unroll
            for (int a = 0; a < 2; ++a)
#pragma unroll
                for (int b = 0; b < 2; ++b)
#pragma unroll
                    for (int m = 0; m < 4; ++m)
#pragma unroll
                        for (int n = 0; n < 2; ++n) acc[a][b][m][n] = (f32x4){0.f, 0.f, 0.f, 0.f};
        }
        cur = nxt; cA = nA; cB = nB; ++ui;
        if (wr == 1) PG8_BAR;
    }
    PG8_WAIT_V(0);
    PG8_BAR;
#undef PG8_SA
#undef PG8_SB
#undef PG8_STAGE
#undef PG8_LDA
#undef PG8_LDB
#undef PG8_MMA
#undef PG8_WAIT_V
#undef PG8_WAIT_L
#undef PG8_BAR
#undef PG8_SCHED
}
}

struct Args {
    const float *x_prompt, *x_sample, *state_pool, *state_conv, *c_prompt, *c_sample, *w_ada, *b_ada, *w_in, *pool_grp_w, *pool_scale, *conv_w, *w_pool_up, *w_conv_up, *w_o,
        *ln1_g, *ln1_b, *w_ff1, *b_ff1, *w_ff2, *b_ff2, *ln2_g, *ln2_b;
    float* out; unsigned char* ws;
};

__device__ __forceinline__ float wave_sum(float v) {
#pragma unroll
    for (int o = 1; o < 64; o <<= 1) v += __shfl_xor(v, o);
    return v;
}

__device__ __forceinline__ void p0_transpose_item(const float* W, int K, int N, bf16_t* WT, LAS float* scr, int item, int lane) {
    const int nblk = N / 32, kb = item / nblk, nb = item % nblk, k0 = 64 * kb, n0 = 32 * nb;
    f32x4 v[8];
#pragma unroll
    for (int i = 0; i < 8; ++i) v[i] = __builtin_nontemporal_load((const f32x4*)(W + (size_t)(k0 + 8 * i + (lane >> 3)) * N + n0 + 4 * (lane & 7)));
#pragma unroll
    for (int i = 0; i < 8; ++i) { LAS float* d = scr + (8 * i + (lane >> 3)) * 33 + 4 * (lane & 7); d[0] = v[i][0]; d[1] = v[i][1]; d[2] = v[i][2]; d[3] = v[i][3]; }
    asm volatile("s_waitcnt lgkmcnt(0)" ::: "memory");
    const int c = lane & 7;
#pragma unroll
    for (int j = 0; j < 4; ++j) { const int n = (lane >> 3) + 8 * j; const LAS float* s = scr + (8 * c) * 33 + n;
        u32x4 o; o.x = pk2(s[0 * 33], s[1 * 33]); o.y = pk2(s[2 * 33], s[3 * 33]); o.z = pk2(s[4 * 33], s[5 * 33]); o.w = pk2(s[6 * 33], s[7 * 33]);
        *(u32x4*)(WT + (size_t)(n0 + n) * K + k0 + 8 * c) = o; }
    asm volatile("s_waitcnt lgkmcnt(0)" ::: "memory");
}

__device__ __forceinline__ void p0_ada_item(const Args& a, float* ada, LAS unsigned char* lds, int item, int wave, int lane) {
    const int n0 = item * 48, fr = lane & 15, kq = lane >> 4;
    f32x4 acc[9][3];
#pragma unroll
    for (int mt = 0; mt < 9; ++mt)
#pragma unroll
        for (int q = 0; q < 3; ++q) acc[mt][q] = (f32x4){0.f, 0.f, 0.f, 0.f};
    const float* const cr0 = fr < NB ? a.c_prompt + (size_t)fr * D : a.c_sample + (size_t)(fr - NB) * D;
    const float* const crm = a.c_sample + (size_t)(fr + 12) * D;
    const float* const cr8 = a.c_sample + (size_t)(124 + fr > NS - 1 ? NS - 1 : 124 + fr) * D;
#pragma unroll 2
    for (int ks = 0; ks < 8; ++ks) {
        const int k0 = wave * 256 + ks * 32 + kq * 8;
        float b[8][3];
#pragma unroll
        for (int j = 0; j < 8; ++j) { const float* p = a.w_ada + (size_t)(k0 + j) * NADA + n0 + 3 * fr; b[j][0] = __builtin_nontemporal_load(p); b[j][1] = __builtin_nontemporal_load(p + 1); b[j][2] = __builtin_nontemporal_load(p + 2); }
        bf16x8 bfr[3];
#pragma unroll
        for (int q = 0; q < 3; ++q) { u32x4 w; w.x = pk2(b[0][q], b[1][q]); w.y = pk2(b[2][q], b[3][q]); w.z = pk2(b[4][q], b[5][q]); w.w = pk2(b[6][q], b[7][q]); bfr[q] = __builtin_bit_cast(bf16x8, w); }
#pragma unroll
        for (int mt = 0; mt < 9; ++mt) {
            const float* cp = (mt == 0) ? cr0 : (mt == 8 ? cr8 : crm + (size_t)(mt - 1) * 16 * D);
            const f32x4 a0 = *(const f32x4*)(cp + k0), a1 = *(const f32x4*)(cp + k0 + 4);
            u32x4 w; w.x = pk2(a0[0], a0[1]); w.y = pk2(a0[2], a0[3]); w.z = pk2(a1[0], a1[1]); w.w = pk2(a1[2], a1[3]);
            const bf16x8 af = __builtin_bit_cast(bf16x8, w);
#pragma unroll
            for (int q = 0; q < 3; ++q) acc[mt][q] = __builtin_amdgcn_mfma_f32_16x16x32_bf16(af, bfr[q], acc[mt][q], 0, 0, 0);
            if (mt % 3 == 2) asm volatile("" ::: "memory");
        }
    }
    LAS float* red = (LAS float*)lds;
#pragma unroll
    for (int s = 4; s >= 1; s >>= 1) {
        if (wave >= s && wave < 2 * s) { LAS float* dst = red + (wave - s) * 6912 + lane;
#pragma unroll
            for (int mt = 0; mt < 9; ++mt)
#pragma unroll
                for (int q = 0; q < 3; ++q)
#pragma unroll
                    for (int j = 0; j < 4; ++j) dst[((mt * 3 + q) * 4 + j) * 64] = acc[mt][q][j]; }
        __syncthreads();
        if (wave < s) { const LAS float* src = red + wave * 6912 + lane;
#pragma unroll
            for (int mt = 0; mt < 9; ++mt)
#pragma unroll
                for (int q = 0; q < 3; ++q)
#pragma unroll
                    for (int j = 0; j < 4; ++j) acc[mt][q][j] += src[((mt * 3 + q) * 4 + j) * 64]; }
        __syncthreads();
    }
    if (wave == 0) {
#pragma unroll
        for (int q = 0; q < 3; ++q) { const int n = n0 + 3 * fr + q; const float bb = a.b_ada[n];
#pragma unroll
            for (int mt = 0; mt < 9; ++mt)
#pragma unroll
                for (int j = 0; j < 4; ++j) { const int r = mt * 16 + kq * 4 + j; if (r < NCOND) ada[(size_t)r * NADAP + item * 64 + 3 * fr + q] = acc[mt][q][j] + bb; } }
    }
}

__device__ __forceinline__ void p0_weff_item(const Args& a, bf16_t* WT, LAS unsigned char* lds, int item, int tid) {
    constexpr int AP = 260, BP = 80;
    const int g = item >> 7, it = (item >> 5) & 3, nt = item & 31, i0 = it * 64, n0 = nt * 64;
    LAS float* As = (LAS float*)lds;
    LAS float* Bs = (LAS float*)(lds + 66560);
#pragma unroll
    for (int r = 0; r < 8; ++r) { const int idx = tid + r * 512, row = idx >> 6, c4 = idx & 63;
        *(LAS f32x4*)(As + row * AP + c4 * 4) = *(const f32x4*)(a.pool_grp_w + ((size_t)(g * 256 + i0 + row)) * 256 + c4 * 4); }
    const int lane = tid & 63, wave = tid >> 6, fr = lane & 15, kq = lane >> 4, mt = wave >> 1, np = (wave & 1) * 2;
    f32x4 acc[2] = {(f32x4){0.f, 0.f, 0.f, 0.f}, (f32x4){0.f, 0.f, 0.f, 0.f}};
#pragma unroll 1
    for (int h = 0; h < 2; ++h) {
        __syncthreads();
#pragma unroll
        for (int r = 0; r < 4; ++r) { const int idx = tid + r * 512, o = idx >> 4, c4 = idx & 15;
            const float sc = a.pool_scale[g * 256 + h * 128 + o];
            *(LAS f32x4*)(Bs + o * BP + c4 * 4) = *(const f32x4*)(a.w_pool_up + (size_t)(g * 256 + h * 128 + o) * D + n0 + c4 * 4) * sc; }
        __syncthreads();
#pragma unroll 8
        for (int o4 = 0; o4 < 32; ++o4) {
            const float av = As[(mt * 16 + fr) * AP + h * 128 + o4 * 4 + kq];
            const float b0 = Bs[(o4 * 4 + kq) * BP + np * 16 + fr], b1 = Bs[(o4 * 4 + kq) * BP + np * 16 + 16 + fr];
            acc[0] = __builtin_amdgcn_mfma_f32_16x16x4f32(av, b0, acc[0], 0, 0, 0);
            acc[1] = __builtin_amdgcn_mfma_f32_16x16x4f32(av, b1, acc[1], 0, 0, 0);
        }
    }
#pragma unroll
    for (int t = 0; t < 2; ++t)
        *(u32x2*)(WT + (size_t)(n0 + (np + t) * 16 + fr) * PW + g * 256 + i0 + mt * 16 + kq * 4) = (u32x2){pk2(acc[t][0], acc[t][1]), pk2(acc[t][2], acc[t][3])};
    __syncthreads();
}

__device__ __forceinline__ void p1_modulate(const Args& a, const float* ada, bf16_t* U, int gw, int NGW, int lane) {
    for (int r = gw; r < MV; r += NGW) {
        u32x2* o8 = (u32x2*)(U + (size_t)r * D) + lane;
        const f32x4* xr = (const f32x4*)x_rowp(a.x_prompt, a.x_sample, r) + lane;
        const float* ar = ada + (size_t)cond_row(r) * NADAP;
#pragma unroll
        for (int j = 0; j < 8; ++j) { const int c = 4 * (lane + 64 * j); const f32x4 v = __builtin_nontemporal_load(xr + 64 * j) * (*(const f32x4*)(ar + adac(D + c)) + 1.f) + *(const f32x4*)(ar + adac(c));
            o8[64 * j] = (u32x2){pk2(v[0], v[1]), pk2(v[2], v[3])}; }
    }
}

__device__ __forceinline__ void p3_mixer(const Args& a, const bf16_t* proj, bf16_t* PRE, bf16_t* CIN, int tid) {
    const int j0 = 2 * tid, wave = tid >> 6, W = 2 << (wave >> 1);
    const f32x2 cw0 = *(const f32x2*)(a.conv_w + j0), cw1 = *(const f32x2*)(a.conv_w + CW + j0), cw2 = *(const f32x2*)(a.conv_w + 2 * CW + j0);
    float* const npp = a.out + O_NPP; float* const ncp = a.out + O_NCP; float* const nps = a.out + O_NPS; float* const ncs = a.out + O_NCS;
    for (int it = blockIdx.x; it < 384; it += gridDim.x) {
        if (it < 256) {
            const int b = it >> 6, s0 = (it & 63) * 32;
            const bf16_t* pb = proj + (size_t)(b * SEQ) * INW + j0;
            float S0 = 0.f, S1 = 0.f;
            for (int i = 1; i < W; ++i) { const int s = s0 - i; if (s >= 0) { const unsigned w = *(const unsigned*)(pb + (size_t)s * INW); S0 += bflo(w); S1 += bfhi(w); } }
            float v1a = 0.f, v1b = 0.f, v2a = 0.f, v2b = 0.f;
            if (s0 >= 1) { const bf16_t* p = pb + (size_t)(s0 - 1) * INW; const unsigned wx = *(const unsigned*)(p + 1024), wc = *(const unsigned*)(p + 3072); v1a = bflo(wc) * bflo(wx); v1b = bfhi(wc) * bfhi(wx); }
            if (s0 >= 2) { const bf16_t* p = pb + (size_t)(s0 - 2) * INW; const unsigned wx = *(const unsigned*)(p + 1024), wc = *(const unsigned*)(p + 3072); v2a = bflo(wc) * bflo(wx); v2b = bfhi(wc) * bfhi(wx); }
#pragma unroll 4
            for (int s = s0; s < s0 + 32; ++s) {
                const bf16_t* p = pb + (size_t)s * INW;
                const unsigned wz = *(const unsigned*)p, wx = *(const unsigned*)(p + 1024), wb = *(const unsigned*)(p + 2048), wc = *(const unsigned*)(p + 3072);
                const float z0 = bflo(wz), z1 = bfhi(wz);
                S0 += z0; S1 += z1;
                const int cnt = (s + 1 < W) ? s + 1 : W; const float fc = (float)cnt;
                const float p0 = S0 / fc - z0, p1 = S1 / fc - z1;
                const int so = s - W + 1;
                if (so >= 0) { const unsigned wo = *(const unsigned*)(pb + (size_t)so * INW); S0 -= bflo(wo); S1 -= bfhi(wo); }
                const float va = bflo(wc) * bflo(wx), vb = bfhi(wc) * bfhi(wx);
                const float ya = cw0[0] * v2a + cw1[0] * v1a + cw2[0] * va, yb = cw0[1] * v2b + cw1[1] * v1b + cw2[1] * vb;
                const size_t row = (size_t)(b * SEQ + s);
                *(unsigned*)(PRE + row * PW + j0) = pk2(p0, p1);
                *(unsigned*)(CIN + row * CW + j0) = pk2(bflo(wb) * ya, bfhi(wb) * yb);
                if (s >= SEQ - 15) *(f32x2*)(npp + ((size_t)(b * 15 + s - (SEQ - 15))) * PW + j0) = (f32x2){z0, z1};
                if (s >= SEQ - 2) *(f32x2*)(ncp + ((size_t)(b * 2 + s - (SEQ - 2))) * CW + j0) = (f32x2){va, vb};
                v2a = v1a; v2b = v1b; v1a = va; v1b = vb;
            }
        } else {
            const int b = it - 256; const size_t row = (size_t)(MP + b);
            const bf16_t* p = proj + row * INW + j0;
            const unsigned wz = *(const unsigned*)p, wx = *(const unsigned*)(p + 1024), wb = *(const unsigned*)(p + 2048), wc = *(const unsigned*)(p + 3072);
            const float z0 = bflo(wz), z1 = bfhi(wz);
            const float* sp = a.state_pool + (size_t)b * 15 * PW + j0;
            float S0 = z0, S1 = z1;
            for (int i = 1; i < W; ++i) { const f32x2 h = *(const f32x2*)(sp + (size_t)(15 - i) * PW); S0 += h[0]; S1 += h[1]; }
            const float fc = (float)W;
            *(unsigned*)(PRE + row * PW + j0) = pk2(S0 / fc - z0, S1 / fc - z1);
            const f32x2 h0 = *(const f32x2*)(a.state_conv + (size_t)(b * 2) * CW + j0), h1 = *(const f32x2*)(a.state_conv + (size_t)(b * 2 + 1) * CW + j0);
            const float va = bflo(wc) * bflo(wx), vb = bfhi(wc) * bfhi(wx);
            const float ya = cw0[0] * h0[0] + cw1[0] * h1[0] + cw2[0] * va, yb = cw0[1] * h0[1] + cw1[1] * h1[1] + cw2[1] * vb;
            *(unsigned*)(CIN + row * CW + j0) = pk2(bflo(wb) * ya, bfhi(wb) * yb);
#pragma unroll
            for (int r = 0; r < 14; ++r) *(f32x2*)(nps + ((size_t)(b * 15 + r)) * PW + j0) = *(const f32x2*)(sp + (size_t)(r + 1) * PW);
            *(f32x2*)(nps + ((size_t)(b * 15 + 14)) * PW + j0) = (f32x2){z0, z1};
            *(f32x2*)(ncs + ((size_t)(b * 2)) * CW + j0) = h1;
            *(f32x2*)(ncs + ((size_t)(b * 2 + 1)) * CW + j0) = (f32x2){va, vb};
        }
    }
}

__device__ __forceinline__ void ln_row(f32x4 (&v)[8], const float* g, const float* b, int lane) {
    float s = 0.f;
#pragma unroll
    for (int j = 0; j < 8; ++j) s += (v[j][0] + v[j][1]) + (v[j][2] + v[j][3]);
    const float mean = wave_sum(s) * (1.f / D); float s2 = 0.f;
#pragma unroll
    for (int j = 0; j < 8; ++j) { v[j] = v[j] - mean; s2 += (v[j][0] * v[j][0] + v[j][1] * v[j][1]) + (v[j][2] * v[j][2] + v[j][3] * v[j][3]); }
    const float rstd = 1.f / sqrtf(wave_sum(s2) * (1.f / D) + LN_EPS);
    const f32x4* g4 = (const f32x4*)g + lane; const f32x4* b4 = (const f32x4*)b + lane;
#pragma unroll
    for (int j = 0; j < 8; ++j) v[j] = v[j] * rstd * g4[64 * j] + b4[64 * j];
}
__device__ __forceinline__ void p6_ln1(const Args& a, const float* ada, float* res, const float* part, bf16_t* U, int gw, int NGW, int lane) {
    for (int r = gw; r < MV; r += NGW) {
        u32x2* o8 = (u32x2*)(U + (size_t)r * D) + lane;
        f32x4* rr = (f32x4*)(res + (size_t)r * D) + lane;
        const float* ar = ada + (size_t)cond_row(r) * NADAP;
        f32x4 v[8];
        if (r < MP) {
#pragma unroll
            for (int j = 0; j < 8; ++j) v[j] = rr[64 * j];
        } else {
            const f32x4* xr = (const f32x4*)(a.x_sample + (size_t)(r - MP) * D) + lane;
#pragma unroll
            for (int j = 0; j < 8; ++j) { f32x4 sum = (f32x4){0.f, 0.f, 0.f, 0.f};
#pragma unroll
                for (int sl = 0; sl < 16; ++sl) sum += ((const f32x4*)(part + ((size_t)sl * NS + (r - MP)) * D) + lane)[64 * j];
                v[j] = xr[64 * j] * ALPHA + *(const f32x4*)(ar + adac(2 * D + 4 * (lane + 64 * j))) * sum; }
        }
        ln_row(v, a.ln1_g, a.ln1_b, lane);
#pragma unroll
        for (int j = 0; j < 8; ++j) { const int c = 4 * (lane + 64 * j); rr[64 * j] = v[j]; const f32x4 t = v[j] * (*(const f32x4*)(ar + adac(4 * D + c)) + 1.f) + *(const f32x4*)(ar + adac(3 * D + c));
            o8[64 * j] = (u32x2){pk2(t[0], t[1]), pk2(t[2], t[3])}; }
    }
}
__device__ __forceinline__ void p9_ln2(const Args& a, const float* ada, const float* res, const float* part, int gw, int NGW, int lane) {
    for (int r = gw; r < MV; r += NGW) {
        const f32x4* rr = (const f32x4*)(res + (size_t)r * D) + lane;
        f32x4 v[8];
#pragma unroll
        for (int j = 0; j < 8; ++j) v[j] = rr[64 * j];
        if (r >= MP) {
            const float* ar = ada + (size_t)cond_row(r) * NADAP;
#pragma unroll
            for (int j = 0; j < 8; ++j) { f32x4 sum = *((const f32x4*)a.b_ff2 + lane + 64 * j);
#pragma unroll
                for (int sl = 0; sl < 16; ++sl) sum += ((const f32x4*)(part + ((size_t)sl * NS + (r - MP)) * D) + lane)[64 * j];
                v[j] = v[j] * ALPHA + *(const f32x4*)(ar + adac(5 * D + 4 * (lane + 64 * j))) * sum; }
        }
        ln_row(v, a.ln2_g, a.ln2_b, lane);
        f32x4* o = (f32x4*)(a.out + (r < MP ? O_YP + (size_t)r * D : O_YS + (size_t)(r - MP) * D)) + lane;
#pragma unroll
        for (int j = 0; j < 8; ++j) o[64 * j] = v[j];
    }
}

typedef f32x4 Acc128[4][2];
__device__ __forceinline__ void gemm128_core(Acc128& acc, LAS unsigned char* lds, const bf16_t* A, const bf16_t* Bt, const int K  , const int klen  ) {
    using namespace pg8;
    const int tid = threadIdx.x, wid = __builtin_amdgcn_readfirstlane(tid >> 6), lane = tid & 63, wr = wid >> 2, wc = wid & 3, fr = lane & 15, fq = lane >> 4;
    const int nt = klen / 64;
    unsigned voff[2];
#pragma unroll
    for (int i = 0; i < 2; ++i) { int R, C; stage_rc(tid * 16 + i * 8192, R, C); voff[i] = (unsigned)(R * K + C) * 2u; }
    const unsigned ldsw = (unsigned)wid * 1024u;
    const int aoff = lds_byte(wr * 64 + fr, fq * 8), boff = lds_byte(wc * 32 + fr, fq * 8);
    const char* pa = (const char*)A; const char* pb = (const char*)Bt;
#define G128_STAGE(st, kt) do { _Pragma("unroll") for (int _i = 0; _i < 2; ++_i) { \
        __builtin_amdgcn_global_load_lds((const unsigned*)(pa + (size_t)(kt) * 128 + voff[_i]), (LAS unsigned*)(lds + (st) * 32768 + ldsw + _i * 8192), 16, 0, 0); \
        __builtin_amdgcn_global_load_lds((const unsigned*)(pb + (size_t)(kt) * 128 + voff[_i]), (LAS unsigned*)(lds + (st) * 32768 + 16384 + ldsw + _i * 8192), 16, 0, 0); } } while (0)
    G128_STAGE(0, 0); G128_STAGE(1, 1 < nt ? 1 : nt - 1); G128_STAGE(2, 2 < nt ? 2 : nt - 1);
#pragma unroll 1
    for (int t = 0; t < nt; ++t) {
        asm volatile("s_waitcnt vmcnt(8)" ::: "memory");
        __builtin_amdgcn_s_barrier();
        asm volatile("" ::: "memory");
        { const int kt = t + 3 < nt ? t + 3 : nt - 1; G128_STAGE((t + 3) & 3, kt); }
        const LAS unsigned char* sa = lds + (t & 3) * 32768; const LAS unsigned char* sb = sa + 16384;
        bf16x8 af[4][2], bfr[2][2];
#pragma unroll
        for (int m = 0; m < 4; ++m)
#pragma unroll
            for (int k = 0; k < 2; ++k) af[m][k] = *(const LAS bf16x8*)(sa + aoff + m * 2048 + k * 1024);
#pragma unroll
        for (int n = 0; n < 2; ++n)
#pragma unroll
            for (int k = 0; k < 2; ++k) bfr[n][k] = *(const LAS bf16x8*)(sb + boff + n * 2048 + k * 1024);
#pragma unroll
        for (int m = 0; m < 4; ++m)
#pragma unroll
            for (int n = 0; n < 2; ++n)
#pragma unroll
                for (int k = 0; k < 2; ++k) acc[m][n] = __builtin_amdgcn_mfma_f32_16x16x32_bf16(bfr[n][k], af[m][k], acc[m][n], 0, 0, 0);
        asm volatile("s_waitcnt lgkmcnt(0)" ::: "memory");
    }
    asm volatile("s_waitcnt vmcnt(0)" ::: "memory");
    __builtin_amdgcn_s_barrier();
    asm volatile("" ::: "memory");
#undef G128_STAGE
}
__device__ __forceinline__ void zero128(Acc128& acc) {
#pragma unroll
    for (int m = 0; m < 4; ++m)
#pragma unroll
        for (int n = 0; n < 2; ++n) acc[m][n] = (f32x4){0.f, 0.f, 0.f, 0.f};
}
template <int MODE>
__device__ __forceinline__ void sample_gemm(const Args& a, LAS unsigned char* lds, const bf16_t* A0, const bf16_t* B0, const bf16_t* A1, const bf16_t* B1, const int K, const int N,
                                            const bf16_t* proj, bf16_t* Ob, float* res, const float* ada) {
    const int tid = threadIdx.x, wid = __builtin_amdgcn_readfirstlane(tid >> 6), lane = tid & 63, wr = wid >> 2, wc = wid & 3, fr = lane & 15, fq = lane >> 4;
    constexpr int NSL = (MODE >= 3) ? 16 : 1;
    for (int unit = blockIdx.x; unit < (N / 128) * NSL; unit += gridDim.x) {
        const int n0 = (unit / NSL) * 128, sl = unit % NSL, klen = K / NSL;
        Acc128 acc, acc2;
        zero128(acc);
        gemm128_core(acc, lds, A0 + (size_t)MP * K + sl * klen, B0 + (size_t)n0 * K + sl * klen, K, klen);
        if (MODE == 2) { zero128(acc2); gemm128_core(acc2, lds, A1 + (size_t)MP * K, B1 + (size_t)n0 * K, K, K); }
#pragma unroll
        for (int m = 0; m < 4; ++m) { const int ms = wr * 64 + m * 16 + fr; const size_t row = (size_t)(MP + ms);
#pragma unroll
            for (int n = 0; n < 2; ++n) { const int c = n0 + wc * 32 + n * 16 + 4 * fq; f32x4 v = acc[m][n];
                if (MODE == 0) { *(u32x2*)(Ob + row * INW + c) = (u32x2){pk2(v[0], v[1]), pk2(v[2], v[3])}; }
                else if (MODE == 1) { v = v + *(const f32x4*)(a.b_ff1 + c);
#pragma unroll
                    for (int j = 0; j < 4; ++j) { const float r = fmaxf(v[j], 0.f); v[j] = r * r; }
                    *(u32x2*)(Ob + row * DFF + c) = (u32x2){pk2(v[0], v[1]), pk2(v[2], v[3])}; }
                else if (MODE == 2) {
                    const u32x2 gpw = *(const u32x2*)(proj + row * INW + 4096 + c), gcw = *(const u32x2*)(proj + row * INW + 6144 + c);
                    const float gp[4] = {bflo(gpw.x), bfhi(gpw.x), bflo(gpw.y), bfhi(gpw.y)}, gc[4] = {bflo(gcw.x), bfhi(gcw.x), bflo(gcw.y), bfhi(gcw.y)};
                    float o[4];
#pragma unroll
                    for (int j = 0; j < 4; ++j) o[j] = v[j] / (1.f + __expf(-gp[j])) + acc2[m][n][j] / (1.f + __expf(-gc[j]));
                    *(u32x2*)(Ob + row * D + c) = (u32x2){pk2(o[0], o[1]), pk2(o[2], o[3])}; }
                else { *(f32x4*)(res + ((size_t)sl * NS + ms) * D + c) = v; }
            } }
    }
}

#define XB_TMO      128
#define XB_XCNT(j)  (256  + 64 * (j))
#define XB_XSUB(j)  (1280 + 64 * (j))
#define XB_XGEN(j)  (2304 + 64 * (j))
#define XB_TOP      3328
#define XB_TOPGEN   3392
#define XCD_BAR_WORDS 3456
#define XB_SPIN_CAP (1u << 18)
__device__ __forceinline__ unsigned xb_ld(unsigned* p)              { return __hip_atomic_load(p, __ATOMIC_RELAXED, __HIP_MEMORY_SCOPE_AGENT); }
__device__ __forceinline__ unsigned xb_add(unsigned* p, unsigned v) { return __hip_atomic_fetch_add(p, v, __ATOMIC_RELAXED, __HIP_MEMORY_SCOPE_AGENT); }
__device__ __forceinline__ unsigned xb_xcc_id() { return (unsigned)__builtin_amdgcn_s_getreg((3 << 11) | 20) & 0xFu; }
#define XB_SPIN(cond, bar) do { unsigned _sp = 0; while (cond) { __builtin_amdgcn_s_sleep(1); \
    if ((++_sp & 255u) == 0u) { if (xb_ld(&(bar)[XB_TMO])) break; if (_sp > XB_SPIN_CAP) { atomicAdd(&(bar)[XB_TMO], 1u); break; } } } } while (0)
struct XcdBarrier { unsigned* bar; unsigned x; volatile LAS unsigned* st; };
__device__ __forceinline__ XcdBarrier xcd_barrier_post(unsigned* bar, volatile LAS unsigned* st) {
    XcdBarrier b; b.bar = bar; b.x = xb_xcc_id(); b.st = st;
    if (threadIdx.x == 0) (void)xb_add(&bar[XB_XCNT(b.x)], 1u);
    return b;
}
__device__ __forceinline__ void xcd_barrier_complete(unsigned* bar, unsigned x, unsigned& nloc, unsigned& nx) {
    const unsigned G = gridDim.x * gridDim.y * gridDim.z;
    unsigned sum, cnt, mine, sp = 0u;
    for (;;) {
        sum = 0u; cnt = 0u; mine = 0u;
#pragma unroll
        for (unsigned j = 0; j < 16; ++j) { const unsigned c = xb_ld(&bar[XB_XCNT(j)]); sum += c; cnt += (c > 0u) ? 1u : 0u; mine = (j == x) ? c : mine; }
        if (sum == G) break;
        __builtin_amdgcn_s_sleep(1);
        if ((++sp & 255u) == 0u) { if (xb_ld(&bar[XB_TMO])) break; if (sp > XB_SPIN_CAP) { atomicAdd(&bar[XB_TMO], 1u); break; } }
    }
    nloc = mine > 0u ? mine : 1u; nx = cnt > 0u ? cnt : 1u;
}
__device__ __forceinline__ void xcd_barrier(const XcdBarrier& b) {
    asm volatile("s_waitcnt vmcnt(0)" ::: "memory");
    __syncthreads();
    if (threadIdx.x == 0) {
        unsigned* bar = b.bar;
        __builtin_amdgcn_s_waitcnt(0);
        unsigned nloc = b.st[0], nx = b.st[1];
        if (nloc == 0u) { xcd_barrier_complete(bar, b.x, nloc, nx); b.st[0] = nloc; b.st[1] = nx; }
        const unsigned old = xb_add(&bar[XB_XSUB(b.x)], 1u);
        const unsigned gen = old / nloc;
        if (old + 1u == (gen + 1u) * nloc) {
            __builtin_amdgcn_fence(__ATOMIC_RELEASE, "agent");
            asm volatile("s_waitcnt vmcnt(0)" ::: "memory");
            const unsigned og = xb_add(&bar[XB_TOP], 1u);
            const unsigned tg = og / nx;
            if (og + 1u == (tg + 1u) * nx) xb_add(&bar[XB_TOPGEN], 1u);
            else XB_SPIN(xb_ld(&bar[XB_TOPGEN]) == tg, bar);
            __builtin_amdgcn_fence(__ATOMIC_ACQUIRE, "agent");
            xb_add(&bar[XB_XGEN(b.x)], 1u);
            asm volatile("s_waitcnt vmcnt(0)" ::: "memory");
        } else {
            XB_SPIN(xb_ld(&bar[XB_XGEN(b.x)]) == gen, bar);
            __builtin_amdgcn_fence(__ATOMIC_ACQUIRE, "agent");
            asm volatile("s_waitcnt vmcnt(0)" ::: "memory");
        }
    }
    __syncthreads();
}

__device__ __forceinline__ void p0_all(const Args& a, LAS unsigned char* lds, int tid, int lane, int wave, int bx, int G) {
    unsigned char* ws = a.ws;
    float* ada = (float*)(ws + WS_ADA);
    bf16_t* WinT = (bf16_t*)(ws + WS_WIN); bf16_t* Wff1T = (bf16_t*)(ws + WS_WFF1); bf16_t* Wff2T = (bf16_t*)(ws + WS_WFF2); bf16_t* WoT = (bf16_t*)(ws + WS_WO);
    bf16_t* WupP = (bf16_t*)(ws + WS_WUPP); bf16_t* WupC = (bf16_t*)(ws + WS_WUPC);
    const int gw = bx * 8 + wave, NGW = G * 8;
    for (int it = bx; it < NADA / 48; it += G) p0_ada_item(a, ada, lds, it, wave, lane);
    for (int it = bx; it < 512; it += G) p0_weff_item(a, WupP, lds, it, tid);
    {
        LAS float* scr = (LAS float*)(lds + wave * 16384);
        constexpr int I_IN = (D / 64) * (INW / 32), I_F1 = (D / 64) * (DFF / 32), I_F2 = (DFF / 64) * (D / 32), I_O = (D / 64) * (D / 32), I_C = (CW / 64) * (D / 32);
        constexpr int NIT = I_IN + I_F1 + I_F2 + I_O + I_C;
        for (int it = gw; it < NIT; it += NGW) {
            int r = it;
            if (r < I_IN) { p0_transpose_item(a.w_in, D, INW, WinT, scr, r, lane); continue; } r -= I_IN;
            if (r < I_F1) { p0_transpose_item(a.w_ff1, D, DFF, Wff1T, scr, r, lane); continue; } r -= I_F1;
            if (r < I_F2) { p0_transpose_item(a.w_ff2, DFF, D, Wff2T, scr, r, lane); continue; } r -= I_F2;
            if (r < I_O) { p0_transpose_item(a.w_o, D, D, WoT, scr, r, lane); continue; } r -= I_O;
            p0_transpose_item(a.w_conv_up, CW, D, WupC, scr, r, lane);
        }
    }
}

__global__ void __launch_bounds__(512, 2) fwd_megakernel(Args a) {
    extern __shared__ __attribute__((aligned(16))) unsigned char lds_raw[];
    LAS unsigned char* lds = (LAS unsigned char*)lds_raw;
    const int tid = threadIdx.x, lane = tid & 63, wave = __builtin_amdgcn_readfirstlane(tid >> 6);
    const int G = gridDim.x, bx = blockIdx.x;
    const int gw = bx * 8 + wave, NGW = G * 8;
    unsigned char* ws = a.ws;
    float* ada = (float*)(ws + WS_ADA);
    unsigned* ctr = (unsigned*)(ws + WS_CTL);
    if (tid < 64) ((LAS unsigned*)(lds + MISC_OFF))[tid] = 0u;
    __syncthreads();
    const XcdBarrier xbar = xcd_barrier_post(ctr, (volatile LAS unsigned*)(lds + MISC_OFF));
#define GB() xcd_barrier(xbar)
    bf16_t* WinT = (bf16_t*)(ws + WS_WIN); bf16_t* Wff1T = (bf16_t*)(ws + WS_WFF1); bf16_t* Wff2T = (bf16_t*)(ws + WS_WFF2); bf16_t* WoT = (bf16_t*)(ws + WS_WO);
    bf16_t* WupP = (bf16_t*)(ws + WS_WUPP); bf16_t* WupC = (bf16_t*)(ws + WS_WUPC);
    bf16_t* U = (bf16_t*)(ws + WS_U); bf16_t* PROJ = (bf16_t*)(ws + WS_PROJ); float* RES = (float*)(ws + WS_RES);
    float* PART = (float*)(ws + WS_PART);
    bf16_t* PRE = (bf16_t*)(ws + WS_RES); bf16_t* CIN = (bf16_t*)(ws + WS_RES + WS_CIN_OFF);

    p0_all(a, lds, tid, lane, wave, bx, G);
    GB();
    p1_modulate(a, ada, U, gw, NGW, lane);
    GB();
    { pg8::Order S; S.init(MP, INW, G, bx, 1, U, WinT, U, WinT);
      pg8::EpiBf16<0> E{PROJ, INW, nullptr};
      pg8::gemm_phase(lds, D, S, E); }
    sample_gemm<0>(a, lds, U, WinT, U, WinT, D, INW, PROJ, PROJ, RES, ada);
    GB();
    p3_mixer(a, PROJ, PRE, CIN, tid);
    GB();
    { pg8::Order S; S.init(MP, D, G, bx, 2, PRE, WupP, CIN, WupC);
      pg8::EpiGate E{PROJ, U};
      pg8::gemm_phase(lds, PW, S, E); }
    sample_gemm<2>(a, lds, PRE, WupP, CIN, WupC, PW, D, PROJ, U, RES, ada);
    GB();
    { pg8::Order S; S.init(MP, D, G, bx, 1, U, WoT, U, WoT);
      pg8::EpiRes E{RES, a.x_prompt, ada, 2 * D, nullptr};
      pg8::gemm_phase(lds, D, S, E); }
    sample_gemm<3>(a, lds, U, WoT, U, WoT, D, D, PROJ, U, PART, ada);
    GB();
    p6_ln1(a, ada, RES, PART, U, gw, NGW, lane);
    GB();
    { pg8::Order S; S.init(MP, DFF, G, bx, 1, U, Wff1T, U, Wff1T);
      pg8::EpiBf16<1> E{PROJ, DFF, a.b_ff1};
      pg8::gemm_phase(lds, D, S, E); }
    sample_gemm<1>(a, lds, U, Wff1T, U, Wff1T, D, DFF, PROJ, PROJ, RES, ada);
    GB();
    { pg8::Order S; S.init(MP, D, G, bx, 1, PROJ, Wff2T, PROJ, Wff2T);
      pg8::EpiRes E{RES, RES, ada, 5 * D, a.b_ff2};
      pg8::gemm_phase(lds, DFF, S, E); }
    sample_gemm<4>(a, lds, PROJ, Wff2T, PROJ, Wff2T, DFF, D, PROJ, U, PART, ada);
    GB();
    p9_ln2(a, ada, RES, PART, gw, NGW, lane);
}

extern "C" void kernel_launch(void* const* d_in, const int* in_sizes, int n_in, void* d_out, int out_size, void* d_ws, size_t ws_size, hipStream_t stream) {
    static int grid = 0;
    if (grid == 0) {
        if (n_in != 23 || ws_size < WS_END) { fprintf(stderr, "kernel_launch: expected 23 inputs and >= %zu bytes of workspace; got %d, %zu\n", (size_t)WS_END, n_in, ws_size); grid = -1; return; }
        int dev = 0, cus = 0, per_cu = 0;
        hipGetDevice(&dev);
        hipDeviceGetAttribute(&cus, hipDeviceAttributeMultiprocessorCount, dev);
        if (hipFuncSetAttribute((const void*)fwd_megakernel, hipFuncAttributeMaxDynamicSharedMemorySize, LDS_BYTES) != hipSuccess) { fprintf(stderr, "kernel_launch: hipFuncSetAttribute failed\n"); grid = -1; return; }
        if (hipOccupancyMaxActiveBlocksPerMultiprocessor(&per_cu, (const void*)fwd_megakernel, 512, LDS_BYTES) != hipSuccess || per_cu < 1) { fprintf(stderr, "kernel_launch: occupancy query says %d blocks per CU\n", per_cu); (void)hipGetLastError(); per_cu = 1; }
        grid = cus;
        fprintf(stderr, "kernel_launch: cus %d per_cu %d grid %d\n", cus, per_cu, grid);
    }
    if (grid < 0) return;
    if (hipMemsetAsync((char*)d_ws + WS_CTL, 0, 16384, stream) != hipSuccess) { fprintf(stderr, "kernel_launch: memset failed\n"); return; }
    Args a{};
    const float** ap = (const float**)&a;
    for (int i = 0; i < 23; ++i) ap[i] = (const float*)d_in[i];
    a.out = (float*)d_out; a.ws = (unsigned char*)d_ws;
    void* args[] = {&a};
    hipError_t e = hipLaunchCooperativeKernel((const void*)fwd_megakernel, dim3(grid), dim3(512), args, LDS_BYTES, stream);
    if (e != hipSuccess) fprintf(stderr, "kernel_launch: cooperative launch failed: %s (grid %d)\n", hipGetErrorString(e), grid);
}
```

```cpp
#include <hip/hip_runtime.h>
#include <cstdio>
#include <cstdint>

#define LAS __attribute__((address_space(3)))
typedef unsigned short bf16_t;
typedef short bf16x8 __attribute__((ext_vector_type(8)));
typedef float f32x4 __attribute__((ext_vector_type(4)));
typedef float f32x2 __attribute__((ext_vector_type(2)));
typedef unsigned u32x4 __attribute__((ext_vector_type(4)));
typedef unsigned u32x2 __attribute__((ext_vector_type(2)));

constexpr int D = 2048, NB = 4, SEQ = 2048, NS = 128;
constexpr int MP = NB * SEQ;
constexpr int MV = MP + NS;
constexpr int MPAD = 8448;
constexpr int PW = 1024, CW = 1024, DFF = 8192, INW = 8192, NADA = 6 * D, NCOND = NB + NS;
constexpr float ALPHA = 1.18920711500272f;
constexpr float LN_EPS = 1e-5f;
constexpr int NADAP = 256 * 64;
__device__ __forceinline__ int adac(int n) { return n + 16 * (n / 48); }

constexpr size_t MiB = 1u << 20;
constexpr size_t WS_CTL = 0;
constexpr size_t WS_ADA = 352 * MiB;
constexpr size_t WS_WIN = 8 * MiB, WS_WFF1 = 40 * MiB, WS_WFF2 = 72 * MiB, WS_WO = 104 * MiB, WS_WUPP = 112 * MiB, WS_WUPC = 116 * MiB;
constexpr size_t WS_U = 120 * MiB;
constexpr size_t WS_PROJ = 153 * MiB;
constexpr size_t WS_RES = 285 * MiB;
constexpr size_t WS_PART = 362 * MiB;
constexpr size_t WS_END = 378 * MiB;
constexpr size_t WS_CIN_OFF = (size_t)MPAD * 1024 * 2;

constexpr size_t O_YP = 0, O_YS = (size_t)MP * D, O_NPP = O_YS + (size_t)NS * D, O_NCP = O_NPP + (size_t)NB * 15 * PW, O_NPS = O_NCP + (size_t)NB * 2 * CW, O_NCS = O_NPS + (size_t)NS * 15 * PW;

constexpr int LDS_BYTES = 131072 + 256, MISC_OFF = 131072;

__device__ __forceinline__ unsigned f2bf(float f) { unsigned u = __builtin_bit_cast(unsigned, f); return (u + 0x7fffu + ((u >> 16) & 1u)) >> 16; }
__device__ __forceinline__ unsigned pk2(float lo, float hi) { return f2bf(lo) | (f2bf(hi) << 16); }
__device__ __forceinline__ unsigned cvt_pk_bf16(float lo, float hi) { unsigned r; asm volatile("v_cvt_pk_bf16_f32 %0, %1, %2" : "=v"(r) : "v"(lo), "v"(hi)); return r; }
__device__ __forceinline__ float bflo(unsigned w) { return __builtin_bit_cast(float, w << 16); }
__device__ __forceinline__ float bfhi(unsigned w) { return __builtin_bit_cast(float, w & 0xffff0000u); }
__device__ __forceinline__ int cond_row(int r) { int s = r - MP; s = s < 0 ? 0 : (s > NS - 1 ? NS - 1 : s); return r < MP ? (r >> 11) : NB + s; }
__device__ __forceinline__ const float* x_rowp(const float* xp, const float* xs, int r) { int s = r - MP; s = s < 0 ? 0 : (s > NS - 1 ? NS - 1 : s); return r < MP ? xp + (size_t)r * D : xs + (size_t)s * D; }

namespace pg8 {
constexpr int BM = 256, BK = 64, HALF = 128, HTB = HALF * BK * 2, NXCD = 8, WGM = 8;
__device__ __forceinline__ int lds_byte(int r, int c) { const int st = (r >> 4) * 2 + (c >> 5), rr = r & 15, cc = c & 31, ob = rr * 64 + cc * 2; return st * 1024 + (ob ^ (((ob >> 9) & 1) << 5)); }
__device__ __forceinline__ void stage_rc(int b, int& R, int& C) { const int st = b / 1024, sb = b % 1024, swz = sb ^ (((sb >> 9) & 1) << 5); R = (st >> 1) * 16 + swz / 64; C = (st & 1) * 32 + (swz % 64) / 2; }
__device__ __forceinline__ int perm32(int rho) { const int n = rho >> 4, i = rho & 15; return 8 * (i >> 2) + 4 * n + (i & 3); }

struct Unit { int pm, pn, grp; };
struct Order {
    int nM, nN, nwg, G, c, rep;
    const char* A0; const char* B0; const char* A1; const char* B1;
    __device__ __forceinline__ void init(int M, int N, int G_, int c_, int rep_, const void* a0, const void* b0, const void* a1, const void* b1) {
        nM = M / BM; nN = N / BM; nwg = nM * nN; G = G_; c = c_; rep = rep_; A0 = (const char*)a0; B0 = (const char*)b0; A1 = (const char*)a1; B1 = (const char*)b1; }
    __device__ __forceinline__ bool next(int i, Unit& u) const {
        const int ti = (rep == 2) ? (i >> 1) : i; u.grp = (rep == 2) ? (i & 1) : 0;
        const long L = (long)ti * G + c; if (L >= nwg) return false;
        int wgid = (int)L; { const int q = nwg / NXCD, r = nwg % NXCD, xcd = wgid % NXCD, off = wgid / NXCD; wgid = (xcd < r ? xcd * (q + 1) : r * (q + 1) + (xcd - r) * q) + off; }
        const int nig = WGM * nN, gid = wgid / nig, fm = gid * WGM, gsz = (nM - fm) < WGM ? (nM - fm) : WGM;
        u.pm = fm + ((wgid % nig) % gsz); u.pn = (wgid % nig) / gsz; return true;
    }
    __device__ __forceinline__ const char* baseA(const Unit& u, size_t tstep) const { return (u.grp ? A1 : A0) + (size_t)u.pm * tstep; }
    __device__ __forceinline__ const char* baseB(const Unit& u, size_t tstep) const { return (u.grp ? B1 : B0) + (size_t)u.pn * tstep; }
};

typedef f32x4 Acc[2][2][4][2];

template <int ACT> struct EpiBf16 {
    static constexpr bool PERM = true;
    bf16_t* O; int ldc; const float* bias;
    __device__ __forceinline__ bool keep(const Unit&) const { return false; }
    __device__ __forceinline__ void operator()(Acc& acc, const Unit& u, int wr, int wc, int fr, int fq) const {
        const int row0 = u.pm * BM + wr * 64 + fr, col0 = u.pn * BM + wc * 32 + 8 * fq;
        f32x4 bv[2][2];
#pragma unroll
        for (int bj = 0; bj < 2; ++bj)
#pragma unroll
            for (int n = 0; n < 2; ++n) bv[bj][n] = bias ? *(const f32x4*)(bias + col0 + bj * HALF + 4 * n) : (f32x4){0.f, 0.f, 0.f, 0.f};
#pragma unroll
        for (int ai = 0; ai < 2; ++ai)
#pragma unroll
            for (int m = 0; m < 4; ++m) { bf16_t* rowp = O + (size_t)(row0 + ai * HALF + m * 16) * ldc + col0;
#pragma unroll
                for (int bj = 0; bj < 2; ++bj) { f32x4 v0 = acc[ai][bj][m][0] + bv[bj][0], v1 = acc[ai][bj][m][1] + bv[bj][1];
                    if (ACT == 1) {
#pragma unroll
                        for (int j = 0; j < 4; ++j) { const float a = fmaxf(v0[j], 0.f), b = fmaxf(v1[j], 0.f); v0[j] = a * a; v1[j] = b * b; } }
                    u32x4 w; w.x = cvt_pk_bf16(v0[0], v0[1]); w.y = cvt_pk_bf16(v0[2], v0[3]); w.z = cvt_pk_bf16(v1[0], v1[1]); w.w = cvt_pk_bf16(v1[2], v1[3]);
                    *(u32x4*)(rowp + bj * HALF) = w; } }
    }
};
__device__ __forceinline__ void unpack8(const u32x4 w, float (&e)[8]) { e[0] = bflo(w.x); e[1] = bfhi(w.x); e[2] = bflo(w.y); e[3] = bfhi(w.y); e[4] = bflo(w.z); e[5] = bfhi(w.z); e[6] = bflo(w.w); e[7] = bfhi(w.w); }
struct EpiGate {
    static constexpr bool PERM = true;
    const bf16_t* proj; bf16_t* O;
    __device__ __forceinline__ bool keep(const Unit& u) const { return u.grp == 0; }
    __device__ __forceinline__ void operator()(Acc& acc, const Unit& u, int wr, int wc, int fr, int fq) const {
        const int row0 = u.pm * BM + wr * 64 + fr, col0 = u.pn * BM + wc * 32 + 8 * fq;
        const bool g0 = (u.grp == 0);
        u32x4 gcw[2], gpw[2];
        { const bf16_t* p = proj + (size_t)row0 * INW + col0; gcw[0] = *(const u32x4*)(p + 6144); gpw[0] = g0 ? *(const u32x4*)(p + 4096) : gcw[0]; }
#pragma unroll
        for (int it = 0; it < 16; ++it) { const int ai = it >> 3, m = (it >> 1) & 3, bj = it & 1;
            const size_t row = (size_t)(row0 + ai * HALF + m * 16); const int col = col0 + bj * HALF;
            if (it < 15) { const int ai2 = (it + 1) >> 3, m2 = ((it + 1) >> 1) & 3, bj2 = (it + 1) & 1;
                const bf16_t* p = proj + (size_t)(row0 + ai2 * HALF + m2 * 16) * INW + col0 + bj2 * HALF;
                gcw[(it + 1) & 1] = *(const u32x4*)(p + 6144); gpw[(it + 1) & 1] = g0 ? *(const u32x4*)(p + 4096) : gcw[(it + 1) & 1]; }
            float ec[8]; unpack8(gcw[it & 1], ec);
#pragma unroll
            for (int j = 0; j < 8; ++j) ec[j] = 1.f + __expf(-fmaxf(ec[j], -30.f));
            if (g0) {
                float ep[8]; unpack8(gpw[it & 1], ep);
#pragma unroll
                for (int j = 0; j < 8; ++j) ep[j] = ec[j] * __builtin_amdgcn_rcpf(1.f + __expf(-ep[j]));
#pragma unroll
                for (int j = 0; j < 4; ++j) { acc[ai][bj][m][0][j] *= ep[j]; acc[ai][bj][m][1][j] *= ep[4 + j]; }
            } else {
                f32x4 v0, v1;
#pragma unroll
                for (int j = 0; j < 4; ++j) { v0[j] = acc[ai][bj][m][0][j] * __builtin_amdgcn_rcpf(ec[j]); v1[j] = acc[ai][bj][m][1][j] * __builtin_amdgcn_rcpf(ec[4 + j]); }
                u32x4 w; w.x = cvt_pk_bf16(v0[0], v0[1]); w.y = cvt_pk_bf16(v0[2], v0[3]); w.z = cvt_pk_bf16(v1[0], v1[1]); w.w = cvt_pk_bf16(v1[2], v1[3]);
                *(u32x4*)(O + row * D + col) = w;
            } }
    }
};
struct EpiRes {
    static constexpr bool PERM = false;
    float* res; const float* base; const float* ada; int gate_off; const float* bias;
    __device__ __forceinline__ bool keep(const Unit&) const { return false; }
    __device__ __forceinline__ void operator()(Acc& acc, const Unit& u, int wr, int wc, int fr, int fq) const {
        const int row0 = u.pm * BM + wr * 64 + fr, col0 = u.pn * BM + wc * 32 + 4 * fq;
        const float* gp = ada + (size_t)(u.pm >> 3) * NADAP;
        f32x4 bv[2][2], gv[2][2], xb[2][2][2];
#pragma unroll
        for (int bj = 0; bj < 2; ++bj)
#pragma unroll
            for (int n = 0; n < 2; ++n) { bv[bj][n] = bias ? *(const f32x4*)(bias + col0 + bj * HALF + n * 16) : (f32x4){0.f, 0.f, 0.f, 0.f}; gv[bj][n] = *(const f32x4*)(gp + adac(gate_off + col0 + bj * HALF + n * 16)); }
#pragma unroll
        for (int bj = 0; bj < 2; ++bj)
#pragma unroll
            for (int n = 0; n < 2; ++n) xb[0][bj][n] = *(const f32x4*)(base + (size_t)row0 * D + col0 + bj * HALF + n * 16);
#pragma unroll
        for (int it = 0; it < 8; ++it) { const int ai = it >> 2, m = it & 3;
            if (it < 7) { const float* bp = base + (size_t)(row0 + ((it + 1) >> 2) * HALF + ((it + 1) & 3) * 16) * D + col0;
#pragma unroll
                for (int bj = 0; bj < 2; ++bj)
#pragma unroll
                    for (int n = 0; n < 2; ++n) xb[(it + 1) & 1][bj][n] = *(const f32x4*)(bp + bj * HALF + n * 16); }
            float* rp = res + (size_t)(row0 + ai * HALF + m * 16) * D + col0;
#pragma unroll
            for (int bj = 0; bj < 2; ++bj)
#pragma unroll
                for (int n = 0; n < 2; ++n) *(f32x4*)(rp + bj * HALF + n * 16) = xb[it & 1][bj][n] * ALPHA + gv[bj][n] * (acc[ai][bj][m][n] + bv[bj][n]); }
    }
};

template <class Epi>
__device__ __forceinline__ void gemm_phase(LAS unsigned char* lds, const int K, const Order& S, const Epi& E) {
    const int tid = threadIdx.x, wid = __builtin_amdgcn_readfirstlane(tid >> 6), lane = tid & 63, wr = wid >> 2, wc = wid & 3, fr = lane & 15, fq = lane >> 4;
    const int nt = K / BK;
    unsigned voffA[2], voffB[2];
#pragma unroll
    for (int i = 0; i < 2; ++i) { int R, C; stage_rc(tid * 16 + i * 8192, R, C); const int Rb = Epi::PERM ? ((R & ~31) + perm32(R & 31)) : R;
        voffA[i] = (unsigned)(R * K + C) * 2u; voffB[i] = (unsigned)(Rb * K + C) * 2u; }
    const size_t kstep = (size_t)(BK * 2);
    const size_t hstep = (size_t)HALF * K * 2;
    const size_t tstep = 2 * hstep;
    const unsigned ldsw = (unsigned)wid * 1024u;
    const int aoff = lds_byte(wr * 64 + fr, fq * 8), boff = lds_byte(wc * 32 + fr, fq * 8);
#define PG8_SA(b, h) (((b) * 2 + (h)) * HTB)
#define PG8_SB(b, h) ((4 + (b) * 2 + (h)) * HTB)
#define PG8_STAGE(bufoff, gbase, voff) do { _Pragma("unroll") for (int _i = 0; _i < 2; ++_i) \
        __builtin_amdgcn_global_load_lds((const unsigned*)((const char*)(gbase) + (voff)[_i]), (LAS unsigned*)(lds + (bufoff) + ldsw + _i * 8192), 16, 0, 0); } while (0)
#define PG8_LDA(dst, b, h) do { _Pragma("unroll") for (int m = 0; m < 4; ++m) _Pragma("unroll") for (int k = 0; k < 2; ++k) dst[m][k] = *(const LAS bf16x8*)(lds + PG8_SA(b, h) + aoff + m * 2048 + k * 1024); } while (0)
#define PG8_LDB(dst, b, h) do { _Pragma("unroll") for (int n = 0; n < 2; ++n) _Pragma("unroll") for (int k = 0; k < 2; ++k) dst[n][k] = *(const LAS bf16x8*)(lds + PG8_SB(b, h) + boff + n * 2048 + k * 1024); } while (0)
#define PG8_MMA(ai, bj, At, Bt) do { __builtin_amdgcn_s_setprio(1); _Pragma("unroll") for (int m = 0; m < 4; ++m) _Pragma("unroll") for (int n = 0; n < 2; ++n) _Pragma("unroll") for (int k = 0; k < 2; ++k) \
        acc[ai][bj][m][n] = __builtin_amdgcn_mfma_f32_16x16x32_bf16(Bt[n][k], At[m][k], acc[ai][bj][m][n], 0, 0, 0); __builtin_amdgcn_s_setprio(0); } while (0)
#define PG8_WAIT_V(n) asm volatile("s_waitcnt vmcnt(" #n ")" ::: "memory")
#define PG8_WAIT_L(n) asm volatile("s_waitcnt lgkmcnt(" #n ")" ::: "memory")
#define PG8_BAR __builtin_amdgcn_s_barrier()
#define PG8_SCHED __builtin_amdgcn_sched_barrier(0)
    Unit cur, nxt; int ui = 0;
    if (!S.next(0, cur)) return;
    Acc acc;
#pragma unroll
    for (int a = 0; a < 2; ++a)
#pragma unroll
        for (int b = 0; b < 2; ++b)
#pragma unroll
            for (int m = 0; m < 4; ++m)
#pragma unroll
                for (int n = 0; n < 2; ++n) acc[a][b][m][n] = (f32x4){0.f, 0.f, 0.f, 0.f};
    bf16x8 At[4][2], B0[2][2], B1[2][2];
    const char* cA = S.baseA(cur, tstep); const char* cB = S.baseB(cur, tstep);
    PG8_STAGE(PG8_SB(0, 0), cB, voffB); PG8_STAGE(PG8_SB(0, 1), cB + hstep, voffB); PG8_STAGE(PG8_SA(0, 0), cA, voffA); PG8_STAGE(PG8_SA(0, 1), cA + hstep, voffA);
    if (wr == 1) PG8_BAR;
    PG8_WAIT_V(2); PG8_BAR;
    PG8_STAGE(PG8_SB(1, 0), cB + kstep, voffB); PG8_STAGE(PG8_SA(1, 0), cA + kstep, voffA); PG8_STAGE(PG8_SB(1, 1), cB + hstep + kstep, voffB);
    PG8_WAIT_V(6); PG8_BAR;
    for (;;) {
        const bool has_next = S.next(ui + 1, nxt);
        const char* nA = has_next ? S.baseA(nxt, tstep) : cA; const char* nB = has_next ? S.baseB(nxt, tstep) : cB;
        for (int t = 0; t < nt; t += 2) {
            const bool last = (t == nt - 2);
            const char* a1 = cA + (size_t)(t + 1) * kstep;
            const char* a2 = last ? nA : cA + (size_t)(t + 2) * kstep; const char* b2 = last ? nB : cB + (size_t)(t + 2) * kstep;
            const char* a3 = a2 + kstep; const char* b3 = b2 + kstep;
            PG8_LDB(B0, 0, 0); PG8_LDB(B1, 0, 1); PG8_SCHED; PG8_LDA(At, 0, 0); PG8_STAGE(PG8_SA(1, 1), a1 + hstep, voffA);
            PG8_WAIT_V(8); PG8_WAIT_L(0); PG8_BAR; PG8_MMA(0, 0, At, B0); PG8_MMA(0, 1, At, B1); PG8_BAR; PG8_SCHED;
            PG8_LDA(At, 0, 1); PG8_STAGE(PG8_SB(0, 0), b2, voffB); PG8_STAGE(PG8_SB(0, 1), b2 + hstep, voffB); PG8_STAGE(PG8_SA(0, 0), a2, voffA);
            PG8_WAIT_V(8); PG8_WAIT_L(0); PG8_BAR; PG8_MMA(1, 0, At, B0); PG8_MMA(1, 1, At, B1); PG8_BAR; PG8_SCHED;
            PG8_LDB(B0, 1, 0); PG8_LDB(B1, 1, 1); PG8_SCHED; PG8_LDA(At, 1, 0); PG8_STAGE(PG8_SA(0, 1), a2 + hstep, voffA);
            PG8_WAIT_V(8); PG8_WAIT_L(0); PG8_BAR; PG8_MMA(0, 0, At, B0); PG8_MMA(0, 1, At, B1); PG8_BAR; PG8_SCHED;
            PG8_LDA(At, 1, 1); PG8_STAGE(PG8_SB(1, 0), b3, voffB); PG8_STAGE(PG8_SB(1, 1), b3 + hstep, voffB); PG8_STAGE(PG8_SA(1, 0), a3, voffA);
            PG8_WAIT_V(8); PG8_WAIT_L(0); PG8_BAR; PG8_MMA(1, 0, At, B0); PG8_MMA(1, 1, At, B1); PG8_BAR; PG8_SCHED;
        }
        if (wr == 0) PG8_BAR;
        E(acc, cur, wr, wc, fr, fq);
        if (!has_next) break;
        if (!E.keep(cur)) {
#pragma unroll
            for (int a = 0; a < 2; ++a)
#pragma unroll
                for (int b = 0; b < 2; ++b)
#pragma unroll
                    for (int m = 0; m < 4; ++m)
#pragma unroll
                        for (int n = 0; n < 2; ++n) acc[a][b][m][n] = (f32x4){0.f, 0.f, 0.f, 0.f};
        }
        cur = nxt; cA = nA; cB = nB; ++ui;
        if (wr == 1) PG8_BAR;
    }
    PG8_WAIT_V(0);
    PG8_BAR;
#undef PG8_SA
#undef PG8_SB
#undef PG8_STAGE
#undef PG8_LDA
#undef PG8_LDB
#undef PG8_MMA
#undef PG8_WAIT_V
#undef PG8_WAIT_L
#undef PG8_BAR
#undef PG8_SCHED
}
}

struct Args {
    const float *x_prompt, *x_sample, *state_pool, *state_conv, *c_prompt, *c_sample, *w_ada, *b_ada, *w_in, *pool_grp_w, *pool_scale, *conv_w, *w_pool_up, *w_conv_up, *w_o,
        *ln1_g, *ln1_b, *w_ff1, *b_ff1, *w_ff2, *b_ff2, *ln2_g, *ln2_b;
    float* out; unsigned char* ws;
};

__device__ __forceinline__ float wave_sum(float v) {
#pragma unroll
    for (int o = 1; o < 64; o <<= 1) v += __shfl_xor(v, o);
    return v;
}

__device__ __forceinline__ void p0_transpose_item(const float* W, int K, int N, bf16_t* WT, LAS float* scr, int item, int lane) {
    const int nblk = N / 32, kb = item / nblk, nb = item % nblk, k0 = 64 * kb, n0 = 32 * nb;
    f32x4 v[8];
#pragma unroll
    for (int i = 0; i < 8; ++i) v[i] = __builtin_nontemporal_load((const f32x4*)(W + (size_t)(k0 + 8 * i + (lane >> 3)) * N + n0 + 4 * (lane & 7)));
#pragma unroll
    for (int i = 0; i < 8; ++i) { LAS float* d = scr + (8 * i + (lane >> 3)) * 33 + 4 * (lane & 7); d[0] = v[i][0]; d[1] = v[i][1]; d[2] = v[i][2]; d[3] = v[i][3]; }
    asm volatile("s_waitcnt lgkmcnt(0)" ::: "memory");
    const int c = lane & 7;
#pragma unroll
    for (int j = 0; j < 4; ++j) { const int n = (lane >> 3) + 8 * j; const LAS float* s = scr + (8 * c) * 33 + n;
        u32x4 o; o.x = pk2(s[0 * 33], s[1 * 33]); o.y = pk2(s[2 * 33], s[3 * 33]); o.z = pk2(s[4 * 33], s[5 * 33]); o.w = pk2(s[6 * 33], s[7 * 33]);
        *(u32x4*)(WT + (size_t)(n0 + n) * K + k0 + 8 * c) = o; }
    asm volatile("s_waitcnt lgkmcnt(0)" ::: "memory");
}

__device__ __forceinline__ void p0_ada_item(const Args& a, float* ada, LAS unsigned char* lds, int item, int wave, int lane) {
    const int n0 = item * 48, fr = lane & 15, kq = lane >> 4;
    f32x4 acc[9][3];
#pragma unroll
    for (int mt = 0; mt < 9; ++mt)
#pragma unroll
        for (int q = 0; q < 3; ++q) acc[mt][q] = (f32x4){0.f, 0.f, 0.f, 0.f};
    const float* const cr0 = fr < NB ? a.c_prompt + (size_t)fr * D : a.c_sample + (size_t)(fr - NB) * D;
    const float* const crm = a.c_sample + (size_t)(fr + 12) * D;
    const float* const cr8 = a.c_sample + (size_t)(124 + fr > NS - 1 ? NS - 1 : 124 + fr) * D;
#pragma unroll 2
    for (int ks = 0; ks < 8; ++ks) {
        const int k0 = wave * 256 + ks * 32 + kq * 8;
        float b[8][3];
#pragma unroll
        for (int j = 0; j < 8; ++j) { const float* p = a.w_ada + (size_t)(k0 + j) * NADA + n0 + 3 * fr; b[j][0] = __builtin_nontemporal_load(p); b[j][1] = __builtin_nontemporal_load(p + 1); b[j][2] = __builtin_nontemporal_load(p + 2); }
        bf16x8 bfr[3];
#pragma unroll
        for (int q = 0; q < 3; ++q) { u32x4 w; w.x = pk2(b[0][q], b[1][q]); w.y = pk2(b[2][q], b[3][q]); w.z = pk2(b[4][q], b[5][q]); w.w = pk2(b[6][q], b[7][q]); bfr[q] = __builtin_bit_cast(bf16x8, w); }
#pragma unroll
        for (int mt = 0; mt < 9; ++mt) {
            const float* cp = (mt == 0) ? cr0 : (mt == 8 ? cr8 : crm + (size_t)(mt - 1) * 16 * D);
            const f32x4 a0 = *(const f32x4*)(cp + k0), a1 = *(const f32x4*)(cp + k0 + 4);
            u32x4 w; w.x = pk2(a0[0], a0[1]); w.y = pk2(a0[2], a0[3]); w.z = pk2(a1[0], a1[1]); w.w = pk2(a1[2], a1[3]);
            const bf16x8 af = __builtin_bit_cast(bf16x8, w);
#pragma unroll
            for (int q = 0; q < 3; ++q) acc[mt][q] = __builtin_amdgcn_mfma_f32_16x16x32_bf16(af, bfr[q], acc[mt][q], 0, 0, 0);
            if (mt % 3 == 2) asm volatile("" ::: "memory");
        }
    }
    LAS float* red = (LAS float*)lds;
#pragma unroll
    for (int s = 4; s >= 1; s >>= 1) {
        if (wave >= s && wave < 2 * s) { LAS float* dst = red + (wave - s) * 6912 + lane;
#pragma unroll
            for (int mt = 0; mt < 9; ++mt)
#pragma unroll
                for (int q = 0; q < 3; ++q)
#pragma unroll
                    for (int j = 0; j < 4; ++j) dst[((mt * 3 + q) * 4 + j) * 64] = acc[mt][q][j]; }
        __syncthreads();
        if (wave < s) { const LAS float* src = red + wave * 6912 + lane;
#pragma unroll
            for (int mt = 0; mt < 9; ++mt)
#pragma unroll
                for (int q = 0; q < 3; ++q)
#pragma unroll
                    for (int j = 0; j < 4; ++j) acc[mt][q][j] += src[((mt * 3 + q) * 4 + j) * 64]; }
        __syncthreads();
    }
    if (wave == 0) {
#pragma unroll
        for (int q = 0; q < 3; ++q) { const int n = n0 + 3 * fr + q; const float bb = a.b_ada[n];
#pragma unroll
            for (int mt = 0; mt < 9; ++mt)
#pragma unroll
                for (int j = 0; j < 4; ++j) { const int r = mt * 16 + kq * 4 + j; if (r < NCOND) ada[(size_t)r * NADAP + item * 64 + 3 * fr + q] = acc[mt][q][j] + bb; } }
    }
}

__device__ __forceinline__ void p0_weff_item(const Args& a, bf16_t* WT, LAS unsigned char* lds, int item, int tid) {
    constexpr int AP = 260, BP = 80;
    const int g = item >> 7, it = (item >> 5) & 3, nt = item & 31, i0 = it * 64, n0 = nt * 64;
    LAS float* As = (LAS float*)lds;
    LAS float* Bs = (LAS float*)(lds + 66560);
#pragma unroll
    for (int r = 0; r < 8; ++r) { const int idx = tid + r * 512, row = idx >> 6, c4 = idx & 63;
        *(LAS f32x4*)(As + row * AP + c4 * 4) = *(const f32x4*)(a.pool_grp_w + ((size_t)(g * 256 + i0 + row)) * 256 + c4 * 4); }
    const int lane = tid & 63, wave = tid >> 6, fr = lane & 15, kq = lane >> 4, mt = wave >> 1, np = (wave & 1) * 2;
    f32x4 acc[2] = {(f32x4){0.f, 0.f, 0.f, 0.f}, (f32x4){0.f, 0.f, 0.f, 0.f}};
#pragma unroll 1
    for (int h = 0; h < 2; ++h) {
        __syncthreads();
#pragma unroll
        for (int r = 0; r < 4; ++r) { const int idx = tid + r * 512, o = idx >> 4, c4 = idx & 15;
            const float sc = a.pool_scale[g * 256 + h * 128 + o];
            *(LAS f32x4*)(Bs + o * BP + c4 * 4) = *(const f32x4*)(a.w_pool_up + (size_t)(g * 256 + h * 128 + o) * D + n0 + c4 * 4) * sc; }
        __syncthreads();
#pragma unroll 8
        for (int o4 = 0; o4 < 32; ++o4) {
            const float av = As[(mt * 16 + fr) * AP + h * 128 + o4 * 4 + kq];
            const float b0 = Bs[(o4 * 4 + kq) * BP + np * 16 + fr], b1 = Bs[(o4 * 4 + kq) * BP + np * 16 + 16 + fr];
            acc[0] = __builtin_amdgcn_mfma_f32_16x16x4f32(av, b0, acc[0], 0, 0, 0);
            acc[1] = __builtin_amdgcn_mfma_f32_16x16x4f32(av, b1, acc[1], 0, 0, 0);
        }
    }
#pragma unroll
    for (int t = 0; t < 2; ++t)
        *(u32x2*)(WT + (size_t)(n0 + (np + t) * 16 + fr) * PW + g * 256 + i0 + mt * 16 + kq * 4) = (u32x2){pk2(acc[t][0], acc[t][1]), pk2(acc[t][2], acc[t][3])};
    __syncthreads();
}

__device__ __forceinline__ void p1_modulate(const Args& a, const float* ada, bf16_t* U, int gw, int NGW, int lane) {
    for (int r = gw; r < MV; r += NGW) {
        u32x2* o8 = (u32x2*)(U + (size_t)r * D) + lane;
        const f32x4* xr = (const f32x4*)x_rowp(a.x_prompt, a.x_sample, r) + lane;
        const float* ar = ada + (size_t)cond_row(r) * NADAP;
#pragma unroll
        for (int j = 0; j < 8; ++j) { const int c = 4 * (lane + 64 * j); const f32x4 v = __builtin_nontemporal_load(xr + 64 * j) * (*(const f32x4*)(ar + adac(D + c)) + 1.f) + *(const f32x4*)(ar + adac(c));
            o8[64 * j] = (u32x2){pk2(v[0], v[1]), pk2(v[2], v[3])}; }
    }
}

__device__ __forceinline__ void p3_mixer(const Args& a, const bf16_t* proj, bf16_t* PRE, bf16_t* CIN, int tid) {
    const int j0 = 2 * tid, wave = tid >> 6, W = 2 << (wave >> 1);
    const f32x2 cw0 = *(const f32x2*)(a.conv_w + j0), cw1 = *(const f32x2*)(a.conv_w + CW + j0), cw2 = *(const f32x2*)(a.conv_w + 2 * CW + j0);
    float* const npp = a.out + O_NPP; float* const ncp = a.out + O_NCP; float* const nps = a.out + O_NPS; float* const ncs = a.out + O_NCS;
    for (int it = blockIdx.x; it < 384; it += gridDim.x) {
        if (it < 256) {
            const int b = it >> 6, s0 = (it & 63) * 32;
            const bf16_t* pb = proj + (size_t)(b * SEQ) * INW + j0;
            float S0 = 0.f, S1 = 0.f;
            for (int i = 1; i < W; ++i) { const int s = s0 - i; if (s >= 0) { const unsigned w = *(const unsigned*)(pb + (size_t)s * INW); S0 += bflo(w); S1 += bfhi(w); } }
            float v1a = 0.f, v1b = 0.f, v2a = 0.f, v2b = 0.f;
            if (s0 >= 1) { const bf16_t* p = pb + (size_t)(s0 - 1) * INW; const unsigned wx = *(const unsigned*)(p + 1024), wc = *(const unsigned*)(p + 3072); v1a = bflo(wc) * bflo(wx); v1b = bfhi(wc) * bfhi(wx); }
            if (s0 >= 2) { const bf16_t* p = pb + (size_t)(s0 - 2) * INW; const unsigned wx = *(const unsigned*)(p + 1024), wc = *(const unsigned*)(p + 3072); v2a = bflo(wc) * bflo(wx); v2b = bfhi(wc) * bfhi(wx); }
#pragma unroll 4
            for (int s = s0; s < s0 + 32; ++s) {
                const bf16_t* p = pb + (size_t)s * INW;
                const unsigned wz = *(const unsigned*)p, wx = *(const unsigned*)(p + 1024), wb = *(const unsigned*)(p + 2048), wc = *(const unsigned*)(p + 3072);
                const float z0 = bflo(wz), z1 = bfhi(wz);
                S0 += z0; S1 += z1;
                const int cnt = (s + 1 < W) ? s + 1 : W; const float fc = (float)cnt;
                const float p0 = S0 / fc - z0, p1 = S1 / fc - z1;
                const int so = s - W + 1;
                if (so >= 0) { const unsigned wo = *(const unsigned*)(pb + (size_t)so * INW); S0 -= bflo(wo); S1 -= bfhi(wo); }
                const float va = bflo(wc) * bflo(wx), vb = bfhi(wc) * bfhi(wx);
                const float ya = cw0[0] * v2a + cw1[0] * v1a + cw2[0] * va, yb = cw0[1] * v2b + cw1[1] * v1b + cw2[1] * vb;
                const size_t row = (size_t)(b * SEQ + s);
                *(unsigned*)(PRE + row * PW + j0) = pk2(p0, p1);
                *(unsigned*)(CIN + row * CW + j0) = pk2(bflo(wb) * ya, bfhi(wb) * yb);
                if (s >= SEQ - 15) *(f32x2*)(npp + ((size_t)(b * 15 + s - (SEQ - 15))) * PW + j0) = (f32x2){z0, z1};
                if (s >= SEQ - 2) *(f32x2*)(ncp + ((size_t)(b * 2 + s - (SEQ - 2))) * CW + j0) = (f32x2){va, vb};
                v2a = v1a; v2b = v1b; v1a = va; v1b = vb;
            }
        } else {
            const int b = it - 256; const size_t row = (size_t)(MP + b);
            const bf16_t* p = proj + row * INW + j0;
            const unsigned wz = *(const unsigned*)p, wx = *(const unsigned*)(p + 1024), wb = *(const unsigned*)(p + 2048), wc = *(const unsigned*)(p + 3072);
            const float z0 = bflo(wz), z1 = bfhi(wz);
            const float* sp = a.state_pool + (size_t)b * 15 * PW + j0;
            float S0 = z0, S1 = z1;
            for (int i = 1; i < W; ++i) { const f32x2 h = *(const f32x2*)(sp + (size_t)(15 - i) * PW); S0 += h[0]; S1 += h[1]; }
            const float fc = (float)W;
            *(unsigned*)(PRE + row * PW + j0) = pk2(S0 / fc - z0, S1 / fc - z1);
            const f32x2 h0 = *(const f32x2*)(a.state_conv + (size_t)(b * 2) * CW + j0), h1 = *(const f32x2*)(a.state_conv + (size_t)(b * 2 + 1) * CW + j0);
            const float va = bflo(wc) * bflo(wx), vb = bfhi(wc) * bfhi(wx);
            const float ya = cw0[0] * h0[0] + cw1[0] * h1[0] + cw2[0] * va, yb = cw0[1] * h0[1] + cw1[1] * h1[1] + cw2[1] * vb;
            *(unsigned*)(CIN + row * CW + j0) = pk2(bflo(wb) * ya, bfhi(wb) * yb);
#pragma unroll
            for (int r = 0; r < 14; ++r) *(f32x2*)(nps + ((size_t)(b * 15 + r)) * PW + j0) = *(const f32x2*)(sp + (size_t)(r + 1) * PW);
            *(f32x2*)(nps + ((size_t)(b * 15 + 14)) * PW + j0) = (f32x2){z0, z1};
            *(f32x2*)(ncs + ((size_t)(b * 2)) * CW + j0) = h1;
            *(f32x2*)(ncs + ((size_t)(b * 2 + 1)) * CW + j0) = (f32x2){va, vb};
        }
    }
}

__device__ __forceinline__ void ln_row(f32x4 (&v)[8], const float* g, const float* b, int lane) {
    float s = 0.f;
#pragma unroll
    for (int j = 0; j < 8; ++j) s += (v[j][0] + v[j][1]) + (v[j][2] + v[j][3]);
    const float mean = wave_sum(s) * (1.f / D); float s2 = 0.f;
#pragma unroll
    for (int j = 0; j < 8; ++j) { v[j] = v[j] - mean; s2 += (v[j][0] * v[j][0] + v[j][1] * v[j][1]) + (v[j][2] * v[j][2] + v[j][3] * v[j][3]); }
    const float rstd = 1.f / sqrtf(wave_sum(s2) * (1.f / D) + LN_EPS);
    const f32x4* g4 = (const f32x4*)g + lane; const f32x4* b4 = (const f32x4*)b + lane;
#pragma unroll
    for (int j = 0; j < 8; ++j) v[j] = v[j] * rstd * g4[64 * j] + b4[64 * j];
}
__device__ __forceinline__ void p6_ln1(const Args& a, const float* ada, float* res, const float* part, bf16_t* U, int gw, int NGW, int lane) {
    for (int r = gw, nr; r >= 0; r = nr) { nr = -1; if (r < MP) { nr = r + NGW; if (nr >= MP) nr = ((gw & 15) == 0 && (gw >> 4) < NS && NGW >= 16 * NS) ? MP + (gw >> 4) : ((NGW >= 16 * NS) ? -1 : (nr < MV ? nr : -1)); } else if (NGW < 16 * NS) { nr = r + NGW; if (nr >= MV) nr = -1; }
        u32x2* o8 = (u32x2*)(U + (size_t)r * D) + lane;
        f32x4* rr = (f32x4*)(res + (size_t)r * D) + lane;
        const float* ar = ada + (size_t)cond_row(r) * NADAP;
        f32x4 v[8];
        if (r < MP) {
#pragma unroll
            for (int j = 0; j < 8; ++j) v[j] = rr[64 * j];
        } else {
            const f32x4* xr = (const f32x4*)(a.x_sample + (size_t)(r - MP) * D) + lane;
#pragma unroll
            for (int j = 0; j < 8; ++j) { f32x4 sum = (f32x4){0.f, 0.f, 0.f, 0.f};
#pragma unroll
                for (int sl = 0; sl < 16; ++sl) sum += ((const f32x4*)(part + ((size_t)sl * NS + (r - MP)) * D) + lane)[64 * j];
                v[j] = xr[64 * j] * ALPHA + *(const f32x4*)(ar + adac(2 * D + 4 * (lane + 64 * j))) * sum; }
        }
        ln_row(v, a.ln1_g, a.ln1_b, lane);
#pragma unroll
        for (int j = 0; j < 8; ++j) { const int c = 4 * (lane + 64 * j); rr[64 * j] = v[j]; const f32x4 t = v[j] * (*(const f32x4*)(ar + adac(4 * D + c)) + 1.f) + *(const f32x4*)(ar + adac(3 * D + c));
            o8[64 * j] = (u32x2){pk2(t[0], t[1]), pk2(t[2], t[3])}; }
    }
}
__device__ __forceinline__ void p9_ln2(const Args& a, const float* ada, const float* res, const float* part, int gw, int NGW, int lane) {
    for (int r = gw, nr; r >= 0; r = nr) { nr = -1; if (r < MP) { nr = r + NGW; if (nr >= MP) nr = ((gw & 15) == 0 && (gw >> 4) < NS && NGW >= 16 * NS) ? MP + (gw >> 4) : ((NGW >= 16 * NS) ? -1 : (nr < MV ? nr : -1)); } else if (NGW < 16 * NS) { nr = r + NGW; if (nr >= MV) nr = -1; }
        const f32x4* rr = (const f32x4*)(res + (size_t)r * D) + lane;
        f32x4 v[8];
#pragma unroll
        for (int j = 0; j < 8; ++j) v[j] = rr[64 * j];
        if (r >= MP) {
            const float* ar = ada + (size_t)cond_row(r) * NADAP;
#pragma unroll
            for (int j = 0; j < 8; ++j) { f32x4 sum = *((const f32x4*)a.b_ff2 + lane + 64 * j);
#pragma unroll
                for (int sl = 0; sl < 16; ++sl) sum += ((const f32x4*)(part + ((size_t)sl * NS + (r - MP)) * D) + lane)[64 * j];
                v[j] = v[j] * ALPHA + *(const f32x4*)(ar + adac(5 * D + 4 * (lane + 64 * j))) * sum; }
        }
        ln_row(v, a.ln2_g, a.ln2_b, lane);
        f32x4* o = (f32x4*)(a.out + (r < MP ? O_YP + (size_t)r * D : O_YS + (size_t)(r - MP) * D)) + lane;
#pragma unroll
        for (int j = 0; j < 8; ++j) o[64 * j] = v[j];
    }
}

typedef f32x4 Acc128[4][2];
__device__ __forceinline__ void gemm128_core(Acc128& acc, LAS unsigned char* lds, const bf16_t* A, const bf16_t* Bt, const int K  , const int klen  ) {
    using namespace pg8;
    const int tid = threadIdx.x, wid = __builtin_amdgcn_readfirstlane(tid >> 6), lane = tid & 63, wr = wid >> 2, wc = wid & 3, fr = lane & 15, fq = lane >> 4;
    const int nt = klen / 64;
    unsigned voff[2];
#pragma unroll
    for (int i = 0; i < 2; ++i) { int R, C; stage_rc(tid * 16 + i * 8192, R, C); voff[i] = (unsigned)(R * K + C) * 2u; }
    const unsigned ldsw = (unsigned)wid * 1024u;
    const int aoff = lds_byte(wr * 64 + fr, fq * 8), boff = lds_byte(wc * 32 + fr, fq * 8);
    const char* pa = (const char*)A; const char* pb = (const char*)Bt;
#define G128_STAGE(st, kt) do { _Pragma("unroll") for (int _i = 0; _i < 2; ++_i) { \
        __builtin_amdgcn_global_load_lds((const unsigned*)(pa + (size_t)(kt) * 128 + voff[_i]), (LAS unsigned*)(lds + (st) * 32768 + ldsw + _i * 8192), 16, 0, 0); \
        __builtin_amdgcn_global_load_lds((const unsigned*)(pb + (size_t)(kt) * 128 + voff[_i]), (LAS unsigned*)(lds + (st) * 32768 + 16384 + ldsw + _i * 8192), 16, 0, 0); } } while (0)
    G128_STAGE(0, 0); G128_STAGE(1, 1 < nt ? 1 : nt - 1); G128_STAGE(2, 2 < nt ? 2 : nt - 1);
#pragma unroll 1
    for (int t = 0; t < nt; ++t) {
        asm volatile("s_waitcnt vmcnt(8)" ::: "memory");
        __builtin_amdgcn_s_barrier();
        asm volatile("" ::: "memory");
        { const int kt = t + 3 < nt ? t + 3 : nt - 1; G128_STAGE((t + 3) & 3, kt); }
        const LAS unsigned char* sa = lds + (t & 3) * 32768; const LAS unsigned char* sb = sa + 16384;
        bf16x8 af[4][2], bfr[2][2];
#pragma unroll
        for (int m = 0; m < 4; ++m)
#pragma unroll
            for (int k = 0; k < 2; ++k) af[m][k] = *(const LAS bf16x8*)(sa + aoff + m * 2048 + k * 1024);
#pragma unroll
        for (int n = 0; n < 2; ++n)
#pragma unroll
            for (int k = 0; k < 2; ++k) bfr[n][k] = *(const LAS bf16x8*)(sb + boff + n * 2048 + k * 1024);
#pragma unroll
        for (int m = 0; m < 4; ++m)
#pragma unroll
            for (int n = 0; n < 2; ++n)
#pragma unroll
                for (int k = 0; k < 2; ++k) acc[m][n] = __builtin_amdgcn_mfma_f32_16x16x32_bf16(bfr[n][k], af[m][k], acc[m][n], 0, 0, 0);
        asm volatile("s_waitcnt lgkmcnt(0)" ::: "memory");
    }
    asm volatile("s_waitcnt vmcnt(0)" ::: "memory");
    __builtin_amdgcn_s_barrier();
    asm volatile("" ::: "memory");
#undef G128_STAGE
}
__device__ __forceinline__ void zero128(Acc128& acc) {
#pragma unroll
    for (int m = 0; m < 4; ++m)
#pragma unroll
        for (int n = 0; n < 2; ++n) acc[m][n] = (f32x4){0.f, 0.f, 0.f, 0.f};
}
template <int MODE>
__device__ __forceinline__ void sample_gemm(const Args& a, LAS unsigned char* lds, const bf16_t* A0, const bf16_t* B0, const bf16_t* A1, const bf16_t* B1, const int K, const int N,
                                            const bf16_t* proj, bf16_t* Ob, float* res, const float* ada) {
    const int tid = threadIdx.x, wid = __builtin_amdgcn_readfirstlane(tid >> 6), lane = tid & 63, wr = wid >> 2, wc = wid & 3, fr = lane & 15, fq = lane >> 4;
    constexpr int NSL = (MODE >= 3) ? 16 : 1;
    for (int unit = blockIdx.x; unit < (N / 128) * NSL; unit += gridDim.x) {
        const int n0 = (unit / NSL) * 128, sl = unit % NSL, klen = K / NSL;
        Acc128 acc, acc2;
        zero128(acc);
        gemm128_core(acc, lds, A0 + (size_t)MP * K + sl * klen, B0 + (size_t)n0 * K + sl * klen, K, klen);
        if (MODE == 2) { zero128(acc2); gemm128_core(acc2, lds, A1 + (size_t)MP * K, B1 + (size_t)n0 * K, K, K); }
#pragma unroll
        for (int m = 0; m < 4; ++m) { const int ms = wr * 64 + m * 16 + fr; const size_t row = (size_t)(MP + ms);
#pragma unroll
            for (int n = 0; n < 2; ++n) { const int c = n0 + wc * 32 + n * 16 + 4 * fq; f32x4 v = acc[m][n];
                if (MODE == 0) { *(u32x2*)(Ob + row * INW + c) = (u32x2){pk2(v[0], v[1]), pk2(v[2], v[3])}; }
                else if (MODE == 1) { v = v + *(const f32x4*)(a.b_ff1 + c);
#pragma unroll
                    for (int j = 0; j < 4; ++j) { const float r = fmaxf(v[j], 0.f); v[j] = r * r; }
                    *(u32x2*)(Ob + row * DFF + c) = (u32x2){pk2(v[0], v[1]), pk2(v[2], v[3])}; }
                else if (MODE == 2) {
                    const u32x2 gpw = *(const u32x2*)(proj + row * INW + 4096 + c), gcw = *(const u32x2*)(proj + row * INW + 6144 + c);
                    const float gp[4] = {bflo(gpw.x), bfhi(gpw.x), bflo(gpw.y), bfhi(gpw.y)}, gc[4] = {bflo(gcw.x), bfhi(gcw.x), bflo(gcw.y), bfhi(gcw.y)};
                    float o[4];
#pragma unroll
                    for (int j = 0; j < 4; ++j) o[j] = v[j] / (1.f + __expf(-gp[j])) + acc2[m][n][j] / (1.f + __expf(-gc[j]));
                    *(u32x2*)(Ob + row * D + c) = (u32x2){pk2(o[0], o[1]), pk2(o[2], o[3])}; }
                else { *(f32x4*)(res + ((size_t)sl * NS + ms) * D + c) = v; }
            } }
    }
}

#define XB_TMO      128
#define XB_XCNT(j)  (256  + 64 * (j))
#define XB_XSUB(j)  (1280 + 64 * (j))
#define XB_XGEN(j)  (2304 + 64 * (j))
#define XB_TOP      3328
#define XB_TOPGEN   3392
#define XCD_BAR_WORDS 3456
#define XB_SPIN_CAP (1u << 18)
__device__ __forceinline__ unsigned xb_ld(unsigned* p)              { return __hip_atomic_load(p, __ATOMIC_RELAXED, __HIP_MEMORY_SCOPE_AGENT); }
__device__ __forceinline__ unsigned xb_add(unsigned* p, unsigned v) { return __hip_atomic_fetch_add(p, v, __ATOMIC_RELAXED, __HIP_MEMORY_SCOPE_AGENT); }
__device__ __forceinline__ unsigned xb_xcc_id() { return (unsigned)__builtin_amdgcn_s_getreg((3 << 11) | 20) & 0xFu; }
#define XB_SPIN(cond, bar) do { unsigned _sp = 0; while (cond) { __builtin_amdgcn_s_sleep(1); \
    if ((++_sp & 255u) == 0u) { if (xb_ld(&(bar)[XB_TMO])) break; if (_sp > XB_SPIN_CAP) { atomicAdd(&(bar)[XB_TMO], 1u); break; } } } } while (0)
struct XcdBarrier { unsigned* bar; unsigned x; volatile LAS unsigned* st; };
__device__ __forceinline__ XcdBarrier xcd_barrier_post(unsigned* bar, volatile LAS unsigned* st) {
    XcdBarrier b; b.bar = bar; b.x = xb_xcc_id(); b.st = st;
    if (threadIdx.x == 0) (void)xb_add(&bar[XB_XCNT(b.x)], 1u);
    return b;
}
__device__ __forceinline__ void xcd_barrier_complete(unsigned* bar, unsigned x, unsigned& nloc, unsigned& nx) {
    const unsigned G = gridDim.x * gridDim.y * gridDim.z;
    unsigned sum, cnt, mine, sp = 0u;
    for (;;) {
        sum = 0u; cnt = 0u; mine = 0u;
#pragma unroll
        for (unsigned j = 0; j < 16; ++j) { const unsigned c = xb_ld(&bar[XB_XCNT(j)]); sum += c; cnt += (c > 0u) ? 1u : 0u; mine = (j == x) ? c : mine; }
        if (sum == G) break;
        __builtin_amdgcn_s_sleep(1);
        if ((++sp & 255u) == 0u) { if (xb_ld(&bar[XB_TMO])) break; if (sp > XB_SPIN_CAP) { atomicAdd(&bar[XB_TMO], 1u); break; } }
    }
    nloc = mine > 0u ? mine : 1u; nx = cnt > 0u ? cnt : 1u;
}
__device__ __forceinline__ void xcd_barrier(const XcdBarrier& b) {
    asm volatile("s_waitcnt vmcnt(0)" ::: "memory");
    __syncthreads();
    if (threadIdx.x == 0) {
        unsigned* bar = b.bar;
        __builtin_amdgcn_s_waitcnt(0);
        unsigned nloc = b.st[0], nx = b.st[1];
        if (nloc == 0u) { xcd_barrier_complete(bar, b.x, nloc, nx); b.st[0] = nloc; b.st[1] = nx; }
        const unsigned old = xb_add(&bar[XB_XSUB(b.x)], 1u);
        const unsigned gen = old / nloc;
        if (old + 1u == (gen + 1u) * nloc) {
            __builtin_amdgcn_fence(__ATOMIC_RELEASE, "agent");
            asm volatile("s_waitcnt vmcnt(0)" ::: "memory");
            const unsigned og = xb_add(&bar[XB_TOP], 1u);
            const unsigned tg = og / nx;
            if (og + 1u == (tg + 1u) * nx) xb_add(&bar[XB_TOPGEN], 1u);
            else XB_SPIN(xb_ld(&bar[XB_TOPGEN]) == tg, bar);
            __builtin_amdgcn_fence(__ATOMIC_ACQUIRE, "agent");
            xb_add(&bar[XB_XGEN(b.x)], 1u);
            asm volatile("s_waitcnt vmcnt(0)" ::: "memory");
        } else {
            XB_SPIN(xb_ld(&bar[XB_XGEN(b.x)]) == gen, bar);
            __builtin_amdgcn_fence(__ATOMIC_ACQUIRE, "agent");
            asm volatile("s_waitcnt vmcnt(0)" ::: "memory");
        }
    }
    __syncthreads();
}

__device__ __forceinline__ void p0_all(const Args& a, LAS unsigned char* lds, int tid, int lane, int wave, int bx, int G) {
    unsigned char* ws = a.ws;
    float* ada = (float*)(ws + WS_ADA);
    bf16_t* WinT = (bf16_t*)(ws + WS_WIN); bf16_t* Wff1T = (bf16_t*)(ws + WS_WFF1); bf16_t* Wff2T = (bf16_t*)(ws + WS_WFF2); bf16_t* WoT = (bf16_t*)(ws + WS_WO);
    bf16_t* WupP = (bf16_t*)(ws + WS_WUPP); bf16_t* WupC = (bf16_t*)(ws + WS_WUPC);
    const int gw = bx * 8 + wave, NGW = G * 8;
    for (int it = bx; it < NADA / 48; it += G) p0_ada_item(a, ada, lds, it, wave, lane);
    for (int it = bx; it < 512; it += G) p0_weff_item(a, WupP, lds, it, tid);
    {
        LAS float* scr = (LAS float*)(lds + wave * 16384);
        constexpr int I_IN = (D / 64) * (INW / 32), I_F1 = (D / 64) * (DFF / 32), I_F2 = (DFF / 64) * (D / 32), I_O = (D / 64) * (D / 32), I_C = (CW / 64) * (D / 32);
        constexpr int NIT = I_IN + I_F1 + I_F2 + I_O + I_C;
        for (int it = gw; it < NIT; it += NGW) {
            int r = it;
            if (r < I_IN) { p0_transpose_item(a.w_in, D, INW, WinT, scr, r, lane); continue; } r -= I_IN;
            if (r < I_F1) { p0_transpose_item(a.w_ff1, D, DFF, Wff1T, scr, r, lane); continue; } r -= I_F1;
            if (r < I_F2) { p0_transpose_item(a.w_ff2, DFF, D, Wff2T, scr, r, lane); continue; } r -= I_F2;
            if (r < I_O) { p0_transpose_item(a.w_o, D, D, WoT, scr, r, lane); continue; } r -= I_O;
            p0_transpose_item(a.w_conv_up, CW, D, WupC, scr, r, lane);
        }
    }
}

__global__ void __launch_bounds__(512, 2) fwd_megakernel(Args a) {
    extern __shared__ __attribute__((aligned(16))) unsigned char lds_raw[];
    LAS unsigned char* lds = (LAS unsigned char*)lds_raw;
    const int tid = threadIdx.x, lane = tid & 63, wave = __builtin_amdgcn_readfirstlane(tid >> 6);
    const int G = gridDim.x, bx = blockIdx.x;
    const int gw = bx * 8 + wave, NGW = G * 8;
    unsigned char* ws = a.ws;
    float* ada = (float*)(ws + WS_ADA);
    unsigned* ctr = (unsigned*)(ws + WS_CTL);
    if (tid < 64) ((LAS unsigned*)(lds + MISC_OFF))[tid] = 0u;
    __syncthreads();
    const XcdBarrier xbar = xcd_barrier_post(ctr, (volatile LAS unsigned*)(lds + MISC_OFF));
#define GB() xcd_barrier(xbar)
    bf16_t* WinT = (bf16_t*)(ws + WS_WIN); bf16_t* Wff1T = (bf16_t*)(ws + WS_WFF1); bf16_t* Wff2T = (bf16_t*)(ws + WS_WFF2); bf16_t* WoT = (bf16_t*)(ws + WS_WO);
    bf16_t* WupP = (bf16_t*)(ws + WS_WUPP); bf16_t* WupC = (bf16_t*)(ws + WS_WUPC);
    bf16_t* U = (bf16_t*)(ws + WS_U); bf16_t* PROJ = (bf16_t*)(ws + WS_PROJ); float* RES = (float*)(ws + WS_RES);
    float* PART = (float*)(ws + WS_PART);
    bf16_t* PRE = (bf16_t*)(ws + WS_RES); bf16_t* CIN = (bf16_t*)(ws + WS_RES + WS_CIN_OFF);

    p0_all(a, lds, tid, lane, wave, bx, G);
    GB();
    p1_modulate(a, ada, U, gw, NGW, lane);
    GB();
    { pg8::Order S; S.init(MP, INW, G, bx, 1, U, WinT, U, WinT);
      pg8::EpiBf16<0> E{PROJ, INW, nullptr};
      pg8::gemm_phase(lds, D, S, E); }
    sample_gemm<0>(a, lds, U, WinT, U, WinT, D, INW, PROJ, PROJ, RES, ada);
    GB();
    p3_mixer(a, PROJ, PRE, CIN, tid);
    GB();
    { pg8::Order S; S.init(MP, D, G, bx, 2, PRE, WupP, CIN, WupC);
      pg8::EpiGate E{PROJ, U};
      pg8::gemm_phase(lds, PW, S, E); }
    sample_gemm<2>(a, lds, PRE, WupP, CIN, WupC, PW, D, PROJ, U, RES, ada);
    GB();
    { pg8::Order S; S.init(MP, D, G, bx, 1, U, WoT, U, WoT);
      pg8::EpiRes E{RES, a.x_prompt, ada, 2 * D, nullptr};
      pg8::gemm_phase(lds, D, S, E); }
    sample_gemm<3>(a, lds, U, WoT, U, WoT, D, D, PROJ, U, PART, ada);
    GB();
    p6_ln1(a, ada, RES, PART, U, gw, NGW, lane);
    GB();
    { pg8::Order S; S.init(MP, DFF, G, bx, 1, U, Wff1T, U, Wff1T);
      pg8::EpiBf16<1> E{PROJ, DFF, a.b_ff1};
      pg8::gemm_phase(lds, D, S, E); }
    sample_gemm<1>(a, lds, U, Wff1T, U, Wff1T, D, DFF, PROJ, PROJ, RES, ada);
    GB();
    { pg8::Order S; S.init(MP, D, G, bx, 1, PROJ, Wff2T, PROJ, Wff2T);
      pg8::EpiRes E{RES, RES, ada, 5 * D, a.b_ff2};
      pg8::gemm_phase(lds, DFF, S, E); }
    sample_gemm<4>(a, lds, PROJ, Wff2T, PROJ, Wff2T, DFF, D, PROJ, U, PART, ada);
    GB();
    p9_ln2(a, ada, RES, PART, gw, NGW, lane);
}

extern "C" void kernel_launch(void* const* d_in, const int* in_sizes, int n_in, void* d_out, int out_size, void* d_ws, size_t ws_size, hipStream_t stream) {
    static int grid = 0;
    if (grid == 0) {
        if (n_in != 23 || ws_size < WS_END) { fprintf(stderr, "kernel_launch: expected 23 inputs and >= %zu bytes of workspace; got %d, %zu\n", (size_t)WS_END, n_in, ws_size); grid = -1; return; }
        int dev = 0, cus = 0, per_cu = 0;
        hipGetDevice(&dev);
        hipDeviceGetAttribute(&cus, hipDeviceAttributeMultiprocessorCount, dev);
        if (hipFuncSetAttribute((const void*)fwd_megakernel, hipFuncAttributeMaxDynamicSharedMemorySize, LDS_BYTES) != hipSuccess) { fprintf(stderr, "kernel_launch: hipFuncSetAttribute failed\n"); grid = -1; return; }
        if (hipOccupancyMaxActiveBlocksPerMultiprocessor(&per_cu, (const void*)fwd_megakernel, 512, LDS_BYTES) != hipSuccess || per_cu < 1) { fprintf(stderr, "kernel_launch: occupancy query says %d blocks per CU\n", per_cu); (void)hipGetLastError(); per_cu = 1; }
        grid = cus;
        fprintf(stderr, "kernel_launch: cus %d per_cu %d grid %d\n", cus, per_cu, grid);
    }
    if (grid < 0) return;
    if (hipMemsetAsync((char*)d_ws + WS_CTL, 0, 16384, stream) != hipSuccess) { fprintf(stderr, "kernel_launch: memset failed\n"); return; }
    Args a{};
    const float** ap = (const float**)&a;
    for (int i = 0; i < 23; ++i) ap[i] = (const float*)d_in[i];
    a.out = (float*)d_out; a.ws = (unsigned char*)d_ws;
    void* args[] = {&a};
    hipError_t e = hipLaunchCooperativeKernel((const void*)fwd_megakernel, dim3(grid), dim3(512), args, LDS_BYTES, stream);
    if (e != hipSuccess) fprintf(stderr, "kernel_launch: cooperative launch failed: %s (grid %d)\n", hipGetErrorString(e), grid);
}
```

```cpp
#include <hip/hip_runtime.h>
#include <cstdio>
#include <cstdint>

#define LAS __attribute__((address_space(3)))
typedef unsigned short bf16_t;
typedef short bf16x8 __attribute__((ext_vector_type(8)));
typedef float f32x4 __attribute__((ext_vector_type(4)));
typedef float f32x2 __attribute__((ext_vector_type(2)));
typedef unsigned u32x4 __attribute__((ext_vector_type(4)));
typedef unsigned u32x2 __attribute__((ext_vector_type(2)));

constexpr int D = 2048, NB = 4, SEQ = 2048, NS = 128;
constexpr int MP = NB * SEQ;
constexpr int MV = MP + NS;
constexpr int MPAD = 8448;
constexpr int PW = 1024, CW = 1024, DFF = 8192, INW = 8192, NADA = 6 * D, NCOND = NB + NS;
constexpr float ALPHA = 1.18920711500272f;
constexpr float LN_EPS = 1e-5f;
constexpr int NADAP = 256 * 64;
__device__ __forceinline__ int adac(int n) { return n + 16 * (n / 48); }

constexpr size_t MiB = 1u << 20;
constexpr size_t WS_CTL = 0;
constexpr size_t WS_ADA = 352 * MiB;
constexpr size_t WS_WIN = 8 * MiB, WS_WFF1 = 40 * MiB, WS_WFF2 = 72 * MiB, WS_WO = 104 * MiB, WS_WUPP = 112 * MiB, WS_WUPC = 116 * MiB;
constexpr size_t WS_U = 120 * MiB;
constexpr size_t WS_PROJ = 153 * MiB;
constexpr size_t WS_RES = 285 * MiB;
constexpr size_t WS_PART = 362 * MiB;
constexpr size_t WS_END = 378 * MiB;
constexpr size_t WS_CIN_OFF = (size_t)MPAD * 1024 * 2;

constexpr size_t O_YP = 0, O_YS = (size_t)MP * D, O_NPP = O_YS + (size_t)NS * D, O_NCP = O_NPP + (size_t)NB * 15 * PW, O_NPS = O_NCP + (size_t)NB * 2 * CW, O_NCS = O_NPS + (size_t)NS * 15 * PW;

constexpr int LDS_BYTES = 131072 + 256, MISC_OFF = 131072;

__device__ __forceinline__ unsigned f2bf(float f) { unsigned u = __builtin_bit_cast(unsigned, f); return (u + 0x7fffu + ((u >> 16) & 1u)) >> 16; }
__device__ __forceinline__ unsigned pk2(float lo, float hi) { return f2bf(lo) | (f2bf(hi) << 16); }
__device__ __forceinline__ unsigned cvt_pk_bf16(float lo, float hi) { unsigned r; asm volatile("v_cvt_pk_bf16_f32 %0, %1, %2" : "=v"(r) : "v"(lo), "v"(hi)); return r; }
__device__ __forceinline__ float bflo(unsigned w) { return __builtin_bit_cast(float, w << 16); }
__device__ __forceinline__ float bfhi(unsigned w) { return __builtin_bit_cast(float, w & 0xffff0000u); }
__device__ __forceinline__ int cond_row(int r) { int s = r - MP; s = s < 0 ? 0 : (s > NS - 1 ? NS - 1 : s); return r < MP ? (r >> 11) : NB + s; }
__device__ __forceinline__ const float* x_rowp(const float* xp, const float* xs, int r) { int s = r - MP; s = s < 0 ? 0 : (s > NS - 1 ? NS - 1 : s); return r < MP ? xp + (size_t)r * D : xs + (size_t)s * D; }

namespace pg8 {
constexpr int BM = 256, BK = 64, HALF = 128, HTB = HALF * BK * 2, NXCD = 8, WGM = 8;
__device__ __forceinline__ int lds_byte(int r, int c) { const int st = (r >> 4) * 2 + (c >> 5), rr = r & 15, cc = c & 31, ob = rr * 64 + cc * 2; return st * 1024 + (ob ^ (((ob >> 9) & 1) << 5)); }
__device__ __forceinline__ void stage_rc(int b, int& R, int& C) { const int st = b / 1024, sb = b % 1024, swz = sb ^ (((sb >> 9) & 1) << 5); R = (st >> 1) * 16 + swz / 64; C = (st & 1) * 32 + (swz % 64) / 2; }
__device__ __forceinline__ int perm32(int rho) { const int n = rho >> 4, i = rho & 15; return 8 * (i >> 2) + 4 * n + (i & 3); }

struct Unit { int pm, pn, grp; };
struct Order {
    int nM, nN, nwg, G, c, rep;
    const char* A0; const char* B0; const char* A1; const char* B1;
    __device__ __forceinline__ void init(int M, int N, int G_, int c_, int rep_, const void* a0, const void* b0, const void* a1, const void* b1) {
        nM = M / BM; nN = N / BM; nwg = nM * nN; G = G_; c = c_; rep = rep_; A0 = (const char*)a0; B0 = (const char*)b0; A1 = (const char*)a1; B1 = (const char*)b1; }
    __device__ __forceinline__ bool next(int i, Unit& u) const {
        const int ti = (rep == 2) ? (i >> 1) : i; u.grp = (rep == 2) ? (i & 1) : 0;
        const long L = (long)ti * G + c; if (L >= nwg) return false;
        int wgid = (int)L; { const int q = nwg / NXCD, r = nwg % NXCD, xcd = wgid % NXCD, off = wgid / NXCD; wgid = (xcd < r ? xcd * (q + 1) : r * (q + 1) + (xcd - r) * q) + off; }
        const int nig = WGM * nN, gid = wgid / nig, fm = gid * WGM, gsz = (nM - fm) < WGM ? (nM - fm) : WGM;
        u.pm = fm + ((wgid % nig) % gsz); u.pn = (wgid % nig) / gsz; return true;
    }
    __device__ __forceinline__ const char* baseA(const Unit& u, size_t tstep) const { return (u.grp ? A1 : A0) + (size_t)u.pm * tstep; }
    __device__ __forceinline__ const char* baseB(const Unit& u, size_t tstep) const { return (u.grp ? B1 : B0) + (size_t)u.pn * tstep; }
};

typedef f32x4 Acc[2][2][4][2];

template <int ACT> struct EpiBf16 {
    static constexpr bool PERM = true;
    bf16_t* O; int ldc; const float* bias;
    __device__ __forceinline__ bool keep(const Unit&) const { return false; }
    __device__ __forceinline__ void operator()(Acc& acc, const Unit& u, int wr, int wc, int fr, int fq) const {
        const int row0 = u.pm * BM + wr * 64 + fr, col0 = u.pn * BM + wc * 32 + 8 * fq;
        f32x4 bv[2][2];
#pragma unroll
        for (int bj = 0; bj < 2; ++bj)
#pragma unroll
            for (int n = 0; n < 2; ++n) bv[bj][n] = bias ? *(const f32x4*)(bias + col0 + bj * HALF + 4 * n) : (f32x4){0.f, 0.f, 0.f, 0.f};
#pragma unroll
        for (int ai = 0; ai < 2; ++ai)
#pragma unroll
            for (int m = 0; m < 4; ++m) { bf16_t* rowp = O + (size_t)(row0 + ai * HALF + m * 16) * ldc + col0;
#pragma unroll
                for (int bj = 0; bj < 2; ++bj) { f32x4 v0 = acc[ai][bj][m][0] + bv[bj][0], v1 = acc[ai][bj][m][1] + bv[bj][1];
                    if (ACT == 1) {
#pragma unroll
                        for (int j = 0; j < 4; ++j) { const float a = fmaxf(v0[j], 0.f), b = fmaxf(v1[j], 0.f); v0[j] = a * a; v1[j] = b * b; } }
                    u32x4 w; w.x = cvt_pk_bf16(v0[0], v0[1]); w.y = cvt_pk_bf16(v0[2], v0[3]); w.z = cvt_pk_bf16(v1[0], v1[1]); w.w = cvt_pk_bf16(v1[2], v1[3]);
                    *(u32x4*)(rowp + bj * HALF) = w; } }
    }
};
__device__ __forceinline__ void unpack8(const u32x4 w, float (&e)[8]) { e[0] = bflo(w.x); e[1] = bfhi(w.x); e[2] = bflo(w.y); e[3] = bfhi(w.y); e[4] = bflo(w.z); e[5] = bfhi(w.z); e[6] = bflo(w.w); e[7] = bfhi(w.w); }
struct EpiGate {
    static constexpr bool PERM = true;
    const bf16_t* proj; bf16_t* O;
    __device__ __forceinline__ bool keep(const Unit& u) const { return u.grp == 0; }
    __device__ __forceinline__ void operator()(Acc& acc, const Unit& u, int wr, int wc, int fr, int fq) const {
        const int row0 = u.pm * BM + wr * 64 + fr, col0 = u.pn * BM + wc * 32 + 8 * fq;
        const bool g0 = (u.grp == 0);
        u32x4 gcw[2], gpw[2];
        { const bf16_t* p = proj + (size_t)row0 * INW + col0; gcw[0] = *(const u32x4*)(p + 6144); gpw[0] = g0 ? *(const u32x4*)(p + 4096) : gcw[0]; }
#pragma unroll
        for (int it = 0; it < 16; ++it) { const int ai = it >> 3, m = (it >> 1) & 3, bj = it & 1;
            const size_t row = (size_t)(row0 + ai * HALF + m * 16); const int col = col0 + bj * HALF;
            if (it < 15) { const int ai2 = (it + 1) >> 3, m2 = ((it + 1) >> 1) & 3, bj2 = (it + 1) & 1;
                const bf16_t* p = proj + (size_t)(row0 + ai2 * HALF + m2 * 16) * INW + col0 + bj2 * HALF;
                gcw[(it + 1) & 1] = *(const u32x4*)(p + 6144); gpw[(it + 1) & 1] = g0 ? *(const u32x4*)(p + 4096) : gcw[(it + 1) & 1]; }
            float ec[8]; unpack8(gcw[it & 1], ec);
#pragma unroll
            for (int j = 0; j < 8; ++j) ec[j] = 1.f + __expf(-fmaxf(ec[j], -30.f));
            if (g0) {
                float ep[8]; unpack8(gpw[it & 1], ep);
#pragma unroll
                for (int j = 0; j < 8; ++j) ep[j] = ec[j] * __builtin_amdgcn_rcpf(1.f + __expf(-ep[j]));
#pragma unroll
                for (int j = 0; j < 4; ++j) { acc[ai][bj][m][0][j] *= ep[j]; acc[ai][bj][m][1][j] *= ep[4 + j]; }
            } else {
                f32x4 v0, v1;
#pragma unroll
                for (int j = 0; j < 4; ++j) { v0[j] = acc[ai][bj][m][0][j] * __builtin_amdgcn_rcpf(ec[j]); v1[j] = acc[ai][bj][m][1][j] * __builtin_amdgcn_rcpf(ec[4 + j]); }
                u32x4 w; w.x = cvt_pk_bf16(v0[0], v0[1]); w.y = cvt_pk_bf16(v0[2], v0[3]); w.z = cvt_pk_bf16(v1[0], v1[1]); w.w = cvt_pk_bf16(v1[2], v1[3]);
                *(u32x4*)(O + row * D + col) = w;
            } }
    }
};
struct EpiRes {
    static constexpr bool PERM = false;
    float* res; const float* base; const float* ada; int gate_off; const float* bias;
    __device__ __forceinline__ bool keep(const Unit&) const { return false; }
    __device__ __forceinline__ void operator()(Acc& acc, const Unit& u, int wr, int wc, int fr, int fq) const {
        const int row0 = u.pm * BM + wr * 64 + fr, col0 = u.pn * BM + wc * 32 + 4 * fq;
        const float* gp = ada + (size_t)(u.pm >> 3) * NADAP;
        f32x4 bv[2][2], gv[2][2], xb[2][2][2];
#pragma unroll
        for (int bj = 0; bj < 2; ++bj)
#pragma unroll
            for (int n = 0; n < 2; ++n) { bv[bj][n] = bias ? *(const f32x4*)(bias + col0 + bj * HALF + n * 16) : (f32x4){0.f, 0.f, 0.f, 0.f}; gv[bj][n] = *(const f32x4*)(gp + adac(gate_off + col0 + bj * HALF + n * 16)); }
#pragma unroll
        for (int bj = 0; bj < 2; ++bj)
#pragma unroll
            for (int n = 0; n < 2; ++n) xb[0][bj][n] = *(const f32x4*)(base + (size_t)row0 * D + col0 + bj * HALF + n * 16);
#pragma unroll
        for (int it = 0; it < 8; ++it) { const int ai = it >> 2, m = it & 3;
            if (it < 7) { const float* bp = base + (size_t)(row0 + ((it + 1) >> 2) * HALF + ((it + 1) & 3) * 16) * D + col0;
#pragma unroll
                for (int bj = 0; bj < 2; ++bj)
#pragma unroll
                    for (int n = 0; n < 2; ++n) xb[(it + 1) & 1][bj][n] = *(const f32x4*)(bp + bj * HALF + n * 16); }
            float* rp = res + (size_t)(row0 + ai * HALF + m * 16) * D + col0;
#pragma unroll
            for (int bj = 0; bj < 2; ++bj)
#pragma unroll
                for (int n = 0; n < 2; ++n) *(f32x4*)(rp + bj * HALF + n * 16) = xb[it & 1][bj][n] * ALPHA + gv[bj][n] * (acc[ai][bj][m][n] + bv[bj][n]); }
    }
};

template <class Epi>
__device__ __forceinline__ void gemm_phase(LAS unsigned char* lds, const int K, const Order& S, const Epi& E) {
    const int tid = threadIdx.x, wid = __builtin_amdgcn_readfirstlane(tid >> 6), lane = tid & 63, wr = wid >> 2, wc = wid & 3, fr = lane & 15, fq = lane >> 4;
    const int nt = K / BK;
    unsigned voffA[2], voffB[2];
#pragma unroll
    for (int i = 0; i < 2; ++i) { int R, C; stage_rc(tid * 16 + i * 8192, R, C); const int Rb = Epi::PERM ? ((R & ~31) + perm32(R & 31)) : R;
        voffA[i] = (unsigned)(R * K + C) * 2u; voffB[i] = (unsigned)(Rb * K + C) * 2u; }
    const size_t kstep = (size_t)(BK * 2);
    const size_t hstep = (size_t)HALF * K * 2;
    const size_t tstep = 2 * hstep;
    const unsigned ldsw = (unsigned)wid * 1024u;
    const int aoff = lds_byte(wr * 64 + fr, fq * 8), boff = lds_byte(wc * 32 + fr, fq * 8);
#define PG8_SA(b, h) (((b) * 2 + (h)) * HTB)
#define PG8_SB(b, h) ((4 + (b) * 2 + (h)) * HTB)
#define PG8_STAGE(bufoff, gbase, voff) do { _Pragma("unroll") for (int _i = 0; _i < 2; ++_i) \
        __builtin_amdgcn_global_load_lds((const unsigned*)((const char*)(gbase) + (voff)[_i]), (LAS unsigned*)(lds + (bufoff) + ldsw + _i * 8192), 16, 0, 0); } while (0)
#define PG8_LDA(dst, b, h) do { _Pragma("unroll") for (int m = 0; m < 4; ++m) _Pragma("unroll") for (int k = 0; k < 2; ++k) dst[m][k] = *(const LAS bf16x8*)(lds + PG8_SA(b, h) + aoff + m * 2048 + k * 1024); } while (0)
#define PG8_LDB(dst, b, h) do { _Pragma("unroll") for (int n = 0; n < 2; ++n) _Pragma("unroll") for (int k = 0; k < 2; ++k) dst[n][k] = *(const LAS bf16x8*)(lds + PG8_SB(b, h) + boff + n * 2048 + k * 1024); } while (0)
#define PG8_MMA(ai, bj, At, Bt) do { __builtin_amdgcn_s_setprio(1); _Pragma("unroll") for (int m = 0; m < 4; ++m) _Pragma("unroll") for (int n = 0; n < 2; ++n) _Pragma("unroll") for (int k = 0; k < 2; ++k) \
        acc[ai][bj][m][n] = __builtin_amdgcn_mfma_f32_16x16x32_bf16(Bt[n][k], At[m][k], acc[ai][bj][m][n], 0, 0, 0); __builtin_amdgcn_s_setprio(0); } while (0)
#define PG8_WAIT_V(n) asm volatile("s_waitcnt vmcnt(" #n ")" ::: "memory")
#define PG8_WAIT_L(n) asm volatile("s_waitcnt lgkmcnt(" #n ")" ::: "memory")
#define PG8_BAR __builtin_amdgcn_s_barrier()
#define PG8_SCHED __builtin_amdgcn_sched_barrier(0)
    Unit cur, nxt; int ui = 0;
    if (!S.next(0, cur)) return;
    Acc acc;
#pragma unroll
    for (int a = 0; a < 2; ++a)
#pragma unroll
        for (int b = 0; b < 2; ++b)
#pragma unroll
            for (int m = 0; m < 4; ++m)
#pragma unroll
                for (int n = 0; n < 2; ++n) acc[a][b][m][n] = (f32x4){0.f, 0.f, 0.f, 0.f};
    bf16x8 At[4][2], B0[2][2], B1[2][2];
    const char* cA = S.baseA(cur, tstep); const char* cB = S.baseB(cur, tstep);
    PG8_STAGE(PG8_SB(0, 0), cB, voffB); PG8_STAGE(PG8_SB(0, 1), cB + hstep, voffB); PG8_STAGE(PG8_SA(0, 0), cA, voffA); PG8_STAGE(PG8_SA(0, 1), cA + hstep, voffA);
    if (wr == 1) PG8_BAR;
    PG8_WAIT_V(2); PG8_BAR;
    PG8_STAGE(PG8_SB(1, 0), cB + kstep, voffB); PG8_STAGE(PG8_SA(1, 0), cA + kstep, voffA); PG8_STAGE(PG8_SB(1, 1), cB + hstep + kstep, voffB);
    PG8_WAIT_V(6); PG8_BAR;
    for (;;) {
        const bool has_next = S.next(ui + 1, nxt);
        const char* nA = has_next ? S.baseA(nxt, tstep) : cA; const char* nB = has_next ? S.baseB(nxt, tstep) : cB;
        for (int t = 0; t < nt; t += 2) {
            const bool last = (t == nt - 2);
            const char* a1 = cA + (size_t)(t + 1) * kstep;
            const char* a2 = last ? nA : cA + (size_t)(t + 2) * kstep; const char* b2 = last ? nB : cB + (size_t)(t + 2) * kstep;
            const char* a3 = a2 + kstep; const char* b3 = b2 + kstep;
            PG8_LDB(B0, 0, 0); PG8_LDB(B1, 0, 1); PG8_SCHED; PG8_LDA(At, 0, 0); PG8_STAGE(PG8_SA(1, 1), a1 + hstep, voffA);
            PG8_WAIT_V(8); PG8_WAIT_L(0); PG8_BAR; PG8_MMA(0, 0, At, B0); PG8_MMA(0, 1, At, B1); PG8_BAR; PG8_SCHED;
            PG8_LDA(At, 0, 1); PG8_STAGE(PG8_SB(0, 0), b2, voffB); PG8_STAGE(PG8_SB(0, 1), b2 + hstep, voffB); PG8_STAGE(PG8_SA(0, 0), a2, voffA);
            PG8_WAIT_V(8); PG8_WAIT_L(0); PG8_BAR; PG8_MMA(1, 0, At, B0); PG8_MMA(1, 1, At, B1); PG8_BAR; PG8_SCHED;
            PG8_LDB(B0, 1, 0); PG8_LDB(B1, 1, 1); PG8_SCHED; PG8_LDA(At, 1, 0); PG8_STAGE(PG8_SA(0, 1), a2 + hstep, voffA);
            PG8_WAIT_V(8); PG8_WAIT_L(0); PG8_BAR; PG8_MMA(0, 0, At, B0); PG8_MMA(0, 1, At, B1); PG8_BAR; PG8_SCHED;
            PG8_LDA(At, 1, 1); PG8_STAGE(PG8_SB(1, 0), b3, voffB); PG8_STAGE(PG8_SB(1, 1), b3 + hstep, voffB); PG8_STAGE(PG8_SA(1, 0), a3, voffA);
            PG8_WAIT_V(8); PG8_WAIT_L(0); PG8_BAR; PG8_MMA(1, 0, At, B0); PG8_MMA(1, 1, At, B1); PG8_BAR; PG8_SCHED;
        }
        if (wr == 0) PG8_BAR;
        E(acc, cur, wr, wc, fr, fq);
        if (!has_next) break;
        if (!E.keep(cur)) {
#pragma unroll
            for (int a = 0; a < 2; ++a)
#pragma unroll
                for (int b = 0; b < 2; ++b)
#pragma unroll
                    for (int m = 0; m < 4; ++m)
#pragma unroll
                        for (int n = 0; n < 2; ++n) acc[a][b][m][n] = (f32x4){0.f, 0.f, 0.f, 0.f};
        }
        cur = nxt; cA = nA; cB = nB; ++ui;
        if (wr == 1) PG8_BAR;
    }
    PG8_WAIT_V(0);
    PG8_BAR;
#undef PG8_SA
#undef PG8_SB
#undef PG8_STAGE
#undef PG8_LDA
#undef PG8_LDB
#undef PG8_MMA
#undef PG8_WAIT_V
#undef PG8_WAIT_L
#undef PG8_BAR
#undef PG8_SCHED
}
}

struct Args {
    const float *x_prompt, *x_sample, *state_pool, *state_conv, *c_prompt, *c_sample, *w_ada, *b_ada, *w_in, *pool_grp_w, *pool_scale, *conv_w, *w_pool_up, *w_conv_up, *w_o,
        *ln1_g, *ln1_b, *w_ff1, *b_ff1, *w_ff2, *b_ff2, *ln2_g, *ln2_b;
    float* out; unsigned char* ws;
};

__device__ __forceinline__ float wave_sum(float v) {
#pragma unroll
    for (int o = 1; o < 64; o <<= 1) v += __shfl_xor(v, o);
    return v;
}

__device__ __forceinline__ void p0_transpose_item(const float* W, int K, int N, bf16_t* WT, LAS float* scr, int item, int lane) {
    const int nblk = N / 32, kb = item / nblk, nb = item % nblk, k0 = 64 * kb, n0 = 32 * nb;
    f32x4 v[8];
#pragma unroll
    for (int i = 0; i < 8; ++i) v[i] = __builtin_nontemporal_load((const f32x4*)(W + (size_t)(k0 + 8 * i + (lane >> 3)) * N + n0 + 4 * (lane & 7)));
#pragma unroll
    for (int i = 0; i < 8; ++i) { LAS float* d = scr + (8 * i + (lane >> 3)) * 33 + 4 * (lane & 7); d[0] = v[i][0]; d[1] = v[i][1]; d[2] = v[i][2]; d[3] = v[i][3]; }
    asm volatile("s_waitcnt lgkmcnt(0)" ::: "memory");
    const int c = lane & 7;
#pragma unroll
    for (int j = 0; j < 4; ++j) { const int n = (lane >> 3) + 8 * j; const LAS float* s = scr + (8 * c) * 33 + n;
        u32x4 o; o.x = pk2(s[0 * 33], s[1 * 33]); o.y = pk2(s[2 * 33], s[3 * 33]); o.z = pk2(s[4 * 33], s[5 * 33]); o.w = pk2(s[6 * 33], s[7 * 33]);
        *(u32x4*)(WT + (size_t)(n0 + n) * K + k0 + 8 * c) = o; }
    asm volatile("s_waitcnt lgkmcnt(0)" ::: "memory");
}

__device__ __forceinline__ void p0_ada_item(const Args& a, float* ada, LAS unsigned char* lds, int item, int wave, int lane) {
    const int n0 = item * 48, fr = lane & 15, kq = lane >> 4;
    f32x4 acc[9][3];
#pragma unroll
    for (int mt = 0; mt < 9; ++mt)
#pragma unroll
        for (int q = 0; q < 3; ++q) acc[mt][q] = (f32x4){0.f, 0.f, 0.f, 0.f};
    const float* const cr0 = fr < NB ? a.c_prompt + (size_t)fr * D : a.c_sample + (size_t)(fr - NB) * D;
    const float* const crm = a.c_sample + (size_t)(fr + 12) * D;
    const float* const cr8 = a.c_sample + (size_t)(124 + fr > NS - 1 ? NS - 1 : 124 + fr) * D;
#pragma unroll 2
    for (int ks = 0; ks < 8; ++ks) {
        const int k0 = wave * 256 + ks * 32 + kq * 8;
        float b[8][3];
#pragma unroll
        for (int j = 0; j < 8; ++j) { const float* p = a.w_ada + (size_t)(k0 + j) * NADA + n0 + 3 * fr; b[j][0] = __builtin_nontemporal_load(p); b[j][1] = __builtin_nontemporal_load(p + 1); b[j][2] = __builtin_nontemporal_load(p + 2); }
        bf16x8 bfr[3];
#pragma unroll
        for (int q = 0; q < 3; ++q) { u32x4 w; w.x = pk2(b[0][q], b[1][q]); w.y = pk2(b[2][q], b[3][q]); w.z = pk2(b[4][q], b[5][q]); w.w = pk2(b[6][q], b[7][q]); bfr[q] = __builtin_bit_cast(bf16x8, w); }
#pragma unroll
        for (int mt = 0; mt < 9; ++mt) {
            const float* cp = (mt == 0) ? cr0 : (mt == 8 ? cr8 : crm + (size_t)(mt - 1) * 16 * D);
            const f32x4 a0 = *(const f32x4*)(cp + k0), a1 = *(const f32x4*)(cp + k0 + 4);
            u32x4 w; w.x = pk2(a0[0], a0[1]); w.y = pk2(a0[2], a0[3]); w.z = pk2(a1[0], a1[1]); w.w = pk2(a1[2], a1[3]);
            const bf16x8 af = __builtin_bit_cast(bf16x8, w);
#pragma unroll
            for (int q = 0; q < 3; ++q) acc[mt][q] = __builtin_amdgcn_mfma_f32_16x16x32_bf16(af, bfr[q], acc[mt][q], 0, 0, 0);
            if (mt % 3 == 2) asm volatile("" ::: "memory");
        }
    }
    LAS float* red = (LAS float*)lds;
#pragma unroll
    for (int s = 4; s >= 1; s >>= 1) {
        if (wave >= s && wave < 2 * s) { LAS float* dst = red + (wave - s) * 6912 + lane;
#pragma unroll
            for (int mt = 0; mt < 9; ++mt)
#pragma unroll
                for (int q = 0; q < 3; ++q)
#pragma unroll
                    for (int j = 0; j < 4; ++j) dst[((mt * 3 + q) * 4 + j) * 64] = acc[mt][q][j]; }
        __syncthreads();
        if (wave < s) { const LAS float* src = red + wave * 6912 + lane;
#pragma unroll
            for (int mt = 0; mt < 9; ++mt)
#pragma unroll
                for (int q = 0; q < 3; ++q)
#pragma unroll
                    for (int j = 0; j < 4; ++j) acc[mt][q][j] += src[((mt * 3 + q) * 4 + j) * 64]; }
        __syncthreads();
    }
    if (wave == 0) {
#pragma unroll
        for (int q = 0; q < 3; ++q) { const int n = n0 + 3 * fr + q; const float bb = a.b_ada[n];
#pragma unroll
            for (int mt = 0; mt < 9; ++mt)
#pragma unroll
                for (int j = 0; j < 4; ++j) { const int r = mt * 16 + kq * 4 + j; if (r < NCOND) ada[(size_t)r * NADAP + item * 64 + 3 * fr + q] = acc[mt][q][j] + bb; } }
    }
}

__device__ __forceinline__ void p0_weff_item(const Args& a, bf16_t* WT, LAS unsigned char* lds, int item, int tid) {
    constexpr int AP = 260, BP = 80;
    const int g = item >> 7, it = (item >> 5) & 3, nt = item & 31, i0 = it * 64, n0 = nt * 64;
    LAS float* As = (LAS float*)lds;
    LAS float* Bs = (LAS float*)(lds + 66560);
#pragma unroll
    for (int r = 0; r < 8; ++r) { const int idx = tid + r * 512, row = idx >> 6, c4 = idx & 63;
        *(LAS f32x4*)(As + row * AP + c4 * 4) = *(const f32x4*)(a.pool_grp_w + ((size_t)(g * 256 + i0 + row)) * 256 + c4 * 4); }
    const int lane = tid & 63, wave = tid >> 6, fr = lane & 15, kq = lane >> 4, mt = wave >> 1, np = (wave & 1) * 2;
    f32x4 acc[2] = {(f32x4){0.f, 0.f, 0.f, 0.f}, (f32x4){0.f, 0.f, 0.f, 0.f}};
#pragma unroll 1
    for (int h = 0; h < 2; ++h) {
        __syncthreads();
#pragma unroll
        for (int r = 0; r < 4; ++r) { const int idx = tid + r * 512, o = idx >> 4, c4 = idx & 15;
            const float sc = a.pool_scale[g * 256 + h * 128 + o];
            *(LAS f32x4*)(Bs + o * BP + c4 * 4) = *(const f32x4*)(a.w_pool_up + (size_t)(g * 256 + h * 128 + o) * D + n0 + c4 * 4) * sc; }
        __syncthreads();
#pragma unroll 8
        for (int o4 = 0; o4 < 32; ++o4) {
            const float av = As[(mt * 16 + fr) * AP + h * 128 + o4 * 4 + kq];
            const float b0 = Bs[(o4 * 4 + kq) * BP + np * 16 + fr], b1 = Bs[(o4 * 4 + kq) * BP + np * 16 + 16 + fr];
            acc[0] = __builtin_amdgcn_mfma_f32_16x16x4f32(av, b0, acc[0], 0, 0, 0);
            acc[1] = __builtin_amdgcn_mfma_f32_16x16x4f32(av, b1, acc[1], 0, 0, 0);
        }
    }
#pragma unroll
    for (int t = 0; t < 2; ++t)
        *(u32x2*)(WT + (size_t)(n0 + (np + t) * 16 + fr) * PW + g * 256 + i0 + mt * 16 + kq * 4) = (u32x2){pk2(acc[t][0], acc[t][1]), pk2(acc[t][2], acc[t][3])};
    __syncthreads();
}

__device__ __forceinline__ void p1_modulate(const Args& a, const float* ada, bf16_t* U, int gw, int NGW, int lane) {
    if (NGW >= 2 * 8 * NS && (gw & 1) == 0 && (gw >> 1) < 8 * NS) {
        const int r = MP + (gw >> 4), c = ((gw >> 1) & 7) * 256 + 4 * lane;
        const float* ar = ada + (size_t)cond_row(r) * NADAP;
        const f32x4 v = *(const f32x4*)(a.x_sample + (size_t)(r - MP) * D + c) * (*(const f32x4*)(ar + adac(D + c)) + 1.f) + *(const f32x4*)(ar + adac(c));
        *(u32x2*)(U + (size_t)r * D + c) = (u32x2){pk2(v[0], v[1]), pk2(v[2], v[3])};
    }
    for (int r = gw; r < (NGW >= 2 * 8 * NS ? MP : MV); r += NGW) {
        u32x2* o8 = (u32x2*)(U + (size_t)r * D) + lane;
        const f32x4* xr = (const f32x4*)x_rowp(a.x_prompt, a.x_sample, r) + lane;
        const float* ar = ada + (size_t)cond_row(r) * NADAP;
#pragma unroll
        for (int j = 0; j < 8; ++j) { const int c = 4 * (lane + 64 * j); const f32x4 v = __builtin_nontemporal_load(xr + 64 * j) * (*(const f32x4*)(ar + adac(D + c)) + 1.f) + *(const f32x4*)(ar + adac(c));
            o8[64 * j] = (u32x2){pk2(v[0], v[1]), pk2(v[2], v[3])}; }
    }
}

__device__ __forceinline__ void p3_mixer(const Args& a, const bf16_t* proj, bf16_t* PRE, bf16_t* CIN, int tid) {
    const int j0 = 2 * tid, wave = tid >> 6, W = 2 << (wave >> 1);
    const f32x2 cw0 = *(const f32x2*)(a.conv_w + j0), cw1 = *(const f32x2*)(a.conv_w + CW + j0), cw2 = *(const f32x2*)(a.conv_w + 2 * CW + j0);
    float* const npp = a.out + O_NPP; float* const ncp = a.out + O_NCP; float* const nps = a.out + O_NPS; float* const ncs = a.out + O_NCS;
    for (int it = blockIdx.x; it < 384; it += gridDim.x) {
        if (it < 256) {
            const int b = it >> 6, s0 = (it & 63) * 32;
            const bf16_t* pb = proj + (size_t)(b * SEQ) * INW + j0;
            float S0 = 0.f, S1 = 0.f;
            for (int i = 1; i < W; ++i) { const int s = s0 - i; if (s >= 0) { const unsigned w = *(const unsigned*)(pb + (size_t)s * INW); S0 += bflo(w); S1 += bfhi(w); } }
            float v1a = 0.f, v1b = 0.f, v2a = 0.f, v2b = 0.f;
            if (s0 >= 1) { const bf16_t* p = pb + (size_t)(s0 - 1) * INW; const unsigned wx = *(const unsigned*)(p + 1024), wc = *(const unsigned*)(p + 3072); v1a = bflo(wc) * bflo(wx); v1b = bfhi(wc) * bfhi(wx); }
            if (s0 >= 2) { const bf16_t* p = pb + (size_t)(s0 - 2) * INW; const unsigned wx = *(const unsigned*)(p + 1024), wc = *(const unsigned*)(p + 3072); v2a = bflo(wc) * bflo(wx); v2b = bfhi(wc) * bfhi(wx); }
#pragma unroll 4
            for (int s = s0; s < s0 + 32; ++s) {
                const bf16_t* p = pb + (size_t)s * INW;
                const unsigned wz = *(const unsigned*)p, wx = *(const unsigned*)(p + 1024), wb = *(const unsigned*)(p + 2048), wc = *(const unsigned*)(p + 3072);
                const float z0 = bflo(wz), z1 = bfhi(wz);
                S0 += z0; S1 += z1;
                const int cnt = (s + 1 < W) ? s + 1 : W; const float fc = (float)cnt;
                const float p0 = S0 / fc - z0, p1 = S1 / fc - z1;
                const int so = s - W + 1;
                if (so >= 0) { const unsigned wo = *(const unsigned*)(pb + (size_t)so * INW); S0 -= bflo(wo); S1 -= bfhi(wo); }
                const float va = bflo(wc) * bflo(wx), vb = bfhi(wc) * bfhi(wx);
                const float ya = cw0[0] * v2a + cw1[0] * v1a + cw2[0] * va, yb = cw0[1] * v2b + cw1[1] * v1b + cw2[1] * vb;
                const size_t row = (size_t)(b * SEQ + s);
                *(unsigned*)(PRE + row * PW + j0) = pk2(p0, p1);
                *(unsigned*)(CIN + row * CW + j0) = pk2(bflo(wb) * ya, bfhi(wb) * yb);
                if (s >= SEQ - 15) *(f32x2*)(npp + ((size_t)(b * 15 + s - (SEQ - 15))) * PW + j0) = (f32x2){z0, z1};
                if (s >= SEQ - 2) *(f32x2*)(ncp + ((size_t)(b * 2 + s - (SEQ - 2))) * CW + j0) = (f32x2){va, vb};
                v2a = v1a; v2b = v1b; v1a = va; v1b = vb;
            }
        } else {
            const int b = it - 256; const size_t row = (size_t)(MP + b);
            const bf16_t* p = proj + row * INW + j0;
            const unsigned wz = *(const unsigned*)p, wx = *(const unsigned*)(p + 1024), wb = *(const unsigned*)(p + 2048), wc = *(const unsigned*)(p + 3072);
            const float z0 = bflo(wz), z1 = bfhi(wz);
            const float* sp = a.state_pool + (size_t)b * 15 * PW + j0;
            float S0 = z0, S1 = z1;
            for (int i = 1; i < W; ++i) { const f32x2 h = *(const f32x2*)(sp + (size_t)(15 - i) * PW); S0 += h[0]; S1 += h[1]; }
            const float fc = (float)W;
            *(unsigned*)(PRE + row * PW + j0) = pk2(S0 / fc - z0, S1 / fc - z1);
            const f32x2 h0 = *(const f32x2*)(a.state_conv + (size_t)(b * 2) * CW + j0), h1 = *(const f32x2*)(a.state_conv + (size_t)(b * 2 + 1) * CW + j0);
            const float va = bflo(wc) * bflo(wx), vb = bfhi(wc) * bfhi(wx);
            const float ya = cw0[0] * h0[0] + cw1[0] * h1[0] + cw2[0] * va, yb = cw0[1] * h0[1] + cw1[1] * h1[1] + cw2[1] * vb;
            *(unsigned*)(CIN + row * CW + j0) = pk2(bflo(wb) * ya, bfhi(wb) * yb);
#pragma unroll
            for (int r = 0; r < 14; ++r) *(f32x2*)(nps + ((size_t)(b * 15 + r)) * PW + j0) = *(const f32x2*)(sp + (size_t)(r + 1) * PW);
            *(f32x2*)(nps + ((size_t)(b * 15 + 14)) * PW + j0) = (f32x2){z0, z1};
            *(f32x2*)(ncs + ((size_t)(b * 2)) * CW + j0) = h1;
            *(f32x2*)(ncs + ((size_t)(b * 2 + 1)) * CW + j0) = (f32x2){va, vb};
        }
    }
}

__device__ __forceinline__ void ln_row(f32x4 (&v)[8], const float* g, const float* b, int lane) {
    float s = 0.f;
#pragma unroll
    for (int j = 0; j < 8; ++j) s += (v[j][0] + v[j][1]) + (v[j][2] + v[j][3]);
    const float mean = wave_sum(s) * (1.f / D); float s2 = 0.f;
#pragma unroll
    for (int j = 0; j < 8; ++j) { v[j] = v[j] - mean; s2 += (v[j][0] * v[j][0] + v[j][1] * v[j][1]) + (v[j][2] * v[j][2] + v[j][3] * v[j][3]); }
    const float rstd = 1.f / sqrtf(wave_sum(s2) * (1.f / D) + LN_EPS);
    const f32x4* g4 = (const f32x4*)g + lane; const f32x4* b4 = (const f32x4*)b + lane;
#pragma unroll
    for (int j = 0; j < 8; ++j) v[j] = v[j] * rstd * g4[64 * j] + b4[64 * j];
}
__device__ __forceinline__ void p6_ln1(const Args& a, const float* ada, float* res, const float* part, bf16_t* U, int gw, int NGW, int lane) {
    for (int r = gw, nr; r >= 0; r = nr) { nr = -1; if (r < MP) { nr = r + NGW; if (nr >= MP) nr = ((gw & 15) == 0 && (gw >> 4) < NS && NGW >= 16 * NS) ? MP + (gw >> 4) : ((NGW >= 16 * NS) ? -1 : (nr < MV ? nr : -1)); } else if (NGW < 16 * NS) { nr = r + NGW; if (nr >= MV) nr = -1; }
        u32x2* o8 = (u32x2*)(U + (size_t)r * D) + lane;
        f32x4* rr = (f32x4*)(res + (size_t)r * D) + lane;
        const float* ar = ada + (size_t)cond_row(r) * NADAP;
        f32x4 v[8];
        if (r < MP) {
#pragma unroll
            for (int j = 0; j < 8; ++j) v[j] = rr[64 * j];
        } else {
            const f32x4* xr = (const f32x4*)(a.x_sample + (size_t)(r - MP) * D) + lane;
#pragma unroll
            for (int j = 0; j < 8; ++j) { f32x4 sum = (f32x4){0.f, 0.f, 0.f, 0.f};
#pragma unroll
                for (int sl = 0; sl < 16; ++sl) sum += ((const f32x4*)(part + ((size_t)sl * NS + (r - MP)) * D) + lane)[64 * j];
                v[j] = xr[64 * j] * ALPHA + *(const f32x4*)(ar + adac(2 * D + 4 * (lane + 64 * j))) * sum; }
        }
        ln_row(v, a.ln1_g, a.ln1_b, lane);
#pragma unroll
        for (int j = 0; j < 8; ++j) { const int c = 4 * (lane + 64 * j); rr[64 * j] = v[j]; const f32x4 t = v[j] * (*(const f32x4*)(ar + adac(4 * D + c)) + 1.f) + *(const f32x4*)(ar + adac(3 * D + c));
            o8[64 * j] = (u32x2){pk2(t[0], t[1]), pk2(t[2], t[3])}; }
    }
}
__device__ __forceinline__ void p9_ln2(const Args& a, const float* ada, const float* res, const float* part, int gw, int NGW, int lane) {
    for (int r = gw, nr; r >= 0; r = nr) { nr = -1; if (r < MP) { nr = r + NGW; if (nr >= MP) nr = ((gw & 15) == 0 && (gw >> 4) < NS && NGW >= 16 * NS) ? MP + (gw >> 4) : ((NGW >= 16 * NS) ? -1 : (nr < MV ? nr : -1)); } else if (NGW < 16 * NS) { nr = r + NGW; if (nr >= MV) nr = -1; }
        const f32x4* rr = (const f32x4*)(res + (size_t)r * D) + lane;
        f32x4 v[8];
#pragma unroll
        for (int j = 0; j < 8; ++j) v[j] = rr[64 * j];
        if (r >= MP) {
            const float* ar = ada + (size_t)cond_row(r) * NADAP;
#pragma unroll
            for (int j = 0; j < 8; ++j) { f32x4 sum = *((const f32x4*)a.b_ff2 + lane + 64 * j);
#pragma unroll
                for (int sl = 0; sl < 16; ++sl) sum += ((const f32x4*)(part + ((size_t)sl * NS + (r - MP)) * D) + lane)[64 * j];
                v[j] = v[j] * ALPHA + *(const f32x4*)(ar + adac(5 * D + 4 * (lane + 64 * j))) * sum; }
        }
        ln_row(v, a.ln2_g, a.ln2_b, lane);
        f32x4* o = (f32x4*)(a.out + (r < MP ? O_YP + (size_t)r * D : O_YS + (size_t)(r - MP) * D)) + lane;
#pragma unroll
        for (int j = 0; j < 8; ++j) o[64 * j] = v[j];
    }
}

typedef f32x4 Acc128[4][2];
__device__ __forceinline__ void gemm128_core(Acc128& acc, LAS unsigned char* lds, const bf16_t* A, const bf16_t* Bt, const int K  , const int klen  ) {
    using namespace pg8;
    const int tid = threadIdx.x, wid = __builtin_amdgcn_readfirstlane(tid >> 6), lane = tid & 63, wr = wid >> 2, wc = wid & 3, fr = lane & 15, fq = lane >> 4;
    const int nt = klen / 64;
    unsigned voff[2];
#pragma unroll
    for (int i = 0; i < 2; ++i) { int R, C; stage_rc(tid * 16 + i * 8192, R, C); voff[i] = (unsigned)(R * K + C) * 2u; }
    const unsigned ldsw = (unsigned)wid * 1024u;
    const int aoff = lds_byte(wr * 64 + fr, fq * 8), boff = lds_byte(wc * 32 + fr, fq * 8);
    const char* pa = (const char*)A; const char* pb = (const char*)Bt;
#define G128_STAGE(st, kt) do { _Pragma("unroll") for (int _i = 0; _i < 2; ++_i) { \
        __builtin_amdgcn_global_load_lds((const unsigned*)(pa + (size_t)(kt) * 128 + voff[_i]), (LAS unsigned*)(lds + (st) * 32768 + ldsw + _i * 8192), 16, 0, 0); \
        __builtin_amdgcn_global_load_lds((const unsigned*)(pb + (size_t)(kt) * 128 + voff[_i]), (LAS unsigned*)(lds + (st) * 32768 + 16384 + ldsw + _i * 8192), 16, 0, 0); } } while (0)
    G128_STAGE(0, 0); G128_STAGE(1, 1 < nt ? 1 : nt - 1); G128_STAGE(2, 2 < nt ? 2 : nt - 1);
#pragma unroll 1
    for (int t = 0; t < nt; ++t) {
        asm volatile("s_waitcnt vmcnt(8)" ::: "memory");
        __builtin_amdgcn_s_barrier();
        asm volatile("" ::: "memory");
        { const int kt = t + 3 < nt ? t + 3 : nt - 1; G128_STAGE((t + 3) & 3, kt); }
        const LAS unsigned char* sa = lds + (t & 3) * 32768; const LAS unsigned char* sb = sa + 16384;
        bf16x8 af[4][2], bfr[2][2];
#pragma unroll
        for (int m = 0; m < 4; ++m)
#pragma unroll
            for (int k = 0; k < 2; ++k) af[m][k] = *(const LAS bf16x8*)(sa + aoff + m * 2048 + k * 1024);
#pragma unroll
        for (int n = 0; n < 2; ++n)
#pragma unroll
            for (int k = 0; k < 2; ++k) bfr[n][k] = *(const LAS bf16x8*)(sb + boff + n * 2048 + k * 1024);
#pragma unroll
        for (int m = 0; m < 4; ++m)
#pragma unroll
            for (int n = 0; n < 2; ++n)
#pragma unroll
                for (int k = 0; k < 2; ++k) acc[m][n] = __builtin_amdgcn_mfma_f32_16x16x32_bf16(bfr[n][k], af[m][k], acc[m][n], 0, 0, 0);
        asm volatile("s_waitcnt lgkmcnt(0)" ::: "memory");
    }
    asm volatile("s_waitcnt vmcnt(0)" ::: "memory");
    __builtin_amdgcn_s_barrier();
    asm volatile("" ::: "memory");
#undef G128_STAGE
}
__device__ __forceinline__ void zero128(Acc128& acc) {
#pragma unroll
    for (int m = 0; m < 4; ++m)
#pragma unroll
        for (int n = 0; n < 2; ++n) acc[m][n] = (f32x4){0.f, 0.f, 0.f, 0.f};
}
template <int MODE>
__device__ __forceinline__ void sample_gemm(const Args& a, LAS unsigned char* lds, const bf16_t* A0, const bf16_t* B0, const bf16_t* A1, const bf16_t* B1, const int K, const int N,
                                            const bf16_t* proj, bf16_t* Ob, float* res, const float* ada) {
    const int tid = threadIdx.x, wid = __builtin_amdgcn_readfirstlane(tid >> 6), lane = tid & 63, wr = wid >> 2, wc = wid & 3, fr = lane & 15, fq = lane >> 4;
    constexpr int NSL = (MODE >= 3) ? 16 : 1;
    for (int unit = blockIdx.x; unit < (N / 128) * NSL; unit += gridDim.x) {
        const int n0 = (unit / NSL) * 128, sl = unit % NSL, klen = K / NSL;
        Acc128 acc, acc2;
        zero128(acc);
        gemm128_core(acc, lds, A0 + (size_t)MP * K + sl * klen, B0 + (size_t)n0 * K + sl * klen, K, klen);
        if (MODE == 2) { zero128(acc2); gemm128_core(acc2, lds, A1 + (size_t)MP * K, B1 + (size_t)n0 * K, K, K); }
#pragma unroll
        for (int m = 0; m < 4; ++m) { const int ms = wr * 64 + m * 16 + fr; const size_t row = (size_t)(MP + ms);
#pragma unroll
            for (int n = 0; n < 2; ++n) { const int c = n0 + wc * 32 + n * 16 + 4 * fq; f32x4 v = acc[m][n];
                if (MODE == 0) { *(u32x2*)(Ob + row * INW + c) = (u32x2){pk2(v[0], v[1]), pk2(v[2], v[3])}; }
                else if (MODE == 1) { v = v + *(const f32x4*)(a.b_ff1 + c);
#pragma unroll
                    for (int j = 0; j < 4; ++j) { const float r = fmaxf(v[j], 0.f); v[j] = r * r; }
                    *(u32x2*)(Ob + row * DFF + c) = (u32x2){pk2(v[0], v[1]), pk2(v[2], v[3])}; }
                else if (MODE == 2) {
                    const u32x2 gpw = *(const u32x2*)(proj + row * INW + 4096 + c), gcw = *(const u32x2*)(proj + row * INW + 6144 + c);
                    const float gp[4] = {bflo(gpw.x), bfhi(gpw.x), bflo(gpw.y), bfhi(gpw.y)}, gc[4] = {bflo(gcw.x), bfhi(gcw.x), bflo(gcw.y), bfhi(gcw.y)};
                    float o[4];
#pragma unroll
                    for (int j = 0; j < 4; ++j) o[j] = v[j] / (1.f + __expf(-gp[j])) + acc2[m][n][j] / (1.f + __expf(-gc[j]));
                    *(u32x2*)(Ob + row * D + c) = (u32x2){pk2(o[0], o[1]), pk2(o[2], o[3])}; }
                else { *(f32x4*)(res + ((size_t)sl * NS + ms) * D + c) = v; }
            } }
    }
}

#define XB_TMO      128
#define XB_XCNT(j)  (256  + 64 * (j))
#define XB_XSUB(j)  (1280 + 64 * (j))
#define XB_XGEN(j)  (2304 + 64 * (j))
#define XB_TOP      3328
#define XB_TOPGEN   3392
#define XCD_BAR_WORDS 3456
#define XB_SPIN_CAP (1u << 18)
__device__ __forceinline__ unsigned xb_ld(unsigned* p)              { return __hip_atomic_load(p, __ATOMIC_RELAXED, __HIP_MEMORY_SCOPE_AGENT); }
__device__ __forceinline__ unsigned xb_add(unsigned* p, unsigned v) { return __hip_atomic_fetch_add(p, v, __ATOMIC_RELAXED, __HIP_MEMORY_SCOPE_AGENT); }
__device__ __forceinline__ unsigned xb_xcc_id() { return (unsigned)__builtin_amdgcn_s_getreg((3 << 11) | 20) & 0xFu; }
#define XB_SPIN(cond, bar) do { unsigned _sp = 0; while (cond) { __builtin_amdgcn_s_sleep(1); \
    if ((++_sp & 255u) == 0u) { if (xb_ld(&(bar)[XB_TMO])) break; if (_sp > XB_SPIN_CAP) { atomicAdd(&(bar)[XB_TMO], 1u); break; } } } } while (0)
struct XcdBarrier { unsigned* bar; unsigned x; volatile LAS unsigned* st; };
__device__ __forceinline__ XcdBarrier xcd_barrier_post(unsigned* bar, volatile LAS unsigned* st) {
    XcdBarrier b; b.bar = bar; b.x = xb_xcc_id(); b.st = st;
    if (threadIdx.x == 0) (void)xb_add(&bar[XB_XCNT(b.x)], 1u);
    return b;
}
__device__ __forceinline__ void xcd_barrier_complete(unsigned* bar, unsigned x, unsigned& nloc, unsigned& nx) {
    const unsigned G = gridDim.x * gridDim.y * gridDim.z;
    unsigned sum, cnt, mine, sp = 0u;
    for (;;) {
        sum = 0u; cnt = 0u; mine = 0u;
#pragma unroll
        for (unsigned j = 0; j < 16; ++j) { const unsigned c = xb_ld(&bar[XB_XCNT(j)]); sum += c; cnt += (c > 0u) ? 1u : 0u; mine = (j == x) ? c : mine; }
        if (sum == G) break;
        __builtin_amdgcn_s_sleep(1);
        if ((++sp & 255u) == 0u) { if (xb_ld(&bar[XB_TMO])) break; if (sp > XB_SPIN_CAP) { atomicAdd(&bar[XB_TMO], 1u); break; } }
    }
    nloc = mine > 0u ? mine : 1u; nx = cnt > 0u ? cnt : 1u;
}
__device__ __forceinline__ void xcd_barrier(const XcdBarrier& b) {
    asm volatile("s_waitcnt vmcnt(0)" ::: "memory");
    __syncthreads();
    if (threadIdx.x == 0) {
        unsigned* bar = b.bar;
        __builtin_amdgcn_s_waitcnt(0);
        unsigned nloc = b.st[0], nx = b.st[1];
        if (nloc == 0u) { xcd_barrier_complete(bar, b.x, nloc, nx); b.st[0] = nloc; b.st[1] = nx; }
        const unsigned old = xb_add(&bar[XB_XSUB(b.x)], 1u);
        const unsigned gen = old / nloc;
        if (old + 1u == (gen + 1u) * nloc) {
            __builtin_amdgcn_fence(__ATOMIC_RELEASE, "agent");
            asm volatile("s_waitcnt vmcnt(0)" ::: "memory");
            const unsigned og = xb_add(&bar[XB_TOP], 1u);
            const unsigned tg = og / nx;
            if (og + 1u == (tg + 1u) * nx) xb_add(&bar[XB_TOPGEN], 1u);
            else XB_SPIN(xb_ld(&bar[XB_TOPGEN]) == tg, bar);
            __builtin_amdgcn_fence(__ATOMIC_ACQUIRE, "agent");
            xb_add(&bar[XB_XGEN(b.x)], 1u);
            asm volatile("s_waitcnt vmcnt(0)" ::: "memory");
        } else {
            XB_SPIN(xb_ld(&bar[XB_XGEN(b.x)]) == gen, bar);
            __builtin_amdgcn_fence(__ATOMIC_ACQUIRE, "agent");
            asm volatile("s_waitcnt vmcnt(0)" ::: "memory");
        }
    }
    __syncthreads();
}

__device__ __forceinline__ void p0_all(const Args& a, LAS unsigned char* lds, int tid, int lane, int wave, int bx, int G) {
    unsigned char* ws = a.ws;
    float* ada = (float*)(ws + WS_ADA);
    bf16_t* WinT = (bf16_t*)(ws + WS_WIN); bf16_t* Wff1T = (bf16_t*)(ws + WS_WFF1); bf16_t* Wff2T = (bf16_t*)(ws + WS_WFF2); bf16_t* WoT = (bf16_t*)(ws + WS_WO);
    bf16_t* WupP = (bf16_t*)(ws + WS_WUPP); bf16_t* WupC = (bf16_t*)(ws + WS_WUPC);
    const int gw = bx * 8 + wave, NGW = G * 8;
    for (int it = bx; it < NADA / 48; it += G) p0_ada_item(a, ada, lds, it, wave, lane);
    for (int it = bx; it < 512; it += G) p0_weff_item(a, WupP, lds, it, tid);
    {
        LAS float* scr = (LAS float*)(lds + wave * 16384);
        constexpr int I_IN = (D / 64) * (INW / 32), I_F1 = (D / 64) * (DFF / 32), I_F2 = (DFF / 64) * (D / 32), I_O = (D / 64) * (D / 32), I_C = (CW / 64) * (D / 32);
        constexpr int NIT = I_IN + I_F1 + I_F2 + I_O + I_C;
        for (int it = gw; it < NIT; it += NGW) {
            int r = it;
            if (r < I_IN) { p0_transpose_item(a.w_in, D, INW, WinT, scr, r, lane); continue; } r -= I_IN;
            if (r < I_F1) { p0_transpose_item(a.w_ff1, D, DFF, Wff1T, scr, r, lane); continue; } r -= I_F1;
            if (r < I_F2) { p0_transpose_item(a.w_ff2, DFF, D, Wff2T, scr, r, lane); continue; } r -= I_F2;
            if (r < I_O) { p0_transpose_item(a.w_o, D, D, WoT, scr, r, lane); continue; } r -= I_O;
            p0_transpose_item(a.w_conv_up, CW, D, WupC, scr, r, lane);
        }
    }
}

__global__ void __launch_bounds__(512, 2) fwd_megakernel(Args a) {
    extern __shared__ __attribute__((aligned(16))) unsigned char lds_raw[];
    LAS unsigned char* lds = (LAS unsigned char*)lds_raw;
    const int tid = threadIdx.x, lane = tid & 63, wave = __builtin_amdgcn_readfirstlane(tid >> 6);
    const int G = gridDim.x, bx = blockIdx.x;
    const int gw = bx * 8 + wave, NGW = G * 8;
    unsigned char* ws = a.ws;
    float* ada = (float*)(ws + WS_ADA);
    unsigned* ctr = (unsigned*)(ws + WS_CTL);
    if (tid < 64) ((LAS unsigned*)(lds + MISC_OFF))[tid] = 0u;
    __syncthreads();
    const XcdBarrier xbar = xcd_barrier_post(ctr, (volatile LAS unsigned*)(lds + MISC_OFF));
#define GB() xcd_barrier(xbar)
    bf16_t* WinT = (bf16_t*)(ws + WS_WIN); bf16_t* Wff1T = (bf16_t*)(ws + WS_WFF1); bf16_t* Wff2T = (bf16_t*)(ws + WS_WFF2); bf16_t* WoT = (bf16_t*)(ws + WS_WO);
    bf16_t* WupP = (bf16_t*)(ws + WS_WUPP); bf16_t* WupC = (bf16_t*)(ws + WS_WUPC);
    bf16_t* U = (bf16_t*)(ws + WS_U); bf16_t* PROJ = (bf16_t*)(ws + WS_PROJ); float* RES = (float*)(ws + WS_RES);
    float* PART = (float*)(ws + WS_PART);
    bf16_t* PRE = (bf16_t*)(ws + WS_RES); bf16_t* CIN = (bf16_t*)(ws + WS_RES + WS_CIN_OFF);

    p0_all(a, lds, tid, lane, wave, bx, G);
    GB();
    p1_modulate(a, ada, U, gw, NGW, lane);
    GB();
    { pg8::Order S; S.init(MP, INW, G, bx, 1, U, WinT, U, WinT);
      pg8::EpiBf16<0> E{PROJ, INW, nullptr};
      pg8::gemm_phase(lds, D, S, E); }
    sample_gemm<0>(a, lds, U, WinT, U, WinT, D, INW, PROJ, PROJ, RES, ada);
    GB();
    p3_mixer(a, PROJ, PRE, CIN, tid);
    GB();
    { pg8::Order S; S.init(MP, D, G, bx, 2, PRE, WupP, CIN, WupC);
      pg8::EpiGate E{PROJ, U};
      pg8::gemm_phase(lds, PW, S, E); }
    sample_gemm<2>(a, lds, PRE, WupP, CIN, WupC, PW, D, PROJ, U, RES, ada);
    GB();
    { pg8::Order S; S.init(MP, D, G, bx, 1, U, WoT, U, WoT);
      pg8::EpiRes E{RES, a.x_prompt, ada, 2 * D, nullptr};
      pg8::gemm_phase(lds, D, S, E); }
    sample_gemm<3>(a, lds, U, WoT, U, WoT, D, D, PROJ, U, PART, ada);
    GB();
    p6_ln1(a, ada, RES, PART, U, gw, NGW, lane);
    GB();
    { pg8::Order S; S.init(MP, DFF, G, bx, 1, U, Wff1T, U, Wff1T);
      pg8::EpiBf16<1> E{PROJ, DFF, a.b_ff1};
      pg8::gemm_phase(lds, D, S, E); }
    sample_gemm<1>(a, lds, U, Wff1T, U, Wff1T, D, DFF, PROJ, PROJ, RES, ada);
    GB();
    { pg8::Order S; S.init(MP, D, G, bx, 1, PROJ, Wff2T, PROJ, Wff2T);
      pg8::EpiRes E{RES, RES, ada, 5 * D, a.b_ff2};
      pg8::gemm_phase(lds, DFF, S, E); }
    sample_gemm<4>(a, lds, PROJ, Wff2T, PROJ, Wff2T, DFF, D, PROJ, U, PART, ada);
    GB();
    p9_ln2(a, ada, RES, PART, gw, NGW, lane);
}

extern "C" void kernel_launch(void* const* d_in, const int* in_sizes, int n_in, void* d_out, int out_size, void* d_ws, size_t ws_size, hipStream_t stream) {
    static int grid = 0;
    if (grid == 0) {
        if (n_in != 23 || ws_size < WS_END) { fprintf(stderr, "kernel_launch: expected 23 inputs and >= %zu bytes of workspace; got %d, %zu\n", (size_t)WS_END, n_in, ws_size); grid = -1; return; }
        int dev = 0, cus = 0, per_cu = 0;
        hipGetDevice(&dev);
        hipDeviceGetAttribute(&cus, hipDeviceAttributeMultiprocessorCount, dev);
        if (hipFuncSetAttribute((const void*)fwd_megakernel, hipFuncAttributeMaxDynamicSharedMemorySize, LDS_BYTES) != hipSuccess) { fprintf(stderr, "kernel_launch: hipFuncSetAttribute failed\n"); grid = -1; return; }
        if (hipOccupancyMaxActiveBlocksPerMultiprocessor(&per_cu, (const void*)fwd_megakernel, 512, LDS_BYTES) != hipSuccess || per_cu < 1) { fprintf(stderr, "kernel_launch: occupancy query says %d blocks per CU\n", per_cu); (void)hipGetLastError(); per_cu = 1; }
        grid = cus;
        fprintf(stderr, "kernel_launch: cus %d per_cu %d grid %d\n", cus, per_cu, grid);
    }
    if (grid < 0) return;
    if (hipMemsetAsync((char*)d_ws + WS_CTL, 0, 16384, stream) != hipSuccess) { fprintf(stderr, "kernel_launch: memset failed\n"); return; }
    Args a{};
    const float** ap = (const float**)&a;
    for (int i = 0; i < 23; ++i) ap[i] = (const float*)d_in[i];
    a.out = (float*)d_out; a.ws = (unsigned char*)d_ws;
    void* args[] = {&a};
    hipError_t e = hipLaunchCooperativeKernel((const void*)fwd_megakernel, dim3(grid), dim3(512), args, LDS_BYTES, stream);
    if (e != hipSuccess) fprintf(stderr, "kernel_launch: cooperative launch failed: %s (grid %d)\n", hipGetErrorString(e), grid);
}
```

```cpp
#include <hip/hip_runtime.h>
#include <cstdio>
#include <cstdint>

#define LAS __attribute__((address_space(3)))
typedef unsigned short bf16_t;
typedef short bf16x8 __attribute__((ext_vector_type(8)));
typedef float f32x4 __attribute__((ext_vector_type(4)));
typedef float f32x2 __attribute__((ext_vector_type(2)));
typedef unsigned u32x4 __attribute__((ext_vector_type(4)));
typedef unsigned u32x2 __attribute__((ext_vector_type(2)));

constexpr int D = 2048, NB = 4, SEQ = 2048, NS = 128;
constexpr int MP = NB * SEQ;
constexpr int MV = MP + NS;
constexpr int MPAD = 8448;
constexpr int PW = 1024, CW = 1024, DFF = 8192, INW = 8192, NADA = 6 * D, NCOND = NB + NS;
constexpr float ALPHA = 1.18920711500272f;
constexpr float LN_EPS = 1e-5f;
constexpr int NADAP = 256 * 64;
__device__ __forceinline__ int adac(int n) { return n + 16 * (n / 48); }

constexpr size_t MiB = 1u << 20;
constexpr size_t WS_CTL = 0;
constexpr size_t WS_ADA = 352 * MiB;
constexpr size_t WS_WIN = 8 * MiB, WS_WFF1 = 40 * MiB, WS_WFF2 = 72 * MiB, WS_WO = 104 * MiB, WS_WUPP = 112 * MiB, WS_WUPC = 116 * MiB;
constexpr size_t WS_U = 120 * MiB;
constexpr size_t WS_PROJ = 153 * MiB;
constexpr size_t WS_RES = 285 * MiB;
constexpr size_t WS_PART = 362 * MiB;
constexpr size_t WS_END = 378 * MiB;
constexpr size_t WS_CIN_OFF = (size_t)MPAD * 1024 * 2;

constexpr size_t O_YP = 0, O_YS = (size_t)MP * D, O_NPP = O_YS + (size_t)NS * D, O_NCP = O_NPP + (size_t)NB * 15 * PW, O_NPS = O_NCP + (size_t)NB * 2 * CW, O_NCS = O_NPS + (size_t)NS * 15 * PW;

constexpr int LDS_BYTES = 131072 + 256, MISC_OFF = 131072;

__device__ __forceinline__ unsigned f2bf(float f) { unsigned u = __builtin_bit_cast(unsigned, f); return (u + 0x7fffu + ((u >> 16) & 1u)) >> 16; }
__device__ __forceinline__ unsigned pk2(float lo, float hi) { return f2bf(lo) | (f2bf(hi) << 16); }
__device__ __forceinline__ unsigned cvt_pk_bf16(float lo, float hi) { unsigned r; asm volatile("v_cvt_pk_bf16_f32 %0, %1, %2" : "=v"(r) : "v"(lo), "v"(hi)); return r; }
__device__ __forceinline__ float bflo(unsigned w) { return __builtin_bit_cast(float, w << 16); }
__device__ __forceinline__ float bfhi(unsigned w) { return __builtin_bit_cast(float, w & 0xffff0000u); }
__device__ __forceinline__ int cond_row(int r) { int s = r - MP; s = s < 0 ? 0 : (s > NS - 1 ? NS - 1 : s); return r < MP ? (r >> 11) : NB + s; }
__device__ __forceinline__ const float* x_rowp(const float* xp, const float* xs, int r) { int s = r - MP; s = s < 0 ? 0 : (s > NS - 1 ? NS - 1 : s); return r < MP ? xp + (size_t)r * D : xs + (size_t)s * D; }

namespace pg8 {
constexpr int BM = 256, BK = 64, HALF = 128, HTB = HALF * BK * 2, NXCD = 8, WGM = 8;
__device__ __forceinline__ int lds_byte(int r, int c) { const int st = (r >> 4) * 2 + (c >> 5), rr = r & 15, cc = c & 31, ob = rr * 64 + cc * 2; return st * 1024 + (ob ^ (((ob >> 9) & 1) << 5)); }
__device__ __forceinline__ void stage_rc(int b, int& R, int& C) { const int st = b / 1024, sb = b % 1024, swz = sb ^ (((sb >> 9) & 1) << 5); R = (st >> 1) * 16 + swz / 64; C = (st & 1) * 32 + (swz % 64) / 2; }
__device__ __forceinline__ int perm32(int rho) { const int n = rho >> 4, i = rho & 15; return 8 * (i >> 2) + 4 * n + (i & 3); }

struct Unit { int pm, pn, grp; };
struct Order {
    int nM, nN, nwg, G, c, rep;
    const char* A0; const char* B0; const char* A1; const char* B1;
    __device__ __forceinline__ void init(int M, int N, int G_, int c_, int rep_, const void* a0, const void* b0, const void* a1, const void* b1) {
        nM = M / BM; nN = N / BM; nwg = nM * nN; G = G_; c = c_; rep = rep_; A0 = (const char*)a0; B0 = (const char*)b0; A1 = (const char*)a1; B1 = (const char*)b1; }
    __device__ __forceinline__ bool next(int i, Unit& u) const {
        const int ti = (rep == 2) ? (i >> 1) : i; u.grp = (rep == 2) ? (i & 1) : 0;
        const long L = (long)ti * G + c; if (L >= nwg) return false;
        int wgid = (int)L; { const int q = nwg / NXCD, r = nwg % NXCD, xcd = wgid % NXCD, off = wgid / NXCD; wgid = (xcd < r ? xcd * (q + 1) : r * (q + 1) + (xcd - r) * q) + off; }
        const int nig = WGM * nN, gid = wgid / nig, fm = gid * WGM, gsz = (nM - fm) < WGM ? (nM - fm) : WGM;
        u.pm = fm + ((wgid % nig) % gsz); u.pn = (wgid % nig) / gsz; return true;
    }
    __device__ __forceinline__ const char* baseA(const Unit& u, size_t tstep) const { return (u.grp ? A1 : A0) + (size_t)u.pm * tstep; }
    __device__ __forceinline__ const char* baseB(const Unit& u, size_t tstep) const { return (u.grp ? B1 : B0) + (size_t)u.pn * tstep; }
};

typedef f32x4 Acc[2][2][4][2];

template <int ACT> struct EpiBf16 {
    static constexpr bool PERM = true;
    bf16_t* O; int ldc; const float* bias;
    __device__ __forceinline__ bool keep(const Unit&) const { return false; }
    __device__ __forceinline__ void operator()(Acc& acc, const Unit& u, int wr, int wc, int fr, int fq) const {
        const int row0 = u.pm * BM + wr * 64 + fr, col0 = u.pn * BM + wc * 32 + 8 * fq;
        f32x4 bv[2][2];
#pragma unroll
        for (int bj = 0; bj < 2; ++bj)
#pragma unroll
            for (int n = 0; n < 2; ++n) bv[bj][n] = bias ? *(const f32x4*)(bias + col0 + bj * HALF + 4 * n) : (f32x4){0.f, 0.f, 0.f, 0.f};
#pragma unroll
        for (int ai = 0; ai < 2; ++ai)
#pragma unroll
            for (int m = 0; m < 4; ++m) { bf16_t* rowp = O + (size_t)(row0 + ai * HALF + m * 16) * ldc + col0;
#pragma unroll
                for (int bj = 0; bj < 2; ++bj) { f32x4 v0 = acc[ai][bj][m][0] + bv[bj][0], v1 = acc[ai][bj][m][1] + bv[bj][1];
                    if (ACT == 1) {
#pragma unroll
                        for (int j = 0; j < 4; ++j) { const float a = fmaxf(v0[j], 0.f), b = fmaxf(v1[j], 0.f); v0[j] = a * a; v1[j] = b * b; } }
                    u32x4 w; w.x = cvt_pk_bf16(v0[0], v0[1]); w.y = cvt_pk_bf16(v0[2], v0[3]); w.z = cvt_pk_bf16(v1[0], v1[1]); w.w = cvt_pk_bf16(v1[2], v1[3]);
                    *(u32x4*)(rowp + bj * HALF) = w; } }
    }
};
__device__ __forceinline__ void unpack8(const u32x4 w, float (&e)[8]) { e[0] = bflo(w.x); e[1] = bfhi(w.x); e[2] = bflo(w.y); e[3] = bfhi(w.y); e[4] = bflo(w.z); e[5] = bfhi(w.z); e[6] = bflo(w.w); e[7] = bfhi(w.w); }
struct EpiGate {
    static constexpr bool PERM = true;
    const bf16_t* proj; bf16_t* O;
    __device__ __forceinline__ bool keep(const Unit& u) const { return u.grp == 0; }
    __device__ __forceinline__ void operator()(Acc& acc, const Unit& u, int wr, int wc, int fr, int fq) const {
        const int row0 = u.pm * BM + wr * 64 + fr, col0 = u.pn * BM + wc * 32 + 8 * fq;
        const bool g0 = (u.grp == 0);
        u32x4 gcw[2], gpw[2];
        { const bf16_t* p = proj + (size_t)row0 * INW + col0; gcw[0] = *(const u32x4*)(p + 6144); gpw[0] = g0 ? *(const u32x4*)(p + 4096) : gcw[0]; }
#pragma unroll
        for (int it = 0; it < 16; ++it) { const int ai = it >> 3, m = (it >> 1) & 3, bj = it & 1;
            const size_t row = (size_t)(row0 + ai * HALF + m * 16); const int col = col0 + bj * HALF;
            if (it < 15) { const int ai2 = (it + 1) >> 3, m2 = ((it + 1) >> 1) & 3, bj2 = (it + 1) & 1;
                const bf16_t* p = proj + (size_t)(row0 + ai2 * HALF + m2 * 16) * INW + col0 + bj2 * HALF;
                gcw[(it + 1) & 1] = *(const u32x4*)(p + 6144); gpw[(it + 1) & 1] = g0 ? *(const u32x4*)(p + 4096) : gcw[(it + 1) & 1]; }
            float ec[8]; unpack8(gcw[it & 1], ec);
#pragma unroll
            for (int j = 0; j < 8; ++j) ec[j] = 1.f + __expf(-fmaxf(ec[j], -30.f));
            if (g0) {
                float ep[8]; unpack8(gpw[it & 1], ep);
#pragma unroll
                for (int j = 0; j < 8; ++j) ep[j] = ec[j] * __builtin_amdgcn_rcpf(1.f + __expf(-ep[j]));
#pragma unroll
                for (int j = 0; j < 4; ++j) { acc[ai][bj][m][0][j] *= ep[j]; acc[ai][bj][m][1][j] *= ep[4 + j]; }
            } else {
                f32x4 v0, v1;
#pragma unroll
                for (int j = 0; j < 4; ++j) { v0[j] = acc[ai][bj][m][0][j] * __builtin_amdgcn_rcpf(ec[j]); v1[j] = acc[ai][bj][m][1][j] * __builtin_amdgcn_rcpf(ec[4 + j]); }
                u32x4 w; w.x = cvt_pk_bf16(v0[0], v0[1]); w.y = cvt_pk_bf16(v0[2], v0[3]); w.z = cvt_pk_bf16(v1[0], v1[1]); w.w = cvt_pk_bf16(v1[2], v1[3]);
                *(u32x4*)(O + row * D + col) = w;
            } }
    }
};
struct EpiRes {
    static constexpr bool PERM = false;
    float* res; const float* base; const float* ada; int gate_off; const float* bias;
    __device__ __forceinline__ bool keep(const Unit&) const { return false; }
    __device__ __forceinline__ void operator()(Acc& acc, const Unit& u, int wr, int wc, int fr, int fq) const {
        const int row0 = u.pm * BM + wr * 64 + fr, col0 = u.pn * BM + wc * 32 + 4 * fq;
        const float* gp = ada + (size_t)(u.pm >> 3) * NADAP;
        f32x4 bv[2][2], gv[2][2], xb[2][2][2];
#pragma unroll
        for (int bj = 0; bj < 2; ++bj)
#pragma unroll
            for (int n = 0; n < 2; ++n) { bv[bj][n] = bias ? *(const f32x4*)(bias + col0 + bj * HALF + n * 16) : (f32x4){0.f, 0.f, 0.f, 0.f}; gv[bj][n] = *(const f32x4*)(gp + adac(gate_off + col0 + bj * HALF + n * 16)); }
#pragma unroll
        for (int bj = 0; bj < 2; ++bj)
#pragma unroll
            for (int n = 0; n < 2; ++n) xb[0][bj][n] = *(const f32x4*)(base + (size_t)row0 * D + col0 + bj * HALF + n * 16);
#pragma unroll
        for (int it = 0; it < 8; ++it) { const int ai = it >> 2, m = it & 3;
            if (it < 7) { const float* bp = base + (size_t)(row0 + ((it + 1) >> 2) * HALF + ((it + 1) & 3) * 16) * D + col0;
#pragma unroll
                for (int bj = 0; bj < 2; ++bj)
#pragma unroll
                    for (int n = 0; n < 2; ++n) xb[(it + 1) & 1][bj][n] = *(const f32x4*)(bp + bj * HALF + n * 16); }
            float* rp = res + (size_t)(row0 + ai * HALF + m * 16) * D + col0;
#pragma unroll
            for (int bj = 0; bj < 2; ++bj)
#pragma unroll
                for (int n = 0; n < 2; ++n) *(f32x4*)(rp + bj * HALF + n * 16) = xb[it & 1][bj][n] * ALPHA + gv[bj][n] * (acc[ai][bj][m][n] + bv[bj][n]); }
    }
};

template <class Epi>
__device__ __forceinline__ void gemm_phase(LAS unsigned char* lds, const int K, const Order& S, const Epi& E) {
    const int tid = threadIdx.x, wid = __builtin_amdgcn_readfirstlane(tid >> 6), lane = tid & 63, wr = wid >> 2, wc = wid & 3, fr = lane & 15, fq = lane >> 4;
    const int nt = K / BK;
    unsigned voffA[2], voffB[2];
#pragma unroll
    for (int i = 0; i < 2; ++i) { int R, C; stage_rc(tid * 16 + i * 8192, R, C); const int Rb = Epi::PERM ? ((R & ~31) + perm32(R & 31)) : R;
        voffA[i] = (unsigned)(R * K + C) * 2u; voffB[i] = (unsigned)(Rb * K + C) * 2u; }
    const size_t kstep = (size_t)(BK * 2);
    const size_t hstep = (size_t)HALF * K * 2;
    const size_t tstep = 2 * hstep;
    const unsigned ldsw = (unsigned)wid * 1024u;
    const int aoff = lds_byte(wr * 64 + fr, fq * 8), boff = lds_byte(wc * 32 + fr, fq * 8);
#define PG8_SA(b, h) (((b) * 2 + (h)) * HTB)
#define PG8_SB(b, h) ((4 + (b) * 2 + (h)) * HTB)
#define PG8_STAGE(bufoff, gbase, voff) do { _Pragma("unroll") for (int _i = 0; _i < 2; ++_i) \
        __builtin_amdgcn_global_load_lds((const unsigned*)((const char*)(gbase) + (voff)[_i]), (LAS unsigned*)(lds + (bufoff) + ldsw + _i * 8192), 16, 0, 0); } while (0)
#define PG8_LDA(dst, b, h) do { _Pragma("unroll") for (int m = 0; m < 4; ++m) _Pragma("unroll") for (int k = 0; k < 2; ++k) dst[m][k] = *(const LAS bf16x8*)(lds + PG8_SA(b, h) + aoff + m * 2048 + k * 1024); } while (0)
#define PG8_LDB(dst, b, h) do { _Pragma("unroll") for (int n = 0; n < 2; ++n) _Pragma("unroll") for (int k = 0; k < 2; ++k) dst[n][k] = *(const LAS bf16x8*)(lds + PG8_SB(b, h) + boff + n * 2048 + k * 1024); } while (0)
#define PG8_MMA(ai, bj, At, Bt) do { __builtin_amdgcn_s_setprio(1); _Pragma("unroll") for (int m = 0; m < 4; ++m) _Pragma("unroll") for (int n = 0; n < 2; ++n) _Pragma("unroll") for (int k = 0; k < 2; ++k) \
        acc[ai][bj][m][n] = __builtin_amdgcn_mfma_f32_16x16x32_bf16(Bt[n][k], At[m][k], acc[ai][bj][m][n], 0, 0, 0); __builtin_amdgcn_s_setprio(0); } while (0)
#define PG8_WAIT_V(n) asm volatile("s_waitcnt vmcnt(" #n ")" ::: "memory")
#define PG8_WAIT_L(n) asm volatile("s_waitcnt lgkmcnt(" #n ")" ::: "memory")
#define PG8_BAR __builtin_amdgcn_s_barrier()
#define PG8_SCHED __builtin_amdgcn_sched_barrier(0)
    Unit cur, nxt; int ui = 0;
    if (!S.next(0, cur)) return;
    Acc acc;
#pragma unroll
    for (int a = 0; a < 2; ++a)
#pragma unroll
        for (int b = 0; b < 2; ++b)
#pragma unroll
            for (int m = 0; m < 4; ++m)
#pragma unroll
                for (int n = 0; n < 2; ++n) acc[a][b][m][n] = (f32x4){0.f, 0.f, 0.f, 0.f};
    bf16x8 At[4][2], B0[2][2], B1[2][2];
    const char* cA = S.baseA(cur, tstep); const char* cB = S.baseB(cur, tstep);
    PG8_STAGE(PG8_SB(0, 0), cB, voffB); PG8_STAGE(PG8_SB(0, 1), cB + hstep, voffB); PG8_STAGE(PG8_SA(0, 0), cA, voffA); PG8_STAGE(PG8_SA(0, 1), cA + hstep, voffA);
    if (wr == 1) PG8_BAR;
    PG8_WAIT_V(2); PG8_BAR;
    PG8_STAGE(PG8_SB(1, 0), cB + kstep, voffB); PG8_STAGE(PG8_SA(1, 0), cA + kstep, voffA); PG8_STAGE(PG8_SB(1, 1), cB + hstep + kstep, voffB);
    PG8_WAIT_V(6); PG8_BAR;
    for (;;) {
        const bool has_next = S.next(ui + 1, nxt);
        const char* nA = has_next ? S.baseA(nxt, tstep) : cA; const char* nB = has_next ? S.baseB(nxt, tstep) : cB;
        for (int t = 0; t < nt; t += 2) {
            const bool last = (t == nt - 2);
            const char* a1 = cA + (size_t)(t + 1) * kstep;
            const char* a2 = last ? nA : cA + (size_t)(t + 2) * kstep; const char* b2 = last ? nB : cB + (size_t)(t + 2) * kstep;
            const char* a3 = a2 + kstep; const char* b3 = b2 + kstep;
            PG8_LDB(B0, 0, 0); PG8_LDB(B1, 0, 1); PG8_SCHED; PG8_LDA(At, 0, 0); PG8_STAGE(PG8_SA(1, 1), a1 + hstep, voffA);
            PG8_WAIT_V(8); PG8_WAIT_L(0); PG8_BAR; PG8_MMA(0, 0, At, B0); PG8_MMA(0, 1, At, B1); PG8_BAR; PG8_SCHED;
            PG8_LDA(At, 0, 1); PG8_STAGE(PG8_SB(0, 0), b2, voffB); PG8_STAGE(PG8_SB(0, 1), b2 + hstep, voffB); PG8_STAGE(PG8_SA(0, 0), a2, voffA);
            PG8_WAIT_V(8); PG8_WAIT_L(0); PG8_BAR; PG8_MMA(1, 0, At, B0); PG8_MMA(1, 1, At, B1); PG8_BAR; PG8_SCHED;
            PG8_LDB(B0, 1, 0); PG8_LDB(B1, 1, 1); PG8_SCHED; PG8_LDA(At, 1, 0); PG8_STAGE(PG8_SA(0, 1), a2 + hstep, voffA);
            PG8_WAIT_V(8); PG8_WAIT_L(0); PG8_BAR; PG8_MMA(0, 0, At, B0); PG8_MMA(0, 1, At, B1); PG8_BAR; PG8_SCHED;
            PG8_LDA(At, 1, 1); PG8_STAGE(PG8_SB(1, 0), b3, voffB); PG8_STAGE(PG8_SB(1, 1), b3 + hstep, voffB); PG8_STAGE(PG8_SA(1, 0), a3, voffA);
            PG8_WAIT_V(8); PG8_WAIT_L(0); PG8_BAR; PG8_MMA(1, 0, At, B0); PG8_MMA(1, 1, At, B1); PG8_BAR; PG8_SCHED;
        }
        if (wr == 0) PG8_BAR;
        E(acc, cur, wr, wc, fr, fq);
        if (!has_next) break;
        if (!E.keep(cur)) {
#pragma unroll
            for (int a = 0; a < 2; ++a)
#pragma unroll
                for (int b = 0; b < 2; ++b)
#pragma unroll
                    for (int m = 0; m < 4; ++m)
#pragma unroll
                        for (int n = 0; n < 2; ++n) acc[a][b][m][n] = (f32x4){0.f, 0.f, 0.f, 0.f};
        }
        cur = nxt; cA = nA; cB = nB; ++ui;
        if (wr == 1) PG8_BAR;
    }
    PG8_WAIT_V(0);
    PG8_BAR;
#undef PG8_SA
#undef PG8_SB
#undef PG8_STAGE
#undef PG8_LDA
#undef PG8_LDB
#undef PG8_MMA
#undef PG8_WAIT_V
#undef PG8_WAIT_L
#undef PG8_BAR
#undef PG8_SCHED
}
}

struct Args {
    const float *x_prompt, *x_sample, *state_pool, *state_conv, *c_prompt, *c_sample, *w_ada, *b_ada, *w_in, *pool_grp_w, *pool_scale, *conv_w, *w_pool_up, *w_conv_up, *w_o,
        *ln1_g, *ln1_b, *w_ff1, *b_ff1, *w_ff2, *b_ff2, *ln2_g, *ln2_b;
    float* out; unsigned char* ws;
};

__device__ __forceinline__ float wave_sum(float v) {
#pragma unroll
    for (int o = 1; o < 64; o <<= 1) v += __shfl_xor(v, o);
    return v;
}

__device__ __forceinline__ void p0_transpose_item(const float* W, int K, int N, bf16_t* WT, LAS float* scr, int item, int lane) {
    const int nblk = N / 32, kb = item / nblk, nb = item % nblk, k0 = 64 * kb, n0 = 32 * nb;
    f32x4 v[8];
#pragma unroll
    for (int i = 0; i < 8; ++i) v[i] = __builtin_nontemporal_load((const f32x4*)(W + (size_t)(k0 + 8 * i + (lane >> 3)) * N + n0 + 4 * (lane & 7)));
#pragma unroll
    for (int i = 0; i < 8; ++i) { LAS float* d = scr + (8 * i + (lane >> 3)) * 33 + 4 * (lane & 7); d[0] = v[i][0]; d[1] = v[i][1]; d[2] = v[i][2]; d[3] = v[i][3]; }
    asm volatile("s_waitcnt lgkmcnt(0)" ::: "memory");
    const int c = lane & 7;
#pragma unroll
    for (int j = 0; j < 4; ++j) { const int n = (lane >> 3) + 8 * j; const LAS float* s = scr + (8 * c) * 33 + n;
        u32x4 o; o.x = pk2(s[0 * 33], s[1 * 33]); o.y = pk2(s[2 * 33], s[3 * 33]); o.z = pk2(s[4 * 33], s[5 * 33]); o.w = pk2(s[6 * 33], s[7 * 33]);
        *(u32x4*)(WT + (size_t)(n0 + n) * K + k0 + 8 * c) = o; }
    asm volatile("s_waitcnt lgkmcnt(0)" ::: "memory");
}

__device__ __forceinline__ void p0_ada_item(const Args& a, float* ada, LAS unsigned char* lds, int item, int wave, int lane) {
    const int n0 = item * 48, fr = lane & 15, kq = lane >> 4;
    f32x4 acc[9][3];
#pragma unroll
    for (int mt = 0; mt < 9; ++mt)
#pragma unroll
        for (int q = 0; q < 3; ++q) acc[mt][q] = (f32x4){0.f, 0.f, 0.f, 0.f};
    const float* const cr0 = fr < NB ? a.c_prompt + (size_t)fr * D : a.c_sample + (size_t)(fr - NB) * D;
    const float* const crm = a.c_sample + (size_t)(fr + 12) * D;
    const float* const cr8 = a.c_sample + (size_t)(124 + fr > NS - 1 ? NS - 1 : 124 + fr) * D;
#pragma unroll 2
    for (int ks = 0; ks < 8; ++ks) {
        const int k0 = wave * 256 + ks * 32 + kq * 8;
        float b[8][3];
#pragma unroll
        for (int j = 0; j < 8; ++j) { const float* p = a.w_ada + (size_t)(k0 + j) * NADA + n0 + 3 * fr; b[j][0] = __builtin_nontemporal_load(p); b[j][1] = __builtin_nontemporal_load(p + 1); b[j][2] = __builtin_nontemporal_load(p + 2); }
        bf16x8 bfr[3];
#pragma unroll
        for (int q = 0; q < 3; ++q) { u32x4 w; w.x = pk2(b[0][q], b[1][q]); w.y = pk2(b[2][q], b[3][q]); w.z = pk2(b[4][q], b[5][q]); w.w = pk2(b[6][q], b[7][q]); bfr[q] = __builtin_bit_cast(bf16x8, w); }
#pragma unroll
        for (int mt = 0; mt < 9; ++mt) {
            const float* cp = (mt == 0) ? cr0 : (mt == 8 ? cr8 : crm + (size_t)(mt - 1) * 16 * D);
            const f32x4 a0 = *(const f32x4*)(cp + k0), a1 = *(const f32x4*)(cp + k0 + 4);
            u32x4 w; w.x = pk2(a0[0], a0[1]); w.y = pk2(a0[2], a0[3]); w.z = pk2(a1[0], a1[1]); w.w = pk2(a1[2], a1[3]);
            const bf16x8 af = __builtin_bit_cast(bf16x8, w);
#pragma unroll
            for (int q = 0; q < 3; ++q) acc[mt][q] = __builtin_amdgcn_mfma_f32_16x16x32_bf16(af, bfr[q], acc[mt][q], 0, 0, 0);
            if (mt % 3 == 2) asm volatile("" ::: "memory");
        }
    }
    LAS float* red = (LAS float*)lds;
#pragma unroll
    for (int s = 4; s >= 1; s >>= 1) {
        if (wave >= s && wave < 2 * s) { LAS float* dst = red + (wave - s) * 6912 + lane;
#pragma unroll
            for (int mt = 0; mt < 9; ++mt)
#pragma unroll
                for (int q = 0; q < 3; ++q)
#pragma unroll
                    for (int j = 0; j < 4; ++j) dst[((mt * 3 + q) * 4 + j) * 64] = acc[mt][q][j]; }
        __syncthreads();
        if (wave < s) { const LAS float* src = red + wave * 6912 + lane;
#pragma unroll
            for (int mt = 0; mt < 9; ++mt)
#pragma unroll
                for (int q = 0; q < 3; ++q)
#pragma unroll
                    for (int j = 0; j < 4; ++j) acc[mt][q][j] += src[((mt * 3 + q) * 4 + j) * 64]; }
        __syncthreads();
    }
    if (wave == 0) {
#pragma unroll
        for (int q = 0; q < 3; ++q) { const int n = n0 + 3 * fr + q; const float bb = a.b_ada[n];
#pragma unroll
            for (int mt = 0; mt < 9; ++mt)
#pragma unroll
                for (int j = 0; j < 4; ++j) { const int r = mt * 16 + kq * 4 + j; if (r < NCOND) ada[(size_t)r * NADAP + item * 64 + 3 * fr + q] = acc[mt][q][j] + bb; } }
    }
}

__device__ __forceinline__ void p0_weff_item(const Args& a, bf16_t* WT, LAS unsigned char* lds, int item, int tid) {
    constexpr int AP = 260, BP = 80;
    const int g = item >> 7, it = (item >> 5) & 3, nt = item & 31, i0 = it * 64, n0 = nt * 64;
    LAS float* As = (LAS float*)lds;
    LAS float* Bs = (LAS float*)(lds + 66560);
#pragma unroll
    for (int r = 0; r < 8; ++r) { const int idx = tid + r * 512, row = idx >> 6, c4 = idx & 63;
        *(LAS f32x4*)(As + row * AP + c4 * 4) = *(const f32x4*)(a.pool_grp_w + ((size_t)(g * 256 + i0 + row)) * 256 + c4 * 4); }
    const int lane = tid & 63, wave = tid >> 6, fr = lane & 15, kq = lane >> 4, mt = wave >> 1, np = (wave & 1) * 2;
    f32x4 acc[2] = {(f32x4){0.f, 0.f, 0.f, 0.f}, (f32x4){0.f, 0.f, 0.f, 0.f}};
#pragma unroll 1
    for (int h = 0; h < 2; ++h) {
        __syncthreads();
#pragma unroll
        for (int r = 0; r < 4; ++r) { const int idx = tid + r * 512, o = idx >> 4, c4 = idx & 15;
            const float sc = a.pool_scale[g * 256 + h * 128 + o];
            *(LAS f32x4*)(Bs + o * BP + c4 * 4) = *(const f32x4*)(a.w_pool_up + (size_t)(g * 256 + h * 128 + o) * D + n0 + c4 * 4) * sc; }
        __syncthreads();
#pragma unroll 8
        for (int o4 = 0; o4 < 32; ++o4) {
            const float av = As[(mt * 16 + fr) * AP + h * 128 + o4 * 4 + kq];
            const float b0 = Bs[(o4 * 4 + kq) * BP + np * 16 + fr], b1 = Bs[(o4 * 4 + kq) * BP + np * 16 + 16 + fr];
            acc[0] = __builtin_amdgcn_mfma_f32_16x16x4f32(av, b0, acc[0], 0, 0, 0);
            acc[1] = __builtin_amdgcn_mfma_f32_16x16x4f32(av, b1, acc[1], 0, 0, 0);
        }
    }
#pragma unroll
    for (int t = 0; t < 2; ++t)
        *(u32x2*)(WT + (size_t)(n0 + (np + t) * 16 + fr) * PW + g * 256 + i0 + mt * 16 + kq * 4) = (u32x2){pk2(acc[t][0], acc[t][1]), pk2(acc[t][2], acc[t][3])};
    __syncthreads();
}

__device__ __forceinline__ void p1_modulate(const Args& a, const float* ada, bf16_t* U, int gw, int NGW, int lane) {
    if (NGW >= 2 * 8 * NS && (gw & 1) == 0 && (gw >> 1) < 8 * NS) {
        const int r = MP + (gw >> 4), c = ((gw >> 1) & 7) * 256 + 4 * lane;
        const float* ar = ada + (size_t)cond_row(r) * NADAP;
        const f32x4 v = *(const f32x4*)(a.x_sample + (size_t)(r - MP) * D + c) * (*(const f32x4*)(ar + adac(D + c)) + 1.f) + *(const f32x4*)(ar + adac(c));
        *(u32x2*)(U + (size_t)r * D + c) = (u32x2){pk2(v[0], v[1]), pk2(v[2], v[3])};
    }
    for (int r = gw; r < (NGW >= 2 * 8 * NS ? MP : MV); r += NGW) {
        u32x2* o8 = (u32x2*)(U + (size_t)r * D) + lane;
        const f32x4* xr = (const f32x4*)x_rowp(a.x_prompt, a.x_sample, r) + lane;
        const float* ar = ada + (size_t)cond_row(r) * NADAP;
#pragma unroll
        for (int j = 0; j < 8; ++j) { const int c = 4 * (lane + 64 * j); const f32x4 v = __builtin_nontemporal_load(xr + 64 * j) * (*(const f32x4*)(ar + adac(D + c)) + 1.f) + *(const f32x4*)(ar + adac(c));
            o8[64 * j] = (u32x2){pk2(v[0], v[1]), pk2(v[2], v[3])}; }
    }
}

__device__ __forceinline__ void p3_mixer(const Args& a, const bf16_t* proj, bf16_t* PRE, bf16_t* CIN, int tid) {
    const int j0 = 2 * tid, wave = tid >> 6, W = 2 << (wave >> 1);
    const f32x2 cw0 = *(const f32x2*)(a.conv_w + j0), cw1 = *(const f32x2*)(a.conv_w + CW + j0), cw2 = *(const f32x2*)(a.conv_w + 2 * CW + j0);
    float* const npp = a.out + O_NPP; float* const ncp = a.out + O_NCP; float* const nps = a.out + O_NPS; float* const ncs = a.out + O_NCS;
    for (int it = blockIdx.x; it < 384; it += gridDim.x) {
        if (it < 256) {
            const int b = it >> 6, s0 = (it & 63) * 32;
            const bf16_t* pb = proj + (size_t)(b * SEQ) * INW + j0;
            float S0 = 0.f, S1 = 0.f;
            for (int i = 1; i < W; ++i) { const int s = s0 - i; if (s >= 0) { const unsigned w = *(const unsigned*)(pb + (size_t)s * INW); S0 += bflo(w); S1 += bfhi(w); } }
            float v1a = 0.f, v1b = 0.f, v2a = 0.f, v2b = 0.f;
            if (s0 >= 1) { const bf16_t* p = pb + (size_t)(s0 - 1) * INW; const unsigned wx = *(const unsigned*)(p + 1024), wc = *(const unsigned*)(p + 3072); v1a = bflo(wc) * bflo(wx); v1b = bfhi(wc) * bfhi(wx); }
            if (s0 >= 2) { const bf16_t* p = pb + (size_t)(s0 - 2) * INW; const unsigned wx = *(const unsigned*)(p + 1024), wc = *(const unsigned*)(p + 3072); v2a = bflo(wc) * bflo(wx); v2b = bfhi(wc) * bfhi(wx); }
#pragma unroll 4
            for (int s = s0; s < s0 + 32; ++s) {
                const bf16_t* p = pb + (size_t)s * INW;
                const unsigned wz = *(const unsigned*)p, wx = *(const unsigned*)(p + 1024), wb = *(const unsigned*)(p + 2048), wc = *(const unsigned*)(p + 3072);
                const float z0 = bflo(wz), z1 = bfhi(wz);
                S0 += z0; S1 += z1;
                const int cnt = (s + 1 < W) ? s + 1 : W; const float fc = (float)cnt;
                const float p0 = S0 / fc - z0, p1 = S1 / fc - z1;
                const int so = s - W + 1;
                if (so >= 0) { const unsigned wo = *(const unsigned*)(pb + (size_t)so * INW); S0 -= bflo(wo); S1 -= bfhi(wo); }
                const float va = bflo(wc) * bflo(wx), vb = bfhi(wc) * bfhi(wx);
                const float ya = cw0[0] * v2a + cw1[0] * v1a + cw2[0] * va, yb = cw0[1] * v2b + cw1[1] * v1b + cw2[1] * vb;
                const size_t row = (size_t)(b * SEQ + s);
                *(unsigned*)(PRE + row * PW + j0) = pk2(p0, p1);
                *(unsigned*)(CIN + row * CW + j0) = pk2(bflo(wb) * ya, bfhi(wb) * yb);
                if (s >= SEQ - 15) *(f32x2*)(npp + ((size_t)(b * 15 + s - (SEQ - 15))) * PW + j0) = (f32x2){z0, z1};
                if (s >= SEQ - 2) *(f32x2*)(ncp + ((size_t)(b * 2 + s - (SEQ - 2))) * CW + j0) = (f32x2){va, vb};
                v2a = v1a; v2b = v1b; v1a = va; v1b = vb;
            }
        } else {
            const int b = it - 256; const size_t row = (size_t)(MP + b);
            const bf16_t* p = proj + row * INW + j0;
            const unsigned wz = *(const unsigned*)p, wx = *(const unsigned*)(p + 1024), wb = *(const unsigned*)(p + 2048), wc = *(const unsigned*)(p + 3072);
            const float z0 = bflo(wz), z1 = bfhi(wz);
            const float* sp = a.state_pool + (size_t)b * 15 * PW + j0;
            float S0 = z0, S1 = z1;
            for (int i = 1; i < W; ++i) { const f32x2 h = *(const f32x2*)(sp + (size_t)(15 - i) * PW); S0 += h[0]; S1 += h[1]; }
            const float fc = (float)W;
            *(unsigned*)(PRE + row * PW + j0) = pk2(S0 / fc - z0, S1 / fc - z1);
            const f32x2 h0 = *(const f32x2*)(a.state_conv + (size_t)(b * 2) * CW + j0), h1 = *(const f32x2*)(a.state_conv + (size_t)(b * 2 + 1) * CW + j0);
            const float va = bflo(wc) * bflo(wx), vb = bfhi(wc) * bfhi(wx);
            const float ya = cw0[0] * h0[0] + cw1[0] * h1[0] + cw2[0] * va, yb = cw0[1] * h0[1] + cw1[1] * h1[1] + cw2[1] * vb;
            *(unsigned*)(CIN + row * CW + j0) = pk2(bflo(wb) * ya, bfhi(wb) * yb);
#pragma unroll
            for (int r = 0; r < 14; ++r) *(f32x2*)(nps + ((size_t)(b * 15 + r)) * PW + j0) = *(const f32x2*)(sp + (size_t)(r + 1) * PW);
            *(f32x2*)(nps + ((size_t)(b * 15 + 14)) * PW + j0) = (f32x2){z0, z1};
            *(f32x2*)(ncs + ((size_t)(b * 2)) * CW + j0) = h1;
            *(f32x2*)(ncs + ((size_t)(b * 2 + 1)) * CW + j0) = (f32x2){va, vb};
        }
    }
}

__device__ __forceinline__ void ln_row(f32x4 (&v)[8], const float* g, const float* b, int lane) {
    float s = 0.f;
#pragma unroll
    for (int j = 0; j < 8; ++j) s += (v[j][0] + v[j][1]) + (v[j][2] + v[j][3]);
    const float mean = wave_sum(s) * (1.f / D); float s2 = 0.f;
#pragma unroll
    for (int j = 0; j < 8; ++j) { v[j] = v[j] - mean; s2 += (v[j][0] * v[j][0] + v[j][1] * v[j][1]) + (v[j][2] * v[j][2] + v[j][3] * v[j][3]); }
    const float rstd = 1.f / sqrtf(wave_sum(s2) * (1.f / D) + LN_EPS);
    const f32x4* g4 = (const f32x4*)g + lane; const f32x4* b4 = (const f32x4*)b + lane;
#pragma unroll
    for (int j = 0; j < 8; ++j) v[j] = v[j] * rstd * g4[64 * j] + b4[64 * j];
}
__device__ __forceinline__ void p6_ln1(const Args& a, const float* ada, float* res, const float* part, bf16_t* U, int gw, int NGW, int lane) {
    for (int r = gw, nr; r >= 0; r = nr) { nr = -1; if (r < MP) { nr = r + NGW; if (nr >= MP) nr = ((gw & 15) == 0 && (gw >> 4) < NS && NGW >= 16 * NS) ? MP + (gw >> 4) : ((NGW >= 16 * NS) ? -1 : (nr < MV ? nr : -1)); } else if (NGW < 16 * NS) { nr = r + NGW; if (nr >= MV) nr = -1; }
        u32x2* o8 = (u32x2*)(U + (size_t)r * D) + lane;
        f32x4* rr = (f32x4*)(res + (size_t)r * D) + lane;
        const float* ar = ada + (size_t)cond_row(r) * NADAP;
        f32x4 v[8];
        if (r < MP) {
#pragma unroll
            for (int j = 0; j < 8; ++j) v[j] = rr[64 * j];
        } else {
            const f32x4* xr = (const f32x4*)(a.x_sample + (size_t)(r - MP) * D) + lane;
#pragma unroll
            for (int j = 0; j < 8; ++j) { f32x4 sum = (f32x4){0.f, 0.f, 0.f, 0.f};
#pragma unroll
                for (int sl = 0; sl < 8; ++sl) sum += ((const f32x4*)(part + ((size_t)sl * NS + (r - MP)) * D) + lane)[64 * j];
                v[j] = xr[64 * j] * ALPHA + *(const f32x4*)(ar + adac(2 * D + 4 * (lane + 64 * j))) * sum; }
        }
        ln_row(v, a.ln1_g, a.ln1_b, lane);
#pragma unroll
        for (int j = 0; j < 8; ++j) { const int c = 4 * (lane + 64 * j); rr[64 * j] = v[j]; const f32x4 t = v[j] * (*(const f32x4*)(ar + adac(4 * D + c)) + 1.f) + *(const f32x4*)(ar + adac(3 * D + c));
            o8[64 * j] = (u32x2){pk2(t[0], t[1]), pk2(t[2], t[3])}; }
    }
}
__device__ __forceinline__ void p9_ln2(const Args& a, const float* ada, const float* res, const float* part, int gw, int NGW, int lane) {
    for (int r = gw, nr; r >= 0; r = nr) { nr = -1; if (r < MP) { nr = r + NGW; if (nr >= MP) nr = ((gw & 15) == 0 && (gw >> 4) < NS && NGW >= 16 * NS) ? MP + (gw >> 4) : ((NGW >= 16 * NS) ? -1 : (nr < MV ? nr : -1)); } else if (NGW < 16 * NS) { nr = r + NGW; if (nr >= MV) nr = -1; }
        const f32x4* rr = (const f32x4*)(res + (size_t)r * D) + lane;
        f32x4 v[8];
#pragma unroll
        for (int j = 0; j < 8; ++j) v[j] = rr[64 * j];
        if (r >= MP) {
            const float* ar = ada + (size_t)cond_row(r) * NADAP;
#pragma unroll
            for (int j = 0; j < 8; ++j) { f32x4 sum = *((const f32x4*)a.b_ff2 + lane + 64 * j);
#pragma unroll
                for (int sl = 0; sl < 8; ++sl) sum += ((const f32x4*)(part + ((size_t)sl * NS + (r - MP)) * D) + lane)[64 * j];
                v[j] = v[j] * ALPHA + *(const f32x4*)(ar + adac(5 * D + 4 * (lane + 64 * j))) * sum; }
        }
        ln_row(v, a.ln2_g, a.ln2_b, lane);
        f32x4* o = (f32x4*)(a.out + (r < MP ? O_YP + (size_t)r * D : O_YS + (size_t)(r - MP) * D)) + lane;
#pragma unroll
        for (int j = 0; j < 8; ++j) o[64 * j] = v[j];
    }
}

typedef f32x4 Acc128[4][2];
__device__ __forceinline__ void gemm128_core(Acc128& acc, LAS unsigned char* lds, const bf16_t* A, const bf16_t* Bt, const int K  , const int klen  ) {
    using namespace pg8;
    const int tid = threadIdx.x, wid = __builtin_amdgcn_readfirstlane(tid >> 6), lane = tid & 63, wr = wid >> 2, wc = wid & 3, fr = lane & 15, fq = lane >> 4;
    const int nt = klen / 64;
    unsigned voff[2];
#pragma unroll
    for (int i = 0; i < 2; ++i) { int R, C; stage_rc(tid * 16 + i * 8192, R, C); voff[i] = (unsigned)(R * K + C) * 2u; }
    const unsigned ldsw = (unsigned)wid * 1024u;
    const int aoff = lds_byte(wr * 64 + fr, fq * 8), boff = lds_byte(wc * 32 + fr, fq * 8);
    const char* pa = (const char*)A; const char* pb = (const char*)Bt;
#define G128_STAGE(st, kt) do { _Pragma("unroll") for (int _i = 0; _i < 2; ++_i) { \
        __builtin_amdgcn_global_load_lds((const unsigned*)(pa + (size_t)(kt) * 128 + voff[_i]), (LAS unsigned*)(lds + (st) * 32768 + ldsw + _i * 8192), 16, 0, 0); \
        __builtin_amdgcn_global_load_lds((const unsigned*)(pb + (size_t)(kt) * 128 + voff[_i]), (LAS unsigned*)(lds + (st) * 32768 + 16384 + ldsw + _i * 8192), 16, 0, 0); } } while (0)
    G128_STAGE(0, 0); G128_STAGE(1, 1 < nt ? 1 : nt - 1); G128_STAGE(2, 2 < nt ? 2 : nt - 1);
#pragma unroll 1
    for (int t = 0; t < nt; ++t) {
        asm volatile("s_waitcnt vmcnt(8)" ::: "memory");
        __builtin_amdgcn_s_barrier();
        asm volatile("" ::: "memory");
        { const int kt = t + 3 < nt ? t + 3 : nt - 1; G128_STAGE((t + 3) & 3, kt); }
        const LAS unsigned char* sa = lds + (t & 3) * 32768; const LAS unsigned char* sb = sa + 16384;
        bf16x8 af[4][2], bfr[2][2];
#pragma unroll
        for (int m = 0; m < 4; ++m)
#pragma unroll
            for (int k = 0; k < 2; ++k) af[m][k] = *(const LAS bf16x8*)(sa + aoff + m * 2048 + k * 1024);
#pragma unroll
        for (int n = 0; n < 2; ++n)
#pragma unroll
            for (int k = 0; k < 2; ++k) bfr[n][k] = *(const LAS bf16x8*)(sb + boff + n * 2048 + k * 1024);
#pragma unroll
        for (int m = 0; m < 4; ++m)
#pragma unroll
            for (int n = 0; n < 2; ++n)
#pragma unroll
                for (int k = 0; k < 2; ++k) acc[m][n] = __builtin_amdgcn_mfma_f32_16x16x32_bf16(bfr[n][k], af[m][k], acc[m][n], 0, 0, 0);
        asm volatile("s_waitcnt lgkmcnt(0)" ::: "memory");
    }
    asm volatile("s_waitcnt vmcnt(0)" ::: "memory");
    __builtin_amdgcn_s_barrier();
    asm volatile("" ::: "memory");
#undef G128_STAGE
}
__device__ __forceinline__ void zero128(Acc128& acc) {
#pragma unroll
    for (int m = 0; m < 4; ++m)
#pragma unroll
        for (int n = 0; n < 2; ++n) acc[m][n] = (f32x4){0.f, 0.f, 0.f, 0.f};
}
template <int MODE>
__device__ __forceinline__ void sample_gemm(const Args& a, LAS unsigned char* lds, const bf16_t* A0, const bf16_t* B0, const bf16_t* A1, const bf16_t* B1, const int K, const int N,
                                            const bf16_t* proj, bf16_t* Ob, float* res, const float* ada) {
    const int tid = threadIdx.x, wid = __builtin_amdgcn_readfirstlane(tid >> 6), lane = tid & 63, wr = wid >> 2, wc = wid & 3, fr = lane & 15, fq = lane >> 4;
    constexpr int NSL = (MODE >= 3) ? 8 : 1;
    for (int unit = blockIdx.x; unit < (N / 128) * NSL; unit += gridDim.x) {
        const int n0 = (unit / NSL) * 128, sl = unit % NSL, klen = K / NSL;
        Acc128 acc, acc2;
        zero128(acc);
        gemm128_core(acc, lds, A0 + (size_t)MP * K + sl * klen, B0 + (size_t)n0 * K + sl * klen, K, klen);
        if (MODE == 2) { zero128(acc2); gemm128_core(acc2, lds, A1 + (size_t)MP * K, B1 + (size_t)n0 * K, K, K); }
#pragma unroll
        for (int m = 0; m < 4; ++m) { const int ms = wr * 64 + m * 16 + fr; const size_t row = (size_t)(MP + ms);
#pragma unroll
            for (int n = 0; n < 2; ++n) { const int c = n0 + wc * 32 + n * 16 + 4 * fq; f32x4 v = acc[m][n];
                if (MODE == 0) { *(u32x2*)(Ob + row * INW + c) = (u32x2){pk2(v[0], v[1]), pk2(v[2], v[3])}; }
                else if (MODE == 1) { v = v + *(const f32x4*)(a.b_ff1 + c);
#pragma unroll
                    for (int j = 0; j < 4; ++j) { const float r = fmaxf(v[j], 0.f); v[j] = r * r; }
                    *(u32x2*)(Ob + row * DFF + c) = (u32x2){pk2(v[0], v[1]), pk2(v[2], v[3])}; }
                else if (MODE == 2) {
                    const u32x2 gpw = *(const u32x2*)(proj + row * INW + 4096 + c), gcw = *(const u32x2*)(proj + row * INW + 6144 + c);
                    const float gp[4] = {bflo(gpw.x), bfhi(gpw.x), bflo(gpw.y), bfhi(gpw.y)}, gc[4] = {bflo(gcw.x), bfhi(gcw.x), bflo(gcw.y), bfhi(gcw.y)};
                    float o[4];
#pragma unroll
                    for (int j = 0; j < 4; ++j) o[j] = v[j] / (1.f + __expf(-gp[j])) + acc2[m][n][j] / (1.f + __expf(-gc[j]));
                    *(u32x2*)(Ob + row * D + c) = (u32x2){pk2(o[0], o[1]), pk2(o[2], o[3])}; }
                else { *(f32x4*)(res + ((size_t)sl * NS + ms) * D + c) = v; }
            } }
    }
}

#define XB_TMO      128
#define XB_XCNT(j)  (256  + 64 * (j))
#define XB_XSUB(j)  (1280 + 64 * (j))
#define XB_XGEN(j)  (2304 + 64 * (j))
#define XB_TOP      3328
#define XB_TOPGEN   3392
#define XCD_BAR_WORDS 3456
#define XB_SPIN_CAP (1u << 18)
__device__ __forceinline__ unsigned xb_ld(unsigned* p)              { return __hip_atomic_load(p, __ATOMIC_RELAXED, __HIP_MEMORY_SCOPE_AGENT); }
__device__ __forceinline__ unsigned xb_add(unsigned* p, unsigned v) { return __hip_atomic_fetch_add(p, v, __ATOMIC_RELAXED, __HIP_MEMORY_SCOPE_AGENT); }
__device__ __forceinline__ unsigned xb_xcc_id() { return (unsigned)__builtin_amdgcn_s_getreg((3 << 11) | 20) & 0xFu; }
#define XB_SPIN(cond, bar) do { unsigned _sp = 0; while (cond) { __builtin_amdgcn_s_sleep(1); \
    if ((++_sp & 255u) == 0u) { if (xb_ld(&(bar)[XB_TMO])) break; if (_sp > XB_SPIN_CAP) { atomicAdd(&(bar)[XB_TMO], 1u); break; } } } } while (0)
struct XcdBarrier { unsigned* bar; unsigned x; volatile LAS unsigned* st; };
__device__ __forceinline__ XcdBarrier xcd_barrier_post(unsigned* bar, volatile LAS unsigned* st) {
    XcdBarrier b; b.bar = bar; b.x = xb_xcc_id(); b.st = st;
    if (threadIdx.x == 0) (void)xb_add(&bar[XB_XCNT(b.x)], 1u);
    return b;
}
__device__ __forceinline__ void xcd_barrier_complete(unsigned* bar, unsigned x, unsigned& nloc, unsigned& nx) {
    const unsigned G = gridDim.x * gridDim.y * gridDim.z;
    unsigned sum, cnt, mine, sp = 0u;
    for (;;) {
        sum = 0u; cnt = 0u; mine = 0u;
#pragma unroll
        for (unsigned j = 0; j < 16; ++j) { const unsigned c = xb_ld(&bar[XB_XCNT(j)]); sum += c; cnt += (c > 0u) ? 1u : 0u; mine = (j == x) ? c : mine; }
        if (sum == G) break;
        __builtin_amdgcn_s_sleep(1);
        if ((++sp & 255u) == 0u) { if (xb_ld(&bar[XB_TMO])) break; if (sp > XB_SPIN_CAP) { atomicAdd(&bar[XB_TMO], 1u); break; } }
    }
    nloc = mine > 0u ? mine : 1u; nx = cnt > 0u ? cnt : 1u;
}
__device__ __forceinline__ void xcd_barrier(const XcdBarrier& b) {
    asm volatile("s_waitcnt vmcnt(0)" ::: "memory");
    __syncthreads();
    if (threadIdx.x == 0) {
        unsigned* bar = b.bar;
        __builtin_amdgcn_s_waitcnt(0);
        unsigned nloc = b.st[0], nx = b.st[1];
        if (nloc == 0u) { xcd_barrier_complete(bar, b.x, nloc, nx); b.st[0] = nloc; b.st[1] = nx; }
        const unsigned old = xb_add(&bar[XB_XSUB(b.x)], 1u);
        const unsigned gen = old / nloc;
        if (old + 1u == (gen + 1u) * nloc) {
            __builtin_amdgcn_fence(__ATOMIC_RELEASE, "agent");
            asm volatile("s_waitcnt vmcnt(0)" ::: "memory");
            const unsigned og = xb_add(&bar[XB_TOP], 1u);
            const unsigned tg = og / nx;
            if (og + 1u == (tg + 1u) * nx) xb_add(&bar[XB_TOPGEN], 1u);
            else XB_SPIN(xb_ld(&bar[XB_TOPGEN]) == tg, bar);
            __builtin_amdgcn_fence(__ATOMIC_ACQUIRE, "agent");
            xb_add(&bar[XB_XGEN(b.x)], 1u);
            asm volatile("s_waitcnt vmcnt(0)" ::: "memory");
        } else {
            XB_SPIN(xb_ld(&bar[XB_XGEN(b.x)]) == gen, bar);
            __builtin_amdgcn_fence(__ATOMIC_ACQUIRE, "agent");
            asm volatile("s_waitcnt vmcnt(0)" ::: "memory");
        }
    }
    __syncthreads();
}

__device__ __forceinline__ void p0_all(const Args& a, LAS unsigned char* lds, int tid, int lane, int wave, int bx, int G) {
    unsigned char* ws = a.ws;
    float* ada = (float*)(ws + WS_ADA);
    bf16_t* WinT = (bf16_t*)(ws + WS_WIN); bf16_t* Wff1T = (bf16_t*)(ws + WS_WFF1); bf16_t* Wff2T = (bf16_t*)(ws + WS_WFF2); bf16_t* WoT = (bf16_t*)(ws + WS_WO);
    bf16_t* WupP = (bf16_t*)(ws + WS_WUPP); bf16_t* WupC = (bf16_t*)(ws + WS_WUPC);
    const int gw = bx * 8 + wave, NGW = G * 8;
    for (int it = bx; it < NADA / 48; it += G) p0_ada_item(a, ada, lds, it, wave, lane);
    for (int it = bx; it < 512; it += G) p0_weff_item(a, WupP, lds, it, tid);
    {
        LAS float* scr = (LAS float*)(lds + wave * 16384);
        constexpr int I_IN = (D / 64) * (INW / 32), I_F1 = (D / 64) * (DFF / 32), I_F2 = (DFF / 64) * (D / 32), I_O = (D / 64) * (D / 32), I_C = (CW / 64) * (D / 32);
        constexpr int NIT = I_IN + I_F1 + I_F2 + I_O + I_C;
        for (int it = gw; it < NIT; it += NGW) {
            int r = it;
            if (r < I_IN) { p0_transpose_item(a.w_in, D, INW, WinT, scr, r, lane); continue; } r -= I_IN;
            if (r < I_F1) { p0_transpose_item(a.w_ff1, D, DFF, Wff1T, scr, r, lane); continue; } r -= I_F1;
            if (r < I_F2) { p0_transpose_item(a.w_ff2, DFF, D, Wff2T, scr, r, lane); continue; } r -= I_F2;
            if (r < I_O) { p0_transpose_item(a.w_o, D, D, WoT, scr, r, lane); continue; } r -= I_O;
            p0_transpose_item(a.w_conv_up, CW, D, WupC, scr, r, lane);
        }
    }
}

__global__ void __launch_bounds__(512, 2) fwd_megakernel(Args a) {
    extern __shared__ __attribute__((aligned(16))) unsigned char lds_raw[];
    LAS unsigned char* lds = (LAS unsigned char*)lds_raw;
    const int tid = threadIdx.x, lane = tid & 63, wave = __builtin_amdgcn_readfirstlane(tid >> 6);
    const int G = gridDim.x, bx = blockIdx.x;
    const int gw = bx * 8 + wave, NGW = G * 8;
    unsigned char* ws = a.ws;
    float* ada = (float*)(ws + WS_ADA);
    unsigned* ctr = (unsigned*)(ws + WS_CTL);
    if (tid < 64) ((LAS unsigned*)(lds + MISC_OFF))[tid] = 0u;
    __syncthreads();
    const XcdBarrier xbar = xcd_barrier_post(ctr, (volatile LAS unsigned*)(lds + MISC_OFF));
#define GB() xcd_barrier(xbar)
    bf16_t* WinT = (bf16_t*)(ws + WS_WIN); bf16_t* Wff1T = (bf16_t*)(ws + WS_WFF1); bf16_t* Wff2T = (bf16_t*)(ws + WS_WFF2); bf16_t* WoT = (bf16_t*)(ws + WS_WO);
    bf16_t* WupP = (bf16_t*)(ws + WS_WUPP); bf16_t* WupC = (bf16_t*)(ws + WS_WUPC);
    bf16_t* U = (bf16_t*)(ws + WS_U); bf16_t* PROJ = (bf16_t*)(ws + WS_PROJ); float* RES = (float*)(ws + WS_RES);
    float* PART = (float*)(ws + WS_PART);
    bf16_t* PRE = (bf16_t*)(ws + WS_RES); bf16_t* CIN = (bf16_t*)(ws + WS_RES + WS_CIN_OFF);

    p0_all(a, lds, tid, lane, wave, bx, G);
    GB();
    p1_modulate(a, ada, U, gw, NGW, lane);
    GB();
    { pg8::Order S; S.init(MP, INW, G, bx, 1, U, WinT, U, WinT);
      pg8::EpiBf16<0> E{PROJ, INW, nullptr};
      pg8::gemm_phase(lds, D, S, E); }
    sample_gemm<0>(a, lds, U, WinT, U, WinT, D, INW, PROJ, PROJ, RES, ada);
    GB();
    p3_mixer(a, PROJ, PRE, CIN, tid);
    GB();
    { pg8::Order S; S.init(MP, D, G, bx, 2, PRE, WupP, CIN, WupC);
      pg8::EpiGate E{PROJ, U};
      pg8::gemm_phase(lds, PW, S, E); }
    sample_gemm<2>(a, lds, PRE, WupP, CIN, WupC, PW, D, PROJ, U, RES, ada);
    GB();
    { pg8::Order S; S.init(MP, D, G, bx, 1, U, WoT, U, WoT);
      pg8::EpiRes E{RES, a.x_prompt, ada, 2 * D, nullptr};
      pg8::gemm_phase(lds, D, S, E); }
    sample_gemm<3>(a, lds, U, WoT, U, WoT, D, D, PROJ, U, PART, ada);
    GB();
    p6_ln1(a, ada, RES, PART, U, gw, NGW, lane);
    GB();
    { pg8::Order S; S.init(MP, DFF, G, bx, 1, U, Wff1T, U, Wff1T);
      pg8::EpiBf16<1> E{PROJ, DFF, a.b_ff1};
      pg8::gemm_phase(lds, D, S, E); }
    sample_gemm<1>(a, lds, U, Wff1T, U, Wff1T, D, DFF, PROJ, PROJ, RES, ada);
    GB();
    { pg8::Order S; S.init(MP, D, G, bx, 1, PROJ, Wff2T, PROJ, Wff2T);
      pg8::EpiRes E{RES, RES, ada, 5 * D, a.b_ff2};
      pg8::gemm_phase(lds, DFF, S, E); }
    sample_gemm<4>(a, lds, PROJ, Wff2T, PROJ, Wff2T, DFF, D, PROJ, U, PART, ada);
    GB();
    p9_ln2(a, ada, RES, PART, gw, NGW, lane);
}

extern "C" void kernel_launch(void* const* d_in, const int* in_sizes, int n_in, void* d_out, int out_size, void* d_ws, size_t ws_size, hipStream_t stream) {
    static int grid = 0;
    if (grid == 0) {
        if (n_in != 23 || ws_size < WS_END) { fprintf(stderr, "kernel_launch: expected 23 inputs and >= %zu bytes of workspace; got %d, %zu\n", (size_t)WS_END, n_in, ws_size); grid = -1; return; }
        int dev = 0, cus = 0, per_cu = 0;
        hipGetDevice(&dev);
        hipDeviceGetAttribute(&cus, hipDeviceAttributeMultiprocessorCount, dev);
        if (hipFuncSetAttribute((const void*)fwd_megakernel, hipFuncAttributeMaxDynamicSharedMemorySize, LDS_BYTES) != hipSuccess) { fprintf(stderr, "kernel_launch: hipFuncSetAttribute failed\n"); grid = -1; return; }
        if (hipOccupancyMaxActiveBlocksPerMultiprocessor(&per_cu, (const void*)fwd_megakernel, 512, LDS_BYTES) != hipSuccess || per_cu < 1) { fprintf(stderr, "kernel_launch: occupancy query says %d blocks per CU\n", per_cu); (void)hipGetLastError(); per_cu = 1; }
        grid = cus;
        fprintf(stderr, "kernel_launch: cus %d per_cu %d grid %d\n", cus, per_cu, grid);
    }
    if (grid < 0) return;
    if (hipMemsetAsync((char*)d_ws + WS_CTL, 0, 16384, stream) != hipSuccess) { fprintf(stderr, "kernel_launch: memset failed\n"); return; }
    Args a{};
    const float** ap = (const float**)&a;
    for (int i = 0; i < 23; ++i) ap[i] = (const float*)d_in[i];
    a.out = (float*)d_out; a.ws = (unsigned char*)d_ws;
    void* args[] = {&a};
    hipError_t e = hipLaunchCooperativeKernel((const void*)fwd_megakernel, dim3(grid), dim3(512), args, LDS_BYTES, stream);
    if (e != hipSuccess) fprintf(stderr, "kernel_launch: cooperative launch failed: %s (grid %d)\n", hipGetErrorString(e), grid);
}
```

```cpp
#include <hip/hip_runtime.h>
#include <cstdio>
#include <cstdint>

#define LAS __attribute__((address_space(3)))
typedef unsigned short bf16_t;
typedef short bf16x8 __attribute__((ext_vector_type(8)));
typedef float f32x4 __attribute__((ext_vector_type(4)));
typedef float f32x2 __attribute__((ext_vector_type(2)));
typedef unsigned u32x4 __attribute__((ext_vector_type(4)));
typedef unsigned u32x2 __attribute__((ext_vector_type(2)));

constexpr int D = 2048, NB = 4, SEQ = 2048, NS = 128;
constexpr int MP = NB * SEQ;
constexpr int MV = MP + NS;
constexpr int MPAD = 8448;
constexpr int PW = 1024, CW = 1024, DFF = 8192, INW = 8192, NADA = 6 * D, NCOND = NB + NS;
constexpr float ALPHA = 1.18920711500272f;
constexpr float LN_EPS = 1e-5f;
constexpr int NADAP = 256 * 64;
__device__ __forceinline__ int adac(int n) { return n + 16 * (n / 48); }

constexpr size_t MiB = 1u << 20;
constexpr size_t WS_CTL = 0;
constexpr size_t WS_ADA = 352 * MiB;
constexpr size_t WS_WIN = 8 * MiB, WS_WFF1 = 40 * MiB, WS_WFF2 = 72 * MiB, WS_WO = 104 * MiB, WS_WUPP = 112 * MiB, WS_WUPC = 116 * MiB;
constexpr size_t WS_U = 120 * MiB;
constexpr size_t WS_PROJ = 153 * MiB;
constexpr size_t WS_RES = 285 * MiB;
constexpr size_t WS_PART = 362 * MiB;
constexpr size_t WS_END = 378 * MiB;
constexpr size_t WS_CIN_OFF = (size_t)MPAD * 1024 * 2;

constexpr size_t O_YP = 0, O_YS = (size_t)MP * D, O_NPP = O_YS + (size_t)NS * D, O_NCP = O_NPP + (size_t)NB * 15 * PW, O_NPS = O_NCP + (size_t)NB * 2 * CW, O_NCS = O_NPS + (size_t)NS * 15 * PW;

constexpr int LDS_BYTES = 131072 + 256, MISC_OFF = 131072;

__device__ __forceinline__ unsigned f2bf(float f) { unsigned u = __builtin_bit_cast(unsigned, f); return (u + 0x7fffu + ((u >> 16) & 1u)) >> 16; }
__device__ __forceinline__ unsigned pk2(float lo, float hi) { return f2bf(lo) | (f2bf(hi) << 16); }
__device__ __forceinline__ unsigned cvt_pk_bf16(float lo, float hi) { unsigned r; asm volatile("v_cvt_pk_bf16_f32 %0, %1, %2" : "=v"(r) : "v"(lo), "v"(hi)); return r; }
__device__ __forceinline__ float bflo(unsigned w) { return __builtin_bit_cast(float, w << 16); }
__device__ __forceinline__ float bfhi(unsigned w) { return __builtin_bit_cast(float, w & 0xffff0000u); }
__device__ __forceinline__ int cond_row(int r) { int s = r - MP; s = s < 0 ? 0 : (s > NS - 1 ? NS - 1 : s); return r < MP ? (r >> 11) : NB + s; }
__device__ __forceinline__ const float* x_rowp(const float* xp, const float* xs, int r) { int s = r - MP; s = s < 0 ? 0 : (s > NS - 1 ? NS - 1 : s); return r < MP ? xp + (size_t)r * D : xs + (size_t)s * D; }

namespace pg8 {
constexpr int BM = 256, BK = 64, HALF = 128, HTB = HALF * BK * 2, NXCD = 8, WGM = 8;
__device__ __forceinline__ int lds_byte(int r, int c) { const int st = (r >> 4) * 2 + (c >> 5), rr = r & 15, cc = c & 31, ob = rr * 64 + cc * 2; return st * 1024 + (ob ^ (((ob >> 9) & 1) << 5)); }
__device__ __forceinline__ void stage_rc(int b, int& R, int& C) { const int st = b / 1024, sb = b % 1024, swz = sb ^ (((sb >> 9) & 1) << 5); R = (st >> 1) * 16 + swz / 64; C = (st & 1) * 32 + (swz % 64) / 2; }
__device__ __forceinline__ int perm32(int rho) { const int n = rho >> 4, i = rho & 15; return 8 * (i >> 2) + 4 * n + (i & 3); }

struct Unit { int pm, pn, grp; };
struct Order {
    int nM, nN, nwg, G, c, rep;
    const char* A0; const char* B0; const char* A1; const char* B1;
    __device__ __forceinline__ void init(int M, int N, int G_, int c_, int rep_, const void* a0, const void* b0, const void* a1, const void* b1) {
        nM = M / BM; nN = N / BM; nwg = nM * nN; G = G_; c = c_; rep = rep_; A0 = (const char*)a0; B0 = (const char*)b0; A1 = (const char*)a1; B1 = (const char*)b1; }
    __device__ __forceinline__ bool next(int i, Unit& u) const {
        const int ti = (rep == 2) ? (i >> 1) : i; u.grp = (rep == 2) ? (i & 1) : 0;
        const long L = (long)ti * G + c; if (L >= nwg) return false;
        int wgid = (int)L; { const int q = nwg / NXCD, r = nwg % NXCD, xcd = wgid % NXCD, off = wgid / NXCD; wgid = (xcd < r ? xcd * (q + 1) : r * (q + 1) + (xcd - r) * q) + off; }
        const int nig = WGM * nN, gid = wgid / nig, fm = gid * WGM, gsz = (nM - fm) < WGM ? (nM - fm) : WGM;
        u.pm = fm + ((wgid % nig) % gsz); u.pn = (wgid % nig) / gsz; return true;
    }
    __device__ __forceinline__ const char* baseA(const Unit& u, size_t tstep) const { return (u.grp ? A1 : A0) + (size_t)u.pm * tstep; }
    __device__ __forceinline__ const char* baseB(const Unit& u, size_t tstep) const { return (u.grp ? B1 : B0) + (size_t)u.pn * tstep; }
};

typedef f32x4 Acc[2][2][4][2];

template <int ACT> struct EpiBf16 {
    static constexpr bool PERM = true;
    bf16_t* O; int ldc; const float* bias;
    __device__ __forceinline__ bool keep(const Unit&) const { return false; }
    __device__ __forceinline__ void operator()(Acc& acc, const Unit& u, int wr, int wc, int fr, int fq) const {
        const int row0 = u.pm * BM + wr * 64 + fr, col0 = u.pn * BM + wc * 32 + 8 * fq;
        f32x4 bv[2][2];
#pragma unroll
        for (int bj = 0; bj < 2; ++bj)
#pragma unroll
            for (int n = 0; n < 2; ++n) bv[bj][n] = bias ? *(const f32x4*)(bias + col0 + bj * HALF + 4 * n) : (f32x4){0.f, 0.f, 0.f, 0.f};
#pragma unroll
        for (int ai = 0; ai < 2; ++ai)
#pragma unroll
            for (int m = 0; m < 4; ++m) { bf16_t* rowp = O + (size_t)(row0 + ai * HALF + m * 16) * ldc + col0;
#pragma unroll
                for (int bj = 0; bj < 2; ++bj) { f32x4 v0 = acc[ai][bj][m][0] + bv[bj][0], v1 = acc[ai][bj][m][1] + bv[bj][1];
                    if (ACT == 1) {
#pragma unroll
                        for (int j = 0; j < 4; ++j) { const float a = fmaxf(v0[j], 0.f), b = fmaxf(v1[j], 0.f); v0[j] = a * a; v1[j] = b * b; } }
                    u32x4 w; w.x = cvt_pk_bf16(v0[0], v0[1]); w.y = cvt_pk_bf16(v0[2], v0[3]); w.z = cvt_pk_bf16(v1[0], v1[1]); w.w = cvt_pk_bf16(v1[2], v1[3]);
                    *(u32x4*)(rowp + bj * HALF) = w; } }
    }
};
__device__ __forceinline__ void unpack8(const u32x4 w, float (&e)[8]) { e[0] = bflo(w.x); e[1] = bfhi(w.x); e[2] = bflo(w.y); e[3] = bfhi(w.y); e[4] = bflo(w.z); e[5] = bfhi(w.z); e[6] = bflo(w.w); e[7] = bfhi(w.w); }
struct EpiGate {
    static constexpr bool PERM = true;
    const bf16_t* proj; bf16_t* O;
    __device__ __forceinline__ bool keep(const Unit& u) const { return u.grp == 0; }
    __device__ __forceinline__ void operator()(Acc& acc, const Unit& u, int wr, int wc, int fr, int fq) const {
        const int row0 = u.pm * BM + wr * 64 + fr, col0 = u.pn * BM + wc * 32 + 8 * fq;
        const bool g0 = (u.grp == 0);
        u32x4 gcw[2], gpw[2];
        { const bf16_t* p = proj + (size_t)row0 * INW + col0; gcw[0] = *(const u32x4*)(p + 6144); gpw[0] = g0 ? *(const u32x4*)(p + 4096) : gcw[0]; }
#pragma unroll
        for (int it = 0; it < 16; ++it) { const int ai = it >> 3, m = (it >> 1) & 3, bj = it & 1;
            const size_t row = (size_t)(row0 + ai * HALF + m * 16); const int col = col0 + bj * HALF;
            if (it < 15) { const int ai2 = (it + 1) >> 3, m2 = ((it + 1) >> 1) & 3, bj2 = (it + 1) & 1;
                const bf16_t* p = proj + (size_t)(row0 + ai2 * HALF + m2 * 16) * INW + col0 + bj2 * HALF;
                gcw[(it + 1) & 1] = *(const u32x4*)(p + 6144); gpw[(it + 1) & 1] = g0 ? *(const u32x4*)(p + 4096) : gcw[(it + 1) & 1]; }
            float ec[8]; unpack8(gcw[it & 1], ec);
#pragma unroll
            for (int j = 0; j < 8; ++j) ec[j] = 1.f + __expf(-fmaxf(ec[j], -30.f));
            if (g0) {
                float ep[8]; unpack8(gpw[it & 1], ep);
#pragma unroll
                for (int j = 0; j < 8; ++j) ep[j] = ec[j] * __builtin_amdgcn_rcpf(1.f + __expf(-ep[j]));
#pragma unroll
                for (int j = 0; j < 4; ++j) { acc[ai][bj][m][0][j] *= ep[j]; acc[ai][bj][m][1][j] *= ep[4 + j]; }
            } else {
                f32x4 v0, v1;
#pragma unroll
                for (int j = 0; j < 4; ++j) { v0[j] = acc[ai][bj][m][0][j] * __builtin_amdgcn_rcpf(ec[j]); v1[j] = acc[ai][bj][m][1][j] * __builtin_amdgcn_rcpf(ec[4 + j]); }
                u32x4 w; w.x = cvt_pk_bf16(v0[0], v0[1]); w.y = cvt_pk_bf16(v0[2], v0[3]); w.z = cvt_pk_bf16(v1[0], v1[1]); w.w = cvt_pk_bf16(v1[2], v1[3]);
                *(u32x4*)(O + row * D + col) = w;
            } }
    }
};
struct EpiRes {
    static constexpr bool PERM = false;
    float* res; const float* base; const float* ada; int gate_off; const float* bias;
    __device__ __forceinline__ bool keep(const Unit&) const { return false; }
    __device__ __forceinline__ void operator()(Acc& acc, const Unit& u, int wr, int wc, int fr, int fq) const {
        const int row0 = u.pm * BM + wr * 64 + fr, col0 = u.pn * BM + wc * 32 + 4 * fq;
        const float* gp = ada + (size_t)(u.pm >> 3) * NADAP;
        f32x4 bv[2][2], gv[2][2], xb[2][2][2];
#pragma unroll
        for (int bj = 0; bj < 2; ++bj)
#pragma unroll
            for (int n = 0; n < 2; ++n) { bv[bj][n] = bias ? *(const f32x4*)(bias + col0 + bj * HALF + n * 16) : (f32x4){0.f, 0.f, 0.f, 0.f}; gv[bj][n] = *(const f32x4*)(gp + adac(gate_off + col0 + bj * HALF + n * 16)); }
#pragma unroll
        for (int bj = 0; bj < 2; ++bj)
#pragma unroll
            for (int n = 0; n < 2; ++n) xb[0][bj][n] = *(const f32x4*)(base + (size_t)row0 * D + col0 + bj * HALF + n * 16);
#pragma unroll
        for (int it = 0; it < 8; ++it) { const int ai = it >> 2, m = it & 3;
            if (it < 7) { const float* bp = base + (size_t)(row0 + ((it + 1) >> 2) * HALF + ((it + 1) & 3) * 16) * D + col0;
#pragma unroll
                for (int bj = 0; bj < 2; ++bj)
#pragma unroll
                    for (int n = 0; n < 2; ++n) xb[(it + 1) & 1][bj][n] = *(const f32x4*)(bp + bj * HALF + n * 16); }
            float* rp = res + (size_t)(row0 + ai * HALF + m * 16) * D + col0;
#pragma unroll
            for (int bj = 0; bj < 2; ++bj)
#pragma unroll
                for (int n = 0; n < 2; ++n) *(f32x4*)(rp + bj * HALF + n * 16) = xb[it & 1][bj][n] * ALPHA + gv[bj][n] * (acc[ai][bj][m][n] + bv[bj][n]); }
    }
};

template <class Epi>
__device__ __forceinline__ void gemm_phase(LAS unsigned char* lds, const int K, const Order& S, const Epi& E) {
    const int tid = threadIdx.x, wid = __builtin_amdgcn_readfirstlane(tid >> 6), lane = tid & 63, wr = wid >> 2, wc = wid & 3, fr = lane & 15, fq = lane >> 4;
    const int nt = K / BK;
    unsigned voffA[2], voffB[2];
#pragma unroll
    for (int i = 0; i < 2; ++i) { int R, C; stage_rc(tid * 16 + i * 8192, R, C); const int Rb = Epi::PERM ? ((R & ~31) + perm32(R & 31)) : R;
        voffA[i] = (unsigned)(R * K + C) * 2u; voffB[i] = (unsigned)(Rb * K + C) * 2u; }
    const size_t kstep = (size_t)(BK * 2);
    const size_t hstep = (size_t)HALF * K * 2;
    const size_t tstep = 2 * hstep;
    const unsigned ldsw = (unsigned)wid * 1024u;
    const int aoff = lds_byte(wr * 64 + fr, fq * 8), boff = lds_byte(wc * 32 + fr, fq * 8);
#define PG8_SA(b, h) (((b) * 2 + (h)) * HTB)
#define PG8_SB(b, h) ((4 + (b) * 2 + (h)) * HTB)
#define PG8_STAGE(bufoff, gbase, voff) do { _Pragma("unroll") for (int _i = 0; _i < 2; ++_i) \
        __builtin_amdgcn_global_load_lds((const unsigned*)((const char*)(gbase) + (voff)[_i]), (LAS unsigned*)(lds + (bufoff) + ldsw + _i * 8192), 16, 0, 0); } while (0)
#define PG8_LDA(dst, b, h) do { _Pragma("unroll") for (int m = 0; m < 4; ++m) _Pragma("unroll") for (int k = 0; k < 2; ++k) dst[m][k] = *(const LAS bf16x8*)(lds + PG8_SA(b, h) + aoff + m * 2048 + k * 1024); } while (0)
#define PG8_LDB(dst, b, h) do { _Pragma("unroll") for (int n = 0; n < 2; ++n) _Pragma("unroll") for (int k = 0; k < 2; ++k) dst[n][k] = *(const LAS bf16x8*)(lds + PG8_SB(b, h) + boff + n * 2048 + k * 1024); } while (0)
#define PG8_MMA(ai, bj, At, Bt) do { __builtin_amdgcn_s_setprio(1); _Pragma("unroll") for (int m = 0; m < 4; ++m) _Pragma("unroll") for (int n = 0; n < 2; ++n) _Pragma("unroll") for (int k = 0; k < 2; ++k) \
        acc[ai][bj][m][n] = __builtin_amdgcn_mfma_f32_16x16x32_bf16(Bt[n][k], At[m][k], acc[ai][bj][m][n], 0, 0, 0); __builtin_amdgcn_s_setprio(0); } while (0)
#define PG8_WAIT_V(n) asm volatile("s_waitcnt vmcnt(" #n ")" ::: "memory")
#define PG8_WAIT_L(n) asm volatile("s_waitcnt lgkmcnt(" #n ")" ::: "memory")
#define PG8_BAR __builtin_amdgcn_s_barrier()
#define PG8_SCHED __builtin_amdgcn_sched_barrier(0)
    Unit cur, nxt; int ui = 0;
    if (!S.next(0, cur)) return;
    Acc acc;
#pragma unroll
    for (int a = 0; a < 2; ++a)
#pragma unroll
        for (int b = 0; b < 2; ++b)
#pragma unroll
            for (int m = 0; m < 4; ++m)
#pragma unroll
                for (int n = 0; n < 2; ++n) acc[a][b][m][n] = (f32x4){0.f, 0.f, 0.f, 0.f};
    bf16x8 At[4][2], B0[2][2], B1[2][2];
    const char* cA = S.baseA(cur, tstep); const char* cB = S.baseB(cur, tstep);
    PG8_STAGE(PG8_SB(0, 0), cB, voffB); PG8_STAGE(PG8_SB(0, 1), cB + hstep, voffB); PG8_STAGE(PG8_SA(0, 0), cA, voffA); PG8_STAGE(PG8_SA(0, 1), cA + hstep, voffA);
    if (wr == 1) PG8_BAR;
    PG8_WAIT_V(2); PG8_BAR;
    PG8_STAGE(PG8_SB(1, 0), cB + kstep, voffB); PG8_STAGE(PG8_SA(1, 0), cA + kstep, voffA); PG8_STAGE(PG8_SB(1, 1), cB + hstep + kstep, voffB);
    PG8_WAIT_V(6); PG8_BAR;
    for (;;) {
        const bool has_next = S.next(ui + 1, nxt);
        const char* nA = has_next ? S.baseA(nxt, tstep) : cA; const char* nB = has_next ? S.baseB(nxt, tstep) : cB;
        for (int t = 0; t < nt; t += 2) {
            const bool last = (t == nt - 2);
            const char* a1 = cA + (size_t)(t + 1) * kstep;
            const char* a2 = last ? nA : cA + (size_t)(t + 2) * kstep; const char* b2 = last ? nB : cB + (size_t)(t + 2) * kstep;
            const char* a3 = a2 + kstep; const char* b3 = b2 + kstep;
            PG8_LDB(B0, 0, 0); PG8_LDB(B1, 0, 1); PG8_SCHED; PG8_LDA(At, 0, 0); PG8_STAGE(PG8_SA(1, 1), a1 + hstep, voffA);
            PG8_WAIT_V(8); PG8_WAIT_L(0); PG8_BAR; PG8_MMA(0, 0, At, B0); PG8_MMA(0, 1, At, B1); PG8_BAR; PG8_SCHED;
            PG8_LDA(At, 0, 1); PG8_STAGE(PG8_SB(0, 0), b2, voffB); PG8_STAGE(PG8_SB(0, 1), b2 + hstep, voffB); PG8_STAGE(PG8_SA(0, 0), a2, voffA);
            PG8_WAIT_V(8); PG8_WAIT_L(0); PG8_BAR; PG8_MMA(1, 0, At, B0); PG8_MMA(1, 1, At, B1); PG8_BAR; PG8_SCHED;
            PG8_LDB(B0, 1, 0); PG8_LDB(B1, 1, 1); PG8_SCHED; PG8_LDA(At, 1, 0); PG8_STAGE(PG8_SA(0, 1), a2 + hstep, voffA);
            PG8_WAIT_V(8); PG8_WAIT_L(0); PG8_BAR; PG8_MMA(0, 0, At, B0); PG8_MMA(0, 1, At, B1); PG8_BAR; PG8_SCHED;
            PG8_LDA(At, 1, 1); PG8_STAGE(PG8_SB(1, 0), b3, voffB); PG8_STAGE(PG8_SB(1, 1), b3 + hstep, voffB); PG8_STAGE(PG8_SA(1, 0), a3, voffA);
            PG8_WAIT_V(8); PG8_WAIT_L(0); PG8_BAR; PG8_MMA(1, 0, At, B0); PG8_MMA(1, 1, At, B1); PG8_BAR; PG8_SCHED;
        }
        if (wr == 0) PG8_BAR;
        E(acc, cur, wr, wc, fr, fq);
        if (!has_next) break;
        if (!E.keep(cur)) {
#pragma unroll
            for (int a = 0; a < 2; ++a)
#pragma unroll
                for (int b = 0; b < 2; ++b)
#pragma unroll
                    for (int m = 0; m < 4; ++m)
#pragma unroll
                        for (int n = 0; n < 2; ++n) acc[a][b][m][n] = (f32x4){0.f, 0.f, 0.f, 0.f};
        }
        cur = nxt; cA = nA; cB = nB; ++ui;
        if (wr == 1) PG8_BAR;
    }
    PG8_WAIT_V(0);
    PG8_BAR;
#undef PG8_SA
#undef PG8_SB
#undef PG8_STAGE
#undef PG8_LDA
#undef PG8_LDB
#undef PG8_MMA
#undef PG8_WAIT_V
#undef PG8_WAIT_L
#undef PG8_BAR
#undef PG8_SCHED
}
}

struct Args {
    const float *x_prompt, *x_sample, *state_pool, *state_conv, *c_prompt, *c_sample, *w_ada, *b_ada, *w_in, *pool_grp_w, *pool_scale, *conv_w, *w_pool_up, *w_conv_up, *w_o,
        *ln1_g, *ln1_b, *w_ff1, *b_ff1, *w_ff2, *b_ff2, *ln2_g, *ln2_b;
    float* out; unsigned char* ws;
};

__device__ __forceinline__ float wave_sum(float v) {
#pragma unroll
    for (int o = 1; o < 64; o <<= 1) v += __shfl_xor(v, o);
    return v;
}

__device__ __forceinline__ void p0_transpose_item(const float* W, int K, int N, bf16_t* WT, LAS float* scr, int item, int lane) {
    const int nblk = N / 32, kb = item / nblk, nb = item % nblk, k0 = 64 * kb, n0 = 32 * nb;
    f32x4 v[8];
#pragma unroll
    for (int i = 0; i < 8; ++i) v[i] = __builtin_nontemporal_load((const f32x4*)(W + (size_t)(k0 + 8 * i + (lane >> 3)) * N + n0 + 4 * (lane & 7)));
#pragma unroll
    for (int i = 0; i < 8; ++i) { LAS float* d = scr + (8 * i + (lane >> 3)) * 33 + 4 * (lane & 7); d[0] = v[i][0]; d[1] = v[i][1]; d[2] = v[i][2]; d[3] = v[i][3]; }
    asm volatile("s_waitcnt lgkmcnt(0)" ::: "memory");
    const int c = lane & 7;
#pragma unroll
    for (int j = 0; j < 4; ++j) { const int n = (lane >> 3) + 8 * j; const LAS float* s = scr + (8 * c) * 33 + n;
        u32x4 o; o.x = pk2(s[0 * 33], s[1 * 33]); o.y = pk2(s[2 * 33], s[3 * 33]); o.z = pk2(s[4 * 33], s[5 * 33]); o.w = pk2(s[6 * 33], s[7 * 33]);
        *(u32x4*)(WT + (size_t)(n0 + n) * K + k0 + 8 * c) = o; }
    asm volatile("s_waitcnt lgkmcnt(0)" ::: "memory");
}

__device__ __forceinline__ void p0_ada_item(const Args& a, float* ada, LAS unsigned char* lds, int item, int wave, int lane) {
    const int n0 = item * 48, fr = lane & 15, kq = lane >> 4;
    f32x4 acc[9][3];
#pragma unroll
    for (int mt = 0; mt < 9; ++mt)
#pragma unroll
        for (int q = 0; q < 3; ++q) acc[mt][q] = (f32x4){0.f, 0.f, 0.f, 0.f};
    const float* const cr0 = fr < NB ? a.c_prompt + (size_t)fr * D : a.c_sample + (size_t)(fr - NB) * D;
    const float* const crm = a.c_sample + (size_t)(fr + 12) * D;
    const float* const cr8 = a.c_sample + (size_t)(124 + fr > NS - 1 ? NS - 1 : 124 + fr) * D;
#pragma unroll 2
    for (int ks = 0; ks < 8; ++ks) {
        const int k0 = wave * 256 + ks * 32 + kq * 8;
        float b[8][3];
#pragma unroll
        for (int j = 0; j < 8; ++j) { const float* p = a.w_ada + (size_t)(k0 + j) * NADA + n0 + 3 * fr; b[j][0] = __builtin_nontemporal_load(p); b[j][1] = __builtin_nontemporal_load(p + 1); b[j][2] = __builtin_nontemporal_load(p + 2); }
        bf16x8 bfr[3];
#pragma unroll
        for (int q = 0; q < 3; ++q) { u32x4 w; w.x = pk2(b[0][q], b[1][q]); w.y = pk2(b[2][q], b[3][q]); w.z = pk2(b[4][q], b[5][q]); w.w = pk2(b[6][q], b[7][q]); bfr[q] = __builtin_bit_cast(bf16x8, w); }
#pragma unroll
        for (int mt = 0; mt < 9; ++mt) {
            const float* cp = (mt == 0) ? cr0 : (mt == 8 ? cr8 : crm + (size_t)(mt - 1) * 16 * D);
            const f32x4 a0 = *(const f32x4*)(cp + k0), a1 = *(const f32x4*)(cp + k0 + 4);
            u32x4 w; w.x = pk2(a0[0], a0[1]); w.y = pk2(a0[2], a0[3]); w.z = pk2(a1[0], a1[1]); w.w = pk2(a1[2], a1[3]);
            const bf16x8 af = __builtin_bit_cast(bf16x8, w);
#pragma unroll
            for (int q = 0; q < 3; ++q) acc[mt][q] = __builtin_amdgcn_mfma_f32_16x16x32_bf16(af, bfr[q], acc[mt][q], 0, 0, 0);
            if (mt % 3 == 2) asm volatile("" ::: "memory");
        }
    }
    LAS float* red = (LAS float*)lds;
#pragma unroll
    for (int s = 4; s >= 1; s >>= 1) {
        if (wave >= s && wave < 2 * s) { LAS float* dst = red + (wave - s) * 6912 + lane;
#pragma unroll
            for (int mt = 0; mt < 9; ++mt)
#pragma unroll
                for (int q = 0; q < 3; ++q)
#pragma unroll
                    for (int j = 0; j < 4; ++j) dst[((mt * 3 + q) * 4 + j) * 64] = acc[mt][q][j]; }
        __syncthreads();
        if (wave < s) { const LAS float* src = red + wave * 6912 + lane;
#pragma unroll
            for (int mt = 0; mt < 9; ++mt)
#pragma unroll
                for (int q = 0; q < 3; ++q)
#pragma unroll
                    for (int j = 0; j < 4; ++j) acc[mt][q][j] += src[((mt * 3 + q) * 4 + j) * 64]; }
        __syncthreads();
    }
    if (wave == 0) {
#pragma unroll
        for (int q = 0; q < 3; ++q) { const int n = n0 + 3 * fr + q; const float bb = a.b_ada[n];
#pragma unroll
            for (int mt = 0; mt < 9; ++mt)
#pragma unroll
                for (int j = 0; j < 4; ++j) { const int r = mt * 16 + kq * 4 + j; if (r < NCOND) ada[(size_t)r * NADAP + item * 64 + 3 * fr + q] = acc[mt][q][j] + bb; } }
    }
}

__device__ __forceinline__ void p0_weff_item(const Args& a, bf16_t* WT, LAS unsigned char* lds, int item, int tid) {
    constexpr int AP = 260, BP = 80;
    const int g = item >> 7, it = (item >> 5) & 3, nt = item & 31, i0 = it * 64, n0 = nt * 64;
    LAS float* As = (LAS float*)lds;
    LAS float* Bs = (LAS float*)(lds + 66560);
#pragma unroll
    for (int r = 0; r < 8; ++r) { const int idx = tid + r * 512, row = idx >> 6, c4 = idx & 63;
        *(LAS f32x4*)(As + row * AP + c4 * 4) = *(const f32x4*)(a.pool_grp_w + ((size_t)(g * 256 + i0 + row)) * 256 + c4 * 4); }
    const int lane = tid & 63, wave = tid >> 6, fr = lane & 15, kq = lane >> 4, mt = wave >> 1, np = (wave & 1) * 2;
    f32x4 acc[2] = {(f32x4){0.f, 0.f, 0.f, 0.f}, (f32x4){0.f, 0.f, 0.f, 0.f}};
#pragma unroll 1
    for (int h = 0; h < 2; ++h) {
        __syncthreads();
#pragma unroll
        for (int r = 0; r < 4; ++r) { const int idx = tid + r * 512, o = idx >> 4, c4 = idx & 15;
            const float sc = a.pool_scale[g * 256 + h * 128 + o];
            *(LAS f32x4*)(Bs + o * BP + c4 * 4) = *(const f32x4*)(a.w_pool_up + (size_t)(g * 256 + h * 128 + o) * D + n0 + c4 * 4) * sc; }
        __syncthreads();
#pragma unroll 8
        for (int o4 = 0; o4 < 32; ++o4) {
            const float av = As[(mt * 16 + fr) * AP + h * 128 + o4 * 4 + kq];
            const float b0 = Bs[(o4 * 4 + kq) * BP + np * 16 + fr], b1 = Bs[(o4 * 4 + kq) * BP + np * 16 + 16 + fr];
            acc[0] = __builtin_amdgcn_mfma_f32_16x16x4f32(av, b0, acc[0], 0, 0, 0);
            acc[1] = __builtin_amdgcn_mfma_f32_16x16x4f32(av, b1, acc[1], 0, 0, 0);
        }
    }
#pragma unroll
    for (int t = 0; t < 2; ++t)
        *(u32x2*)(WT + (size_t)(n0 + (np + t) * 16 + fr) * PW + g * 256 + i0 + mt * 16 + kq * 4) = (u32x2){pk2(acc[t][0], acc[t][1]), pk2(acc[t][2], acc[t][3])};
    __syncthreads();
}

__device__ __forceinline__ void p1_modulate(const Args& a, const float* ada, bf16_t* U, int gw, int NGW, int lane) {
    if (NGW >= 2 * 8 * NS && (gw & 1) == 0 && (gw >> 1) < 8 * NS) {
        const int r = MP + (gw >> 4), c = ((gw >> 1) & 7) * 256 + 4 * lane;
        const float* ar = ada + (size_t)cond_row(r) * NADAP;
        const f32x4 v = *(const f32x4*)(a.x_sample + (size_t)(r - MP) * D + c) * (*(const f32x4*)(ar + adac(D + c)) + 1.f) + *(const f32x4*)(ar + adac(c));
        *(u32x2*)(U + (size_t)r * D + c) = (u32x2){pk2(v[0], v[1]), pk2(v[2], v[3])};
    }
    for (int r = gw; r < (NGW >= 2 * 8 * NS ? MP : MV); r += NGW) {
        u32x2* o8 = (u32x2*)(U + (size_t)r * D) + lane;
        const f32x4* xr = (const f32x4*)x_rowp(a.x_prompt, a.x_sample, r) + lane;
        const float* ar = ada + (size_t)cond_row(r) * NADAP;
#pragma unroll
        for (int j = 0; j < 8; ++j) { const int c = 4 * (lane + 64 * j); const f32x4 v = __builtin_nontemporal_load(xr + 64 * j) * (*(const f32x4*)(ar + adac(D + c)) + 1.f) + *(const f32x4*)(ar + adac(c));
            o8[64 * j] = (u32x2){pk2(v[0], v[1]), pk2(v[2], v[3])}; }
    }
}

__device__ __forceinline__ void p3_mixer(const Args& a, const bf16_t* proj, bf16_t* PRE, bf16_t* CIN, int tid) {
    const int j0 = 2 * tid, wave = tid >> 6, W = 2 << (wave >> 1);
    const f32x2 cw0 = *(const f32x2*)(a.conv_w + j0), cw1 = *(const f32x2*)(a.conv_w + CW + j0), cw2 = *(const f32x2*)(a.conv_w + 2 * CW + j0);
    float* const npp = a.out + O_NPP; float* const ncp = a.out + O_NCP; float* const nps = a.out + O_NPS; float* const ncs = a.out + O_NCS;
    for (int it = blockIdx.x; it < 384; it += gridDim.x) {
        if (it < 256) {
            const int b = it >> 6, s0 = (it & 63) * 32;
            const bf16_t* pb = proj + (size_t)(b * SEQ) * INW + j0;
            float S0 = 0.f, S1 = 0.f;
            for (int i = 1; i < W; ++i) { const int s = s0 - i; if (s >= 0) { const unsigned w = *(const unsigned*)(pb + (size_t)s * INW); S0 += bflo(w); S1 += bfhi(w); } }
            float v1a = 0.f, v1b = 0.f, v2a = 0.f, v2b = 0.f;
            if (s0 >= 1) { const bf16_t* p = pb + (size_t)(s0 - 1) * INW; const unsigned wx = *(const unsigned*)(p + 1024), wc = *(const unsigned*)(p + 3072); v1a = bflo(wc) * bflo(wx); v1b = bfhi(wc) * bfhi(wx); }
            if (s0 >= 2) { const bf16_t* p = pb + (size_t)(s0 - 2) * INW; const unsigned wx = *(const unsigned*)(p + 1024), wc = *(const unsigned*)(p + 3072); v2a = bflo(wc) * bflo(wx); v2b = bfhi(wc) * bfhi(wx); }
#pragma unroll 4
            for (int s = s0; s < s0 + 32; ++s) {
                const bf16_t* p = pb + (size_t)s * INW;
                const unsigned wz = *(const unsigned*)p, wx = *(const unsigned*)(p + 1024), wb = *(const unsigned*)(p + 2048), wc = *(const unsigned*)(p + 3072);
                const float z0 = bflo(wz), z1 = bfhi(wz);
                S0 += z0; S1 += z1;
                const int cnt = (s + 1 < W) ? s + 1 : W; const float fc = (float)cnt;
                const float p0 = S0 / fc - z0, p1 = S1 / fc - z1;
                const int so = s - W + 1;
                if (so >= 0) { const unsigned wo = *(const unsigned*)(pb + (size_t)so * INW); S0 -= bflo(wo); S1 -= bfhi(wo); }
                const float va = bflo(wc) * bflo(wx), vb = bfhi(wc) * bfhi(wx);
                const float ya = cw0[0] * v2a + cw1[0] * v1a + cw2[0] * va, yb = cw0[1] * v2b + cw1[1] * v1b + cw2[1] * vb;
                const size_t row = (size_t)(b * SEQ + s);
                *(unsigned*)(PRE + row * PW + j0) = pk2(p0, p1);
                *(unsigned*)(CIN + row * CW + j0) = pk2(bflo(wb) * ya, bfhi(wb) * yb);
                if (s >= SEQ - 15) *(f32x2*)(npp + ((size_t)(b * 15 + s - (SEQ - 15))) * PW + j0) = (f32x2){z0, z1};
                if (s >= SEQ - 2) *(f32x2*)(ncp + ((size_t)(b * 2 + s - (SEQ - 2))) * CW + j0) = (f32x2){va, vb};
                v2a = v1a; v2b = v1b; v1a = va; v1b = vb;
            }
        } else {
            const int b = it - 256; const size_t row = (size_t)(MP + b);
            const bf16_t* p = proj + row * INW + j0;
            const unsigned wz = *(const unsigned*)p, wx = *(const unsigned*)(p + 1024), wb = *(const unsigned*)(p + 2048), wc = *(const unsigned*)(p + 3072);
            const float z0 = bflo(wz), z1 = bfhi(wz);
            const float* sp = a.state_pool + (size_t)b * 15 * PW + j0;
            float S0 = z0, S1 = z1;
            for (int i = 1; i < W; ++i) { const f32x2 h = *(const f32x2*)(sp + (size_t)(15 - i) * PW); S0 += h[0]; S1 += h[1]; }
            const float fc = (float)W;
            *(unsigned*)(PRE + row * PW + j0) = pk2(S0 / fc - z0, S1 / fc - z1);
            const f32x2 h0 = *(const f32x2*)(a.state_conv + (size_t)(b * 2) * CW + j0), h1 = *(const f32x2*)(a.state_conv + (size_t)(b * 2 + 1) * CW + j0);
            const float va = bflo(wc) * bflo(wx), vb = bfhi(wc) * bfhi(wx);
            const float ya = cw0[0] * h0[0] + cw1[0] * h1[0] + cw2[0] * va, yb = cw0[1] * h0[1] + cw1[1] * h1[1] + cw2[1] * vb;
            *(unsigned*)(CIN + row * CW + j0) = pk2(bflo(wb) * ya, bfhi(wb) * yb);
#pragma unroll
            for (int r = 0; r < 14; ++r) *(f32x2*)(nps + ((size_t)(b * 15 + r)) * PW + j0) = *(const f32x2*)(sp + (size_t)(r + 1) * PW);
            *(f32x2*)(nps + ((size_t)(b * 15 + 14)) * PW + j0) = (f32x2){z0, z1};
            *(f32x2*)(ncs + ((size_t)(b * 2)) * CW + j0) = h1;
            *(f32x2*)(ncs + ((size_t)(b * 2 + 1)) * CW + j0) = (f32x2){va, vb};
        }
    }
}

__device__ __forceinline__ void ln_row(f32x4 (&v)[8], const f32x4 (&g4)[8], const f32x4 (&b4)[8]) {
    float s = 0.f;
#pragma unroll
    for (int j = 0; j < 8; ++j) s += (v[j][0] + v[j][1]) + (v[j][2] + v[j][3]);
    const float mean = wave_sum(s) * (1.f / D); float s2 = 0.f;
#pragma unroll
    for (int j = 0; j < 8; ++j) { v[j] = v[j] - mean; s2 += (v[j][0] * v[j][0] + v[j][1] * v[j][1]) + (v[j][2] * v[j][2] + v[j][3] * v[j][3]); }
    const float rstd = 1.f / sqrtf(wave_sum(s2) * (1.f / D) + LN_EPS);
#pragma unroll
    for (int j = 0; j < 8; ++j) v[j] = v[j] * rstd * g4[j] + b4[j];
}
__device__ __forceinline__ void p6_ln1(const Args& a, const float* ada, float* res, const float* part, bf16_t* U, int gw, int NGW, int lane) {
    f32x4 lg[8], lb[8];
#pragma unroll
    for (int j = 0; j < 8; ++j) { lg[j] = ((const f32x4*)a.ln1_g + lane)[64 * j]; lb[j] = ((const f32x4*)a.ln1_b + lane)[64 * j]; }
    for (int r = gw, nr; r >= 0; r = nr) { nr = -1; if (r < MP) { nr = r + NGW; if (nr >= MP) nr = ((gw & 15) == 0 && (gw >> 4) < NS && NGW >= 16 * NS) ? MP + (gw >> 4) : ((NGW >= 16 * NS) ? -1 : (nr < MV ? nr : -1)); } else if (NGW < 16 * NS) { nr = r + NGW; if (nr >= MV) nr = -1; }
        u32x2* o8 = (u32x2*)(U + (size_t)r * D) + lane;
        f32x4* rr = (f32x4*)(res + (size_t)r * D) + lane;
        const float* ar = ada + (size_t)cond_row(r) * NADAP;
        f32x4 v[8];
        if (r < MP) {
#pragma unroll
            for (int j = 0; j < 8; ++j) v[j] = rr[64 * j];
        } else {
            const f32x4* xr = (const f32x4*)(a.x_sample + (size_t)(r - MP) * D) + lane;
#pragma unroll
            for (int j = 0; j < 8; ++j) { f32x4 sum = (f32x4){0.f, 0.f, 0.f, 0.f};
#pragma unroll
                for (int sl = 0; sl < 8; ++sl) sum += ((const f32x4*)(part + ((size_t)sl * NS + (r - MP)) * D) + lane)[64 * j];
                v[j] = xr[64 * j] * ALPHA + *(const f32x4*)(ar + adac(2 * D + 4 * (lane + 64 * j))) * sum; }
        }
        ln_row(v, lg, lb);
#pragma unroll
        for (int j = 0; j < 8; ++j) { const int c = 4 * (lane + 64 * j); rr[64 * j] = v[j]; const f32x4 t = v[j] * (*(const f32x4*)(ar + adac(4 * D + c)) + 1.f) + *(const f32x4*)(ar + adac(3 * D + c));
            o8[64 * j] = (u32x2){pk2(t[0], t[1]), pk2(t[2], t[3])}; }
    }
}
__device__ __forceinline__ void p9_ln2(const Args& a, const float* ada, const float* res, const float* part, int gw, int NGW, int lane) {
    f32x4 lg[8], lb[8];
#pragma unroll
    for (int j = 0; j < 8; ++j) { lg[j] = ((const f32x4*)a.ln2_g + lane)[64 * j]; lb[j] = ((const f32x4*)a.ln2_b + lane)[64 * j]; }
    for (int r = gw, nr; r >= 0; r = nr) { nr = -1; if (r < MP) { nr = r + NGW; if (nr >= MP) nr = ((gw & 15) == 0 && (gw >> 4) < NS && NGW >= 16 * NS) ? MP + (gw >> 4) : ((NGW >= 16 * NS) ? -1 : (nr < MV ? nr : -1)); } else if (NGW < 16 * NS) { nr = r + NGW; if (nr >= MV) nr = -1; }
        const f32x4* rr = (const f32x4*)(res + (size_t)r * D) + lane;
        f32x4 v[8];
#pragma unroll
        for (int j = 0; j < 8; ++j) v[j] = rr[64 * j];
        if (r >= MP) {
            const float* ar = ada + (size_t)cond_row(r) * NADAP;
#pragma unroll
            for (int j = 0; j < 8; ++j) { f32x4 sum = *((const f32x4*)a.b_ff2 + lane + 64 * j);
#pragma unroll
                for (int sl = 0; sl < 8; ++sl) sum += ((const f32x4*)(part + ((size_t)sl * NS + (r - MP)) * D) + lane)[64 * j];
                v[j] = v[j] * ALPHA + *(const f32x4*)(ar + adac(5 * D + 4 * (lane + 64 * j))) * sum; }
        }
        ln_row(v, lg, lb);
        f32x4* o = (f32x4*)(a.out + (r < MP ? O_YP + (size_t)r * D : O_YS + (size_t)(r - MP) * D)) + lane;
#pragma unroll
        for (int j = 0; j < 8; ++j) o[64 * j] = v[j];
    }
}

typedef f32x4 Acc128[4][2];
__device__ __forceinline__ void gemm128_core(Acc128& acc, LAS unsigned char* lds, const bf16_t* A, const bf16_t* Bt, const int K  , const int klen  ) {
    using namespace pg8;
    const int tid = threadIdx.x, wid = __builtin_amdgcn_readfirstlane(tid >> 6), lane = tid & 63, wr = wid >> 2, wc = wid & 3, fr = lane & 15, fq = lane >> 4;
    const int nt = klen / 64;
    unsigned voff[2];
#pragma unroll
    for (int i = 0; i < 2; ++i) { int R, C; stage_rc(tid * 16 + i * 8192, R, C); voff[i] = (unsigned)(R * K + C) * 2u; }
    const unsigned ldsw = (unsigned)wid * 1024u;
    const int aoff = lds_byte(wr * 64 + fr, fq * 8), boff = lds_byte(wc * 32 + fr, fq * 8);
    const char* pa = (const char*)A; const char* pb = (const char*)Bt;
#define G128_STAGE(st, kt) do { _Pragma("unroll") for (int _i = 0; _i < 2; ++_i) { \
        __builtin_amdgcn_global_load_lds((const unsigned*)(pa + (size_t)(kt) * 128 + voff[_i]), (LAS unsigned*)(lds + (st) * 32768 + ldsw + _i * 8192), 16, 0, 0); \
        __builtin_amdgcn_global_load_lds((const unsigned*)(pb + (size_t)(kt) * 128 + voff[_i]), (LAS unsigned*)(lds + (st) * 32768 + 16384 + ldsw + _i * 8192), 16, 0, 0); } } while (0)
    G128_STAGE(0, 0); G128_STAGE(1, 1 < nt ? 1 : nt - 1); G128_STAGE(2, 2 < nt ? 2 : nt - 1);
#pragma unroll 1
    for (int t = 0; t < nt; ++t) {
        asm volatile("s_waitcnt vmcnt(8)" ::: "memory");
        __builtin_amdgcn_s_barrier();
        asm volatile("" ::: "memory");
        { const int kt = t + 3 < nt ? t + 3 : nt - 1; G128_STAGE((t + 3) & 3, kt); }
        const LAS unsigned char* sa = lds + (t & 3) * 32768; const LAS unsigned char* sb = sa + 16384;
        bf16x8 af[4][2], bfr[2][2];
#pragma unroll
        for (int m = 0; m < 4; ++m)
#pragma unroll
            for (int k = 0; k < 2; ++k) af[m][k] = *(const LAS bf16x8*)(sa + aoff + m * 2048 + k * 1024);
#pragma unroll
        for (int n = 0; n < 2; ++n)
#pragma unroll
            for (int k = 0; k < 2; ++k) bfr[n][k] = *(const LAS bf16x8*)(sb + boff + n * 2048 + k * 1024);
#pragma unroll
        for (int m = 0; m < 4; ++m)
#pragma unroll
            for (int n = 0; n < 2; ++n)
#pragma unroll
                for (int k = 0; k < 2; ++k) acc[m][n] = __builtin_amdgcn_mfma_f32_16x16x32_bf16(bfr[n][k], af[m][k], acc[m][n], 0, 0, 0);
        asm volatile("s_waitcnt lgkmcnt(0)" ::: "memory");
    }
    asm volatile("s_waitcnt vmcnt(0)" ::: "memory");
    __builtin_amdgcn_s_barrier();
    asm volatile("" ::: "memory");
#undef G128_STAGE
}
__device__ __forceinline__ void zero128(Acc128& acc) {
#pragma unroll
    for (int m = 0; m < 4; ++m)
#pragma unroll
        for (int n = 0; n < 2; ++n) acc[m][n] = (f32x4){0.f, 0.f, 0.f, 0.f};
}
template <int MODE>
__device__ __forceinline__ void sample_gemm(const Args& a, LAS unsigned char* lds, const bf16_t* A0, const bf16_t* B0, const bf16_t* A1, const bf16_t* B1, const int K, const int N,
                                            const bf16_t* proj, bf16_t* Ob, float* res, const float* ada) {
    const int tid = threadIdx.x, wid = __builtin_amdgcn_readfirstlane(tid >> 6), lane = tid & 63, wr = wid >> 2, wc = wid & 3, fr = lane & 15, fq = lane >> 4;
    constexpr int NSL = (MODE >= 3) ? 8 : 1;
    for (int unit = blockIdx.x; unit < (N / 128) * NSL; unit += gridDim.x) {
        const int n0 = (unit / NSL) * 128, sl = unit % NSL, klen = K / NSL;
        Acc128 acc, acc2;
        zero128(acc);
        gemm128_core(acc, lds, A0 + (size_t)MP * K + sl * klen, B0 + (size_t)n0 * K + sl * klen, K, klen);
        if (MODE == 2) { zero128(acc2); gemm128_core(acc2, lds, A1 + (size_t)MP * K, B1 + (size_t)n0 * K, K, K); }
#pragma unroll
        for (int m = 0; m < 4; ++m) { const int ms = wr * 64 + m * 16 + fr; const size_t row = (size_t)(MP + ms);
#pragma unroll
            for (int n = 0; n < 2; ++n) { const int c = n0 + wc * 32 + n * 16 + 4 * fq; f32x4 v = acc[m][n];
                if (MODE == 0) { *(u32x2*)(Ob + row * INW + c) = (u32x2){pk2(v[0], v[1]), pk2(v[2], v[3])}; }
                else if (MODE == 1) { v = v + *(const f32x4*)(a.b_ff1 + c);
#pragma unroll
                    for (int j = 0; j < 4; ++j) { const float r = fmaxf(v[j], 0.f); v[j] = r * r; }
                    *(u32x2*)(Ob + row * DFF + c) = (u32x2){pk2(v[0], v[1]), pk2(v[2], v[3])}; }
                else if (MODE == 2) {
                    const u32x2 gpw = *(const u32x2*)(proj + row * INW + 4096 + c), gcw = *(const u32x2*)(proj + row * INW + 6144 + c);
                    const float gp[4] = {bflo(gpw.x), bfhi(gpw.x), bflo(gpw.y), bfhi(gpw.y)}, gc[4] = {bflo(gcw.x), bfhi(gcw.x), bflo(gcw.y), bfhi(gcw.y)};
                    float o[4];
#pragma unroll
                    for (int j = 0; j < 4; ++j) o[j] = v[j] / (1.f + __expf(-gp[j])) + acc2[m][n][j] / (1.f + __expf(-gc[j]));
                    *(u32x2*)(Ob + row * D + c) = (u32x2){pk2(o[0], o[1]), pk2(o[2], o[3])}; }
                else { *(f32x4*)(res + ((size_t)sl * NS + ms) * D + c) = v; }
            } }
    }
}

#define XB_TMO      128
#define XB_XCNT(j)  (256  + 64 * (j))
#define XB_XSUB(j)  (1280 + 64 * (j))
#define XB_XGEN(j)  (2304 + 64 * (j))
#define XB_TOP      3328
#define XB_TOPGEN   3392
#define XCD_BAR_WORDS 3456
#define XB_SPIN_CAP (1u << 18)
__device__ __forceinline__ unsigned xb_ld(unsigned* p)              { return __hip_atomic_load(p, __ATOMIC_RELAXED, __HIP_MEMORY_SCOPE_AGENT); }
__device__ __forceinline__ unsigned xb_add(unsigned* p, unsigned v) { return __hip_atomic_fetch_add(p, v, __ATOMIC_RELAXED, __HIP_MEMORY_SCOPE_AGENT); }
__device__ __forceinline__ unsigned xb_xcc_id() { return (unsigned)__builtin_amdgcn_s_getreg((3 << 11) | 20) & 0xFu; }
#define XB_SPIN(cond, bar) do { unsigned _sp = 0; while (cond) { __builtin_amdgcn_s_sleep(1); \
    if ((++_sp & 255u) == 0u) { if (xb_ld(&(bar)[XB_TMO])) break; if (_sp > XB_SPIN_CAP) { atomicAdd(&(bar)[XB_TMO], 1u); break; } } } } while (0)
struct XcdBarrier { unsigned* bar; unsigned x; volatile LAS unsigned* st; };
__device__ __forceinline__ XcdBarrier xcd_barrier_post(unsigned* bar, volatile LAS unsigned* st) {
    XcdBarrier b; b.bar = bar; b.x = xb_xcc_id(); b.st = st;
    if (threadIdx.x == 0) (void)xb_add(&bar[XB_XCNT(b.x)], 1u);
    return b;
}
__device__ __forceinline__ void xcd_barrier_complete(unsigned* bar, unsigned x, unsigned& nloc, unsigned& nx) {
    const unsigned G = gridDim.x * gridDim.y * gridDim.z;
    unsigned sum, cnt, mine, sp = 0u;
    for (;;) {
        sum = 0u; cnt = 0u; mine = 0u;
#pragma unroll
        for (unsigned j = 0; j < 16; ++j) { const unsigned c = xb_ld(&bar[XB_XCNT(j)]); sum += c; cnt += (c > 0u) ? 1u : 0u; mine = (j == x) ? c : mine; }
        if (sum == G) break;
        __builtin_amdgcn_s_sleep(1);
        if ((++sp & 255u) == 0u) { if (xb_ld(&bar[XB_TMO])) break; if (sp > XB_SPIN_CAP) { atomicAdd(&bar[XB_TMO], 1u); break; } }
    }
    nloc = mine > 0u ? mine : 1u; nx = cnt > 0u ? cnt : 1u;
}
__device__ __forceinline__ void xcd_barrier(const XcdBarrier& b) {
    asm volatile("s_waitcnt vmcnt(0)" ::: "memory");
    __syncthreads();
    if (threadIdx.x == 0) {
        unsigned* bar = b.bar;
        __builtin_amdgcn_s_waitcnt(0);
        unsigned nloc = b.st[0], nx = b.st[1];
        if (nloc == 0u) { xcd_barrier_complete(bar, b.x, nloc, nx); b.st[0] = nloc; b.st[1] = nx; }
        const unsigned old = xb_add(&bar[XB_XSUB(b.x)], 1u);
        const unsigned gen = old / nloc;
        if (old + 1u == (gen + 1u) * nloc) {
            __builtin_amdgcn_fence(__ATOMIC_RELEASE, "agent");
            asm volatile("s_waitcnt vmcnt(0)" ::: "memory");
            const unsigned og = xb_add(&bar[XB_TOP], 1u);
            const unsigned tg = og / nx;
            if (og + 1u == (tg + 1u) * nx) xb_add(&bar[XB_TOPGEN], 1u);
            else XB_SPIN(xb_ld(&bar[XB_TOPGEN]) == tg, bar);
            __builtin_amdgcn_fence(__ATOMIC_ACQUIRE, "agent");
            xb_add(&bar[XB_XGEN(b.x)], 1u);
            asm volatile("s_waitcnt vmcnt(0)" ::: "memory");
        } else {
            XB_SPIN(xb_ld(&bar[XB_XGEN(b.x)]) == gen, bar);
            __builtin_amdgcn_fence(__ATOMIC_ACQUIRE, "agent");
            asm volatile("s_waitcnt vmcnt(0)" ::: "memory");
        }
    }
    __syncthreads();
}

__device__ __forceinline__ void p0_all(const Args& a, LAS unsigned char* lds, int tid, int lane, int wave, int bx, int G) {
    unsigned char* ws = a.ws;
    float* ada = (float*)(ws + WS_ADA);
    bf16_t* WinT = (bf16_t*)(ws + WS_WIN); bf16_t* Wff1T = (bf16_t*)(ws + WS_WFF1); bf16_t* Wff2T = (bf16_t*)(ws + WS_WFF2); bf16_t* WoT = (bf16_t*)(ws + WS_WO);
    bf16_t* WupP = (bf16_t*)(ws + WS_WUPP); bf16_t* WupC = (bf16_t*)(ws + WS_WUPC);
    const int gw = bx * 8 + wave, NGW = G * 8;
    for (int it = bx; it < NADA / 48; it += G) p0_ada_item(a, ada, lds, it, wave, lane);
    for (int it = bx; it < 512; it += G) p0_weff_item(a, WupP, lds, it, tid);
    {
        LAS float* scr = (LAS float*)(lds + wave * 16384);
        constexpr int I_IN = (D / 64) * (INW / 32), I_F1 = (D / 64) * (DFF / 32), I_F2 = (DFF / 64) * (D / 32), I_O = (D / 64) * (D / 32), I_C = (CW / 64) * (D / 32);
        constexpr int NIT = I_IN + I_F1 + I_F2 + I_O + I_C;
        for (int it = gw; it < NIT; it += NGW) {
            int r = it;
            if (r < I_IN) { p0_transpose_item(a.w_in, D, INW, WinT, scr, r, lane); continue; } r -= I_IN;
            if (r < I_F1) { p0_transpose_item(a.w_ff1, D, DFF, Wff1T, scr, r, lane); continue; } r -= I_F1;
            if (r < I_F2) { p0_transpose_item(a.w_ff2, DFF, D, Wff2T, scr, r, lane); continue; } r -= I_F2;
            if (r < I_O) { p0_transpose_item(a.w_o, D, D, WoT, scr, r, lane); continue; } r -= I_O;
            p0_transpose_item(a.w_conv_up, CW, D, WupC, scr, r, lane);
        }
    }
}

__global__ void __launch_bounds__(512, 2) fwd_megakernel(Args a) {
    extern __shared__ __attribute__((aligned(16))) unsigned char lds_raw[];
    LAS unsigned char* lds = (LAS unsigned char*)lds_raw;
    const int tid = threadIdx.x, lane = tid & 63, wave = __builtin_amdgcn_readfirstlane(tid >> 6);
    const int G = gridDim.x, bx = blockIdx.x;
    const int gw = bx * 8 + wave, NGW = G * 8;
    unsigned char* ws = a.ws;
    float* ada = (float*)(ws + WS_ADA);
    unsigned* ctr = (unsigned*)(ws + WS_CTL);
    if (tid < 64) ((LAS unsigned*)(lds + MISC_OFF))[tid] = 0u;
    __syncthreads();
    const XcdBarrier xbar = xcd_barrier_post(ctr, (volatile LAS unsigned*)(lds + MISC_OFF));
#define GB() xcd_barrier(xbar)
    bf16_t* WinT = (bf16_t*)(ws + WS_WIN); bf16_t* Wff1T = (bf16_t*)(ws + WS_WFF1); bf16_t* Wff2T = (bf16_t*)(ws + WS_WFF2); bf16_t* WoT = (bf16_t*)(ws + WS_WO);
    bf16_t* WupP = (bf16_t*)(ws + WS_WUPP); bf16_t* WupC = (bf16_t*)(ws + WS_WUPC);
    bf16_t* U = (bf16_t*)(ws + WS_U); bf16_t* PROJ = (bf16_t*)(ws + WS_PROJ); float* RES = (float*)(ws + WS_RES);
    float* PART = (float*)(ws + WS_PART);
    bf16_t* PRE = (bf16_t*)(ws + WS_RES); bf16_t* CIN = (bf16_t*)(ws + WS_RES + WS_CIN_OFF);

    p0_all(a, lds, tid, lane, wave, bx, G);
    GB();
    p1_modulate(a, ada, U, gw, NGW, lane);
    GB();
    { pg8::Order S; S.init(MP, INW, G, bx, 1, U, WinT, U, WinT);
      pg8::EpiBf16<0> E{PROJ, INW, nullptr};
      pg8::gemm_phase(lds, D, S, E); }
    sample_gemm<0>(a, lds, U, WinT, U, WinT, D, INW, PROJ, PROJ, RES, ada);
    GB();
    p3_mixer(a, PROJ, PRE, CIN, tid);
    GB();
    { pg8::Order S; S.init(MP, D, G, bx, 2, PRE, WupP, CIN, WupC);
      pg8::EpiGate E{PROJ, U};
      pg8::gemm_phase(lds, PW, S, E); }
    sample_gemm<2>(a, lds, PRE, WupP, CIN, WupC, PW, D, PROJ, U, RES, ada);
    GB();
    { pg8::Order S; S.init(MP, D, G, bx, 1, U, WoT, U, WoT);
      pg8::EpiRes E{RES, a.x_prompt, ada, 2 * D, nullptr};
      pg8::gemm_phase(lds, D, S, E); }
    sample_gemm<3>(a, lds, U, WoT, U, WoT, D, D, PROJ, U, PART, ada);
    GB();
    p6_ln1(a, ada, RES, PART, U, gw, NGW, lane);
    GB();
    { pg8::Order S; S.init(MP, DFF, G, bx, 1, U, Wff1T, U, Wff1T);
      pg8::EpiBf16<1> E{PROJ, DFF, a.b_ff1};
      pg8::gemm_phase(lds, D, S, E); }
    sample_gemm<1>(a, lds, U, Wff1T, U, Wff1T, D, DFF, PROJ, PROJ, RES, ada);
    GB();
    { pg8::Order S; S.init(MP, D, G, bx, 1, PROJ, Wff2T, PROJ, Wff2T);
      pg8::EpiRes E{RES, RES, ada, 5 * D, a.b_ff2};
      pg8::gemm_phase(lds, DFF, S, E); }
    sample_gemm<4>(a, lds, PROJ, Wff2T, PROJ, Wff2T, DFF, D, PROJ, U, PART, ada);
    GB();
    p9_ln2(a, ada, RES, PART, gw, NGW, lane);
}

extern "C" void kernel_launch(void* const* d_in, const int* in_sizes, int n_in, void* d_out, int out_size, void* d_ws, size_t ws_size, hipStream_t stream) {
    static int grid = 0;
    if (grid == 0) {
        if (n_in != 23 || ws_size < WS_END) { fprintf(stderr, "kernel_launch: expected 23 inputs and >= %zu bytes of workspace; got %d, %zu\n", (size_t)WS_END, n_in, ws_size); grid = -1; return; }
        int dev = 0, cus = 0, per_cu = 0;
        hipGetDevice(&dev);
        hipDeviceGetAttribute(&cus, hipDeviceAttributeMultiprocessorCount, dev);
        if (hipFuncSetAttribute((const void*)fwd_megakernel, hipFuncAttributeMaxDynamicSharedMemorySize, LDS_BYTES) != hipSuccess) { fprintf(stderr, "kernel_launch: hipFuncSetAttribute failed\n"); grid = -1; return; }
        if (hipOccupancyMaxActiveBlocksPerMultiprocessor(&per_cu, (const void*)fwd_megakernel, 512, LDS_BYTES) != hipSuccess || per_cu < 1) { fprintf(stderr, "kernel_launch: occupancy query says %d blocks per CU\n", per_cu); (void)hipGetLastError(); per_cu = 1; }
        grid = cus;
        fprintf(stderr, "kernel_launch: cus %d per_cu %d grid %d\n", cus, per_cu, grid);
    }
    if (grid < 0) return;
    if (hipMemsetAsync((char*)d_ws + WS_CTL, 0, 16384, stream) != hipSuccess) { fprintf(stderr, "kernel_launch: memset failed\n"); return; }
    Args a{};
    const float** ap = (const float**)&a;
    for (int i = 0; i < 23; ++i) ap[i] = (const float*)d_in[i];
    a.out = (float*)d_out; a.ws = (unsigned char*)d_ws;
    void* args[] = {&a};
    hipError_t e = hipLaunchCooperativeKernel((const void*)fwd_megakernel, dim3(grid), dim3(512), args, LDS_BYTES, stream);
    if (e != hipSuccess) fprintf(stderr, "kernel_launch: cooperative launch failed: %s (grid %d)\n", hipGetErrorString(e), grid);
}
```

```cpp
#include <hip/hip_runtime.h>
#include <cstdio>
#include <cstdint>

#define LAS __attribute__((address_space(3)))
typedef unsigned short bf16_t;
typedef short bf16x8 __attribute__((ext_vector_type(8)));
typedef float f32x4 __attribute__((ext_vector_type(4)));
typedef float f32x2 __attribute__((ext_vector_type(2)));
typedef unsigned u32x4 __attribute__((ext_vector_type(4)));
typedef unsigned u32x2 __attribute__((ext_vector_type(2)));

constexpr int D = 2048, NB = 4, SEQ = 2048, NS = 128;
constexpr int MP = NB * SEQ;
constexpr int MV = MP + NS;
constexpr int MPAD = 8448;
constexpr int PW = 1024, CW = 1024, DFF = 8192, INW = 8192, NADA = 6 * D, NCOND = NB + NS;
constexpr float ALPHA = 1.18920711500272f;
constexpr float LN_EPS = 1e-5f;
constexpr int NADAP = 256 * 64;
__device__ __forceinline__ int adac(int n) { return n + 16 * (n / 48); }

constexpr size_t MiB = 1u << 20;
constexpr size_t WS_CTL = 0;
constexpr size_t WS_ADA = 352 * MiB;
constexpr size_t WS_WIN = 8 * MiB, WS_WFF1 = 40 * MiB, WS_WFF2 = 72 * MiB, WS_WO = 104 * MiB, WS_WUPP = 112 * MiB, WS_WUPC = 116 * MiB;
constexpr size_t WS_U = 120 * MiB;
constexpr size_t WS_PROJ = 153 * MiB;
constexpr size_t WS_RES = 285 * MiB;
constexpr size_t WS_PART = 362 * MiB;
constexpr size_t WS_END = 378 * MiB;
constexpr size_t WS_CIN_OFF = (size_t)MPAD * 1024 * 2;

constexpr size_t O_YP = 0, O_YS = (size_t)MP * D, O_NPP = O_YS + (size_t)NS * D, O_NCP = O_NPP + (size_t)NB * 15 * PW, O_NPS = O_NCP + (size_t)NB * 2 * CW, O_NCS = O_NPS + (size_t)NS * 15 * PW;

constexpr int LDS_BYTES = 131072 + 256, MISC_OFF = 131072;

__device__ __forceinline__ unsigned f2bf(float f) { unsigned u = __builtin_bit_cast(unsigned, f); return (u + 0x7fffu + ((u >> 16) & 1u)) >> 16; }
__device__ __forceinline__ unsigned pk2(float lo, float hi) { return f2bf(lo) | (f2bf(hi) << 16); }
__device__ __forceinline__ unsigned cvt_pk_bf16(float lo, float hi) { unsigned r; asm volatile("v_cvt_pk_bf16_f32 %0, %1, %2" : "=v"(r) : "v"(lo), "v"(hi)); return r; }
__device__ __forceinline__ float bflo(unsigned w) { return __builtin_bit_cast(float, w << 16); }
__device__ __forceinline__ float bfhi(unsigned w) { return __builtin_bit_cast(float, w & 0xffff0000u); }
__device__ __forceinline__ int cond_row(int r) { int s = r - MP; s = s < 0 ? 0 : (s > NS - 1 ? NS - 1 : s); return r < MP ? (r >> 11) : NB + s; }
__device__ __forceinline__ const float* x_rowp(const float* xp, const float* xs, int r) { int s = r - MP; s = s < 0 ? 0 : (s > NS - 1 ? NS - 1 : s); return r < MP ? xp + (size_t)r * D : xs + (size_t)s * D; }

namespace pg8 {
constexpr int BM = 256, BK = 64, HALF = 128, HTB = HALF * BK * 2, NXCD = 8, WGM = 4;
__device__ __forceinline__ int lds_byte(int r, int c) { const int st = (r >> 4) * 2 + (c >> 5), rr = r & 15, cc = c & 31, ob = rr * 64 + cc * 2; return st * 1024 + (ob ^ (((ob >> 9) & 1) << 5)); }
__device__ __forceinline__ void stage_rc(int b, int& R, int& C) { const int st = b / 1024, sb = b % 1024, swz = sb ^ (((sb >> 9) & 1) << 5); R = (st >> 1) * 16 + swz / 64; C = (st & 1) * 32 + (swz % 64) / 2; }
__device__ __forceinline__ int perm32(int rho) { const int n = rho >> 4, i = rho & 15; return 8 * (i >> 2) + 4 * n + (i & 3); }

struct Unit { int pm, pn, grp; };
struct Order {
    int nM, nN, nwg, G, c, rep;
    const char* A0; const char* B0; const char* A1; const char* B1;
    __device__ __forceinline__ void init(int M, int N, int G_, int c_, int rep_, const void* a0, const void* b0, const void* a1, const void* b1) {
        nM = M / BM; nN = N / BM; nwg = nM * nN; G = G_; c = c_; rep = rep_; A0 = (const char*)a0; B0 = (const char*)b0; A1 = (const char*)a1; B1 = (const char*)b1; }
    __device__ __forceinline__ bool next(int i, Unit& u) const {
        const int ti = (rep == 2) ? (i >> 1) : i; u.grp = (rep == 2) ? (i & 1) : 0;
        const long L = (long)ti * G + c; if (L >= nwg) return false;
        int wgid = (int)L; { const int q = nwg / NXCD, r = nwg % NXCD, xcd = wgid % NXCD, off = wgid / NXCD; wgid = (xcd < r ? xcd * (q + 1) : r * (q + 1) + (xcd - r) * q) + off; }
        const int nig = WGM * nN, gid = wgid / nig, fm = gid * WGM, gsz = (nM - fm) < WGM ? (nM - fm) : WGM;
        u.pm = fm + ((wgid % nig) % gsz); u.pn = (wgid % nig) / gsz; return true;
    }
    __device__ __forceinline__ const char* baseA(const Unit& u, size_t tstep) const { return (u.grp ? A1 : A0) + (size_t)u.pm * tstep; }
    __device__ __forceinline__ const char* baseB(const Unit& u, size_t tstep) const { return (u.grp ? B1 : B0) + (size_t)u.pn * tstep; }
};

typedef f32x4 Acc[2][2][4][2];

template <int ACT> struct EpiBf16 {
    static constexpr bool PERM = true;
    bf16_t* O; int ldc; const float* bias;
    __device__ __forceinline__ bool keep(const Unit&) const { return false; }
    __device__ __forceinline__ void operator()(Acc& acc, const Unit& u, int wr, int wc, int fr, int fq) const {
        const int row0 = u.pm * BM + wr * 64 + fr, col0 = u.pn * BM + wc * 32 + 8 * fq;
        f32x4 bv[2][2];
#pragma unroll
        for (int bj = 0; bj < 2; ++bj)
#pragma unroll
            for (int n = 0; n < 2; ++n) bv[bj][n] = bias ? *(const f32x4*)(bias + col0 + bj * HALF + 4 * n) : (f32x4){0.f, 0.f, 0.f, 0.f};
#pragma unroll
        for (int ai = 0; ai < 2; ++ai)
#pragma unroll
            for (int m = 0; m < 4; ++m) { bf16_t* rowp = O + (size_t)(row0 + ai * HALF + m * 16) * ldc + col0;
#pragma unroll
                for (int bj = 0; bj < 2; ++bj) { f32x4 v0 = acc[ai][bj][m][0] + bv[bj][0], v1 = acc[ai][bj][m][1] + bv[bj][1];
                    if (ACT == 1) {
#pragma unroll
                        for (int j = 0; j < 4; ++j) { const float a = fmaxf(v0[j], 0.f), b = fmaxf(v1[j], 0.f); v0[j] = a * a; v1[j] = b * b; } }
                    u32x4 w; w.x = cvt_pk_bf16(v0[0], v0[1]); w.y = cvt_pk_bf16(v0[2], v0[3]); w.z = cvt_pk_bf16(v1[0], v1[1]); w.w = cvt_pk_bf16(v1[2], v1[3]);
                    *(u32x4*)(rowp + bj * HALF) = w; } }
    }
};
__device__ __forceinline__ void unpack8(const u32x4 w, float (&e)[8]) { e[0] = bflo(w.x); e[1] = bfhi(w.x); e[2] = bflo(w.y); e[3] = bfhi(w.y); e[4] = bflo(w.z); e[5] = bfhi(w.z); e[6] = bflo(w.w); e[7] = bfhi(w.w); }
struct EpiGate {
    static constexpr bool PERM = true;
    const bf16_t* proj; bf16_t* O;
    __device__ __forceinline__ bool keep(const Unit& u) const { return u.grp == 0; }
    __device__ __forceinline__ void operator()(Acc& acc, const Unit& u, int wr, int wc, int fr, int fq) const {
        const int row0 = u.pm * BM + wr * 64 + fr, col0 = u.pn * BM + wc * 32 + 8 * fq;
        const bool g0 = (u.grp == 0);
        u32x4 gcw[2], gpw[2];
        { const bf16_t* p = proj + (size_t)row0 * INW + col0; gcw[0] = *(const u32x4*)(p + 6144); gpw[0] = g0 ? *(const u32x4*)(p + 4096) : gcw[0]; }
#pragma unroll
        for (int it = 0; it < 16; ++it) { const int ai = it >> 3, m = (it >> 1) & 3, bj = it & 1;
            const size_t row = (size_t)(row0 + ai * HALF + m * 16); const int col = col0 + bj * HALF;
            if (it < 15) { const int ai2 = (it + 1) >> 3, m2 = ((it + 1) >> 1) & 3, bj2 = (it + 1) & 1;
                const bf16_t* p = proj + (size_t)(row0 + ai2 * HALF + m2 * 16) * INW + col0 + bj2 * HALF;
                gcw[(it + 1) & 1] = *(const u32x4*)(p + 6144); gpw[(it + 1) & 1] = g0 ? *(const u32x4*)(p + 4096) : gcw[(it + 1) & 1]; }
            float ec[8]; unpack8(gcw[it & 1], ec);
#pragma unroll
            for (int j = 0; j < 8; ++j) ec[j] = 1.f + __expf(-fmaxf(ec[j], -30.f));
            if (g0) {
                float ep[8]; unpack8(gpw[it & 1], ep);
#pragma unroll
                for (int j = 0; j < 8; ++j) ep[j] = ec[j] * __builtin_amdgcn_rcpf(1.f + __expf(-ep[j]));
#pragma unroll
                for (int j = 0; j < 4; ++j) { acc[ai][bj][m][0][j] *= ep[j]; acc[ai][bj][m][1][j] *= ep[4 + j]; }
            } else {
                f32x4 v0, v1;
#pragma unroll
                for (int j = 0; j < 4; ++j) { v0[j] = acc[ai][bj][m][0][j] * __builtin_amdgcn_rcpf(ec[j]); v1[j] = acc[ai][bj][m][1][j] * __builtin_amdgcn_rcpf(ec[4 + j]); }
                u32x4 w; w.x = cvt_pk_bf16(v0[0], v0[1]); w.y = cvt_pk_bf16(v0[2], v0[3]); w.z = cvt_pk_bf16(v1[0], v1[1]); w.w = cvt_pk_bf16(v1[2], v1[3]);
                *(u32x4*)(O + row * D + col) = w;
            } }
    }
};
struct EpiRes {
    static constexpr bool PERM = false;
    float* res; const float* base; const float* ada; int gate_off; const float* bias;
    __device__ __forceinline__ bool keep(const Unit&) const { return false; }
    __device__ __forceinline__ void operator()(Acc& acc, const Unit& u, int wr, int wc, int fr, int fq) const {
        const int row0 = u.pm * BM + wr * 64 + fr, col0 = u.pn * BM + wc * 32 + 4 * fq;
        const float* gp = ada + (size_t)(u.pm >> 3) * NADAP;
        f32x4 bv[2][2], gv[2][2], xb[2][2][2];
#pragma unroll
        for (int bj = 0; bj < 2; ++bj)
#pragma unroll
            for (int n = 0; n < 2; ++n) { bv[bj][n] = bias ? *(const f32x4*)(bias + col0 + bj * HALF + n * 16) : (f32x4){0.f, 0.f, 0.f, 0.f}; gv[bj][n] = *(const f32x4*)(gp + adac(gate_off + col0 + bj * HALF + n * 16)); }
#pragma unroll
        for (int bj = 0; bj < 2; ++bj)
#pragma unroll
            for (int n = 0; n < 2; ++n) xb[0][bj][n] = *(const f32x4*)(base + (size_t)row0 * D + col0 + bj * HALF + n * 16);
#pragma unroll
        for (int it = 0; it < 8; ++it) { const int ai = it >> 2, m = it & 3;
            if (it < 7) { const float* bp = base + (size_t)(row0 + ((it + 1) >> 2) * HALF + ((it + 1) & 3) * 16) * D + col0;
#pragma unroll
                for (int bj = 0; bj < 2; ++bj)
#pragma unroll
                    for (int n = 0; n < 2; ++n) xb[(it + 1) & 1][bj][n] = *(const f32x4*)(bp + bj * HALF + n * 16); }
            float* rp = res + (size_t)(row0 + ai * HALF + m * 16) * D + col0;
#pragma unroll
            for (int bj = 0; bj < 2; ++bj)
#pragma unroll
                for (int n = 0; n < 2; ++n) *(f32x4*)(rp + bj * HALF + n * 16) = xb[it & 1][bj][n] * ALPHA + gv[bj][n] * (acc[ai][bj][m][n] + bv[bj][n]); }
    }
};

template <class Epi>
__device__ __forceinline__ void gemm_phase(LAS unsigned char* lds, const int K, const Order& S, const Epi& E) {
    const int tid = threadIdx.x, wid = __builtin_amdgcn_readfirstlane(tid >> 6), lane = tid & 63, wr = wid >> 2, wc = wid & 3, fr = lane & 15, fq = lane >> 4;
    const int nt = K / BK;
    unsigned voffA[2], voffB[2];
#pragma unroll
    for (int i = 0; i < 2; ++i) { int R, C; stage_rc(tid * 16 + i * 8192, R, C); const int Rb = Epi::PERM ? ((R & ~31) + perm32(R & 31)) : R;
        voffA[i] = (unsigned)(R * K + C) * 2u; voffB[i] = (unsigned)(Rb * K + C) * 2u; }
    const size_t kstep = (size_t)(BK * 2);
    const size_t hstep = (size_t)HALF * K * 2;
    const size_t tstep = 2 * hstep;
    const unsigned ldsw = (unsigned)wid * 1024u;
    const int aoff = lds_byte(wr * 64 + fr, fq * 8), boff = lds_byte(wc * 32 + fr, fq * 8);
#define PG8_SA(b, h) (((b) * 2 + (h)) * HTB)
#define PG8_SB(b, h) ((4 + (b) * 2 + (h)) * HTB)
#define PG8_STAGE(bufoff, gbase, voff) do { _Pragma("unroll") for (int _i = 0; _i < 2; ++_i) \
        __builtin_amdgcn_global_load_lds((const unsigned*)((const char*)(gbase) + (voff)[_i]), (LAS unsigned*)(lds + (bufoff) + ldsw + _i * 8192), 16, 0, 0); } while (0)
#define PG8_LDA(dst, b, h) do { _Pragma("unroll") for (int m = 0; m < 4; ++m) _Pragma("unroll") for (int k = 0; k < 2; ++k) dst[m][k] = *(const LAS bf16x8*)(lds + PG8_SA(b, h) + aoff + m * 2048 + k * 1024); } while (0)
#define PG8_LDB(dst, b, h) do { _Pragma("unroll") for (int n = 0; n < 2; ++n) _Pragma("unroll") for (int k = 0; k < 2; ++k) dst[n][k] = *(const LAS bf16x8*)(lds + PG8_SB(b, h) + boff + n * 2048 + k * 1024); } while (0)
#define PG8_MMA(ai, bj, At, Bt) do { __builtin_amdgcn_s_setprio(1); _Pragma("unroll") for (int m = 0; m < 4; ++m) _Pragma("unroll") for (int n = 0; n < 2; ++n) _Pragma("unroll") for (int k = 0; k < 2; ++k) \
        acc[ai][bj][m][n] = __builtin_amdgcn_mfma_f32_16x16x32_bf16(Bt[n][k], At[m][k], acc[ai][bj][m][n], 0, 0, 0); __builtin_amdgcn_s_setprio(0); } while (0)
#define PG8_WAIT_V(n) asm volatile("s_waitcnt vmcnt(" #n ")" ::: "memory")
#define PG8_WAIT_L(n) asm volatile("s_waitcnt lgkmcnt(" #n ")" ::: "memory")
#define PG8_BAR __builtin_amdgcn_s_barrier()
#define PG8_SCHED __builtin_amdgcn_sched_barrier(0)
    Unit cur, nxt; int ui = 0;
    if (!S.next(0, cur)) return;
    Acc acc;
#pragma unroll
    for (int a = 0; a < 2; ++a)
#pragma unroll
        for (int b = 0; b < 2; ++b)
#pragma unroll
            for (int m = 0; m < 4; ++m)
#pragma unroll
                for (int n = 0; n < 2; ++n) acc[a][b][m][n] = (f32x4){0.f, 0.f, 0.f, 0.f};
    bf16x8 At[4][2], B0[2][2], B1[2][2];
    const char* cA = S.baseA(cur, tstep); const char* cB = S.baseB(cur, tstep);
    PG8_STAGE(PG8_SB(0, 0), cB, voffB); PG8_STAGE(PG8_SB(0, 1), cB + hstep, voffB); PG8_STAGE(PG8_SA(0, 0), cA, voffA); PG8_STAGE(PG8_SA(0, 1), cA + hstep, voffA);
    if (wr == 1) PG8_BAR;
    PG8_WAIT_V(2); PG8_BAR;
    PG8_STAGE(PG8_SB(1, 0), cB + kstep, voffB); PG8_STAGE(PG8_SA(1, 0), cA + kstep, voffA); PG8_STAGE(PG8_SB(1, 1), cB + hstep + kstep, voffB);
    PG8_WAIT_V(6); PG8_BAR;
    for (;;) {
        const bool has_next = S.next(ui + 1, nxt);
        const char* nA = has_next ? S.baseA(nxt, tstep) : cA; const char* nB = has_next ? S.baseB(nxt, tstep) : cB;
        for (int t = 0; t < nt; t += 2) {
            const bool last = (t == nt - 2);
            const char* a1 = cA + (size_t)(t + 1) * kstep;
            const char* a2 = last ? nA : cA + (size_t)(t + 2) * kstep; const char* b2 = last ? nB : cB + (size_t)(t + 2) * kstep;
            const char* a3 = a2 + kstep; const char* b3 = b2 + kstep;
            PG8_LDB(B0, 0, 0); PG8_LDB(B1, 0, 1); PG8_SCHED; PG8_LDA(At, 0, 0); PG8_STAGE(PG8_SA(1, 1), a1 + hstep, voffA);
            PG8_WAIT_V(8); PG8_WAIT_L(0); PG8_BAR; PG8_MMA(0, 0, At, B0); PG8_MMA(0, 1, At, B1); PG8_BAR; PG8_SCHED;
            PG8_LDA(At, 0, 1); PG8_STAGE(PG8_SB(0, 0), b2, voffB); PG8_STAGE(PG8_SB(0, 1), b2 + hstep, voffB); PG8_STAGE(PG8_SA(0, 0), a2, voffA);
            PG8_WAIT_V(8); PG8_WAIT_L(0); PG8_BAR; PG8_MMA(1, 0, At, B0); PG8_MMA(1, 1, At, B1); PG8_BAR; PG8_SCHED;
            PG8_LDB(B0, 1, 0); PG8_LDB(B1, 1, 1); PG8_SCHED; PG8_LDA(At, 1, 0); PG8_STAGE(PG8_SA(0, 1), a2 + hstep, voffA);
            PG8_WAIT_V(8); PG8_WAIT_L(0); PG8_BAR; PG8_MMA(0, 0, At, B0); PG8_MMA(0, 1, At, B1); PG8_BAR; PG8_SCHED;
            PG8_LDA(At, 1, 1); PG8_STAGE(PG8_SB(1, 0), b3, voffB); PG8_STAGE(PG8_SB(1, 1), b3 + hstep, voffB); PG8_STAGE(PG8_SA(1, 0), a3, voffA);
            PG8_WAIT_V(8); PG8_WAIT_L(0); PG8_BAR; PG8_MMA(1, 0, At, B0); PG8_MMA(1, 1, At, B1); PG8_BAR; PG8_SCHED;
        }
        if (wr == 0) PG8_BAR;
        E(acc, cur, wr, wc, fr, fq);
        if (!has_next) break;
        if (!E.keep(cur)) {
#pragma unroll
            for (int a = 0; a < 2; ++a)
#pragma unroll
                for (int b = 0; b < 2; ++b)
#pragma unroll
                    for (int m = 0; m < 4; ++m)
#pragma unroll
                        for (int n = 0; n < 2; ++n) acc[a][b][m][n] = (f32x4){0.f, 0.f, 0.f, 0.f};
        }
        cur = nxt; cA = nA; cB = nB; ++ui;
        if (wr == 1) PG8_BAR;
    }
    PG8_WAIT_V(0);
    PG8_BAR;
#undef PG8_SA
#undef PG8_SB
#undef PG8_STAGE
#undef PG8_LDA
#undef PG8_LDB
#undef PG8_MMA
#undef PG8_WAIT_V
#undef PG8_WAIT_L
#undef PG8_BAR
#undef PG8_SCHED
}
}

struct Args {
    const float *x_prompt, *x_sample, *state_pool, *state_conv, *c_prompt, *c_sample, *w_ada, *b_ada, *w_in, *pool_grp_w, *pool_scale, *conv_w, *w_pool_up, *w_conv_up, *w_o,
        *ln1_g, *ln1_b, *w_ff1, *b_ff1, *w_ff2, *b_ff2, *ln2_g, *ln2_b;
    float* out; unsigned char* ws;
};

__device__ __forceinline__ float wave_sum(float v) {
#pragma unroll
    for (int o = 1; o < 64; o <<= 1) v += __shfl_xor(v, o);
    return v;
}

__device__ __forceinline__ void p0_transpose_item(const float* W, int K, int N, bf16_t* WT, LAS float* scr, int item, int lane) {
    const int nblk = N / 32, kb = item / nblk, nb = item % nblk, k0 = 64 * kb, n0 = 32 * nb;
    f32x4 v[8];
#pragma unroll
    for (int i = 0; i < 8; ++i) v[i] = __builtin_nontemporal_load((const f32x4*)(W + (size_t)(k0 + 8 * i + (lane >> 3)) * N + n0 + 4 * (lane & 7)));
#pragma unroll
    for (int i = 0; i < 8; ++i) { LAS float* d = scr + (8 * i + (lane >> 3)) * 33 + 4 * (lane & 7); d[0] = v[i][0]; d[1] = v[i][1]; d[2] = v[i][2]; d[3] = v[i][3]; }
    asm volatile("s_waitcnt lgkmcnt(0)" ::: "memory");
    const int c = lane & 7;
#pragma unroll
    for (int j = 0; j < 4; ++j) { const int n = (lane >> 3) + 8 * j; const LAS float* s = scr + (8 * c) * 33 + n;
        u32x4 o; o.x = pk2(s[0 * 33], s[1 * 33]); o.y = pk2(s[2 * 33], s[3 * 33]); o.z = pk2(s[4 * 33], s[5 * 33]); o.w = pk2(s[6 * 33], s[7 * 33]);
        *(u32x4*)(WT + (size_t)(n0 + n) * K + k0 + 8 * c) = o; }
    asm volatile("s_waitcnt lgkmcnt(0)" ::: "memory");
}

__device__ __forceinline__ void p0_ada_item(const Args& a, float* ada, LAS unsigned char* lds, int item, int wave, int lane) {
    const int n0 = item * 48, fr = lane & 15, kq = lane >> 4;
    f32x4 acc[9][3];
#pragma unroll
    for (int mt = 0; mt < 9; ++mt)
#pragma unroll
        for (int q = 0; q < 3; ++q) acc[mt][q] = (f32x4){0.f, 0.f, 0.f, 0.f};
    const float* const cr0 = fr < NB ? a.c_prompt + (size_t)fr * D : a.c_sample + (size_t)(fr - NB) * D;
    const float* const crm = a.c_sample + (size_t)(fr + 12) * D;
    const float* const cr8 = a.c_sample + (size_t)(124 + fr > NS - 1 ? NS - 1 : 124 + fr) * D;
#pragma unroll 2
    for (int ks = 0; ks < 8; ++ks) {
        const int k0 = wave * 256 + ks * 32 + kq * 8;
        float b[8][3];
#pragma unroll
        for (int j = 0; j < 8; ++j) { const float* p = a.w_ada + (size_t)(k0 + j) * NADA + n0 + 3 * fr; b[j][0] = __builtin_nontemporal_load(p); b[j][1] = __builtin_nontemporal_load(p + 1); b[j][2] = __builtin_nontemporal_load(p + 2); }
        bf16x8 bfr[3];
#pragma unroll
        for (int q = 0; q < 3; ++q) { u32x4 w; w.x = pk2(b[0][q], b[1][q]); w.y = pk2(b[2][q], b[3][q]); w.z = pk2(b[4][q], b[5][q]); w.w = pk2(b[6][q], b[7][q]); bfr[q] = __builtin_bit_cast(bf16x8, w); }
#pragma unroll
        for (int mt = 0; mt < 9; ++mt) {
            const float* cp = (mt == 0) ? cr0 : (mt == 8 ? cr8 : crm + (size_t)(mt - 1) * 16 * D);
            const f32x4 a0 = *(const f32x4*)(cp + k0), a1 = *(const f32x4*)(cp + k0 + 4);
            u32x4 w; w.x = pk2(a0[0], a0[1]); w.y = pk2(a0[2], a0[3]); w.z = pk2(a1[0], a1[1]); w.w = pk2(a1[2], a1[3]);
            const bf16x8 af = __builtin_bit_cast(bf16x8, w);
#pragma unroll
            for (int q = 0; q < 3; ++q) acc[mt][q] = __builtin_amdgcn_mfma_f32_16x16x32_bf16(af, bfr[q], acc[mt][q], 0, 0, 0);
            if (mt % 3 == 2) asm volatile("" ::: "memory");
        }
    }
    LAS float* red = (LAS float*)lds;
#pragma unroll
    for (int s = 4; s >= 1; s >>= 1) {
        if (wave >= s && wave < 2 * s) { LAS float* dst = red + (wave - s) * 6912 + lane;
#pragma unroll
            for (int mt = 0; mt < 9; ++mt)
#pragma unroll
                for (int q = 0; q < 3; ++q)
#pragma unroll
                    for (int j = 0; j < 4; ++j) dst[((mt * 3 + q) * 4 + j) * 64] = acc[mt][q][j]; }
        __syncthreads();
        if (wave < s) { const LAS float* src = red + wave * 6912 + lane;
#pragma unroll
            for (int mt = 0; mt < 9; ++mt)
#pragma unroll
                for (int q = 0; q < 3; ++q)
#pragma unroll
                    for (int j = 0; j < 4; ++j) acc[mt][q][j] += src[((mt * 3 + q) * 4 + j) * 64]; }
        __syncthreads();
    }
    if (wave == 0) {
#pragma unroll
        for (int q = 0; q < 3; ++q) { const int n = n0 + 3 * fr + q; const float bb = a.b_ada[n];
#pragma unroll
            for (int mt = 0; mt < 9; ++mt)
#pragma unroll
                for (int j = 0; j < 4; ++j) { const int r = mt * 16 + kq * 4 + j; if (r < NCOND) ada[(size_t)r * NADAP + item * 64 + 3 * fr + q] = acc[mt][q][j] + bb; } }
    }
}

__device__ __forceinline__ void p0_weff_item(const Args& a, bf16_t* WT, LAS unsigned char* lds, int item, int tid) {
    constexpr int AP = 260, BP = 80;
    const int g = item >> 7, it = (item >> 5) & 3, nt = item & 31, i0 = it * 64, n0 = nt * 64;
    LAS float* As = (LAS float*)lds;
    LAS float* Bs = (LAS float*)(lds + 66560);
#pragma unroll
    for (int r = 0; r < 8; ++r) { const int idx = tid + r * 512, row = idx >> 6, c4 = idx & 63;
        *(LAS f32x4*)(As + row * AP + c4 * 4) = *(const f32x4*)(a.pool_grp_w + ((size_t)(g * 256 + i0 + row)) * 256 + c4 * 4); }
    const int lane = tid & 63, wave = tid >> 6, fr = lane & 15, kq = lane >> 4, mt = wave >> 1, np = (wave & 1) * 2;
    f32x4 acc[2] = {(f32x4){0.f, 0.f, 0.f, 0.f}, (f32x4){0.f, 0.f, 0.f, 0.f}};
#pragma unroll 1
    for (int h = 0; h < 2; ++h) {
        __syncthreads();
#pragma unroll
        for (int r = 0; r < 4; ++r) { const int idx = tid + r * 512, o = idx >> 4, c4 = idx & 15;
            const float sc = a.pool_scale[g * 256 + h * 128 + o];
            *(LAS f32x4*)(Bs + o * BP + c4 * 4) = *(const f32x4*)(a.w_pool_up + (size_t)(g * 256 + h * 128 + o) * D + n0 + c4 * 4) * sc; }
        __syncthreads();
#pragma unroll 8
        for (int o4 = 0; o4 < 32; ++o4) {
            const float av = As[(mt * 16 + fr) * AP + h * 128 + o4 * 4 + kq];
            const float b0 = Bs[(o4 * 4 + kq) * BP + np * 16 + fr], b1 = Bs[(o4 * 4 + kq) * BP + np * 16 + 16 + fr];
            acc[0] = __builtin_amdgcn_mfma_f32_16x16x4f32(av, b0, acc[0], 0, 0, 0);
            acc[1] = __builtin_amdgcn_mfma_f32_16x16x4f32(av, b1, acc[1], 0, 0, 0);
        }
    }
#pragma unroll
    for (int t = 0; t < 2; ++t)
        *(u32x2*)(WT + (size_t)(n0 + (np + t) * 16 + fr) * PW + g * 256 + i0 + mt * 16 + kq * 4) = (u32x2){pk2(acc[t][0], acc[t][1]), pk2(acc[t][2], acc[t][3])};
    __syncthreads();
}

__device__ __forceinline__ void p1_modulate(const Args& a, const float* ada, bf16_t* U, int gw, int NGW, int lane) {
    if (NGW >= 2 * 8 * NS && (gw & 1) == 0 && (gw >> 1) < 8 * NS) {
        const int r = MP + (gw >> 4), c = ((gw >> 1) & 7) * 256 + 4 * lane;
        const float* ar = ada + (size_t)cond_row(r) * NADAP;
        const f32x4 v = *(const f32x4*)(a.x_sample + (size_t)(r - MP) * D + c) * (*(const f32x4*)(ar + adac(D + c)) + 1.f) + *(const f32x4*)(ar + adac(c));
        *(u32x2*)(U + (size_t)r * D + c) = (u32x2){pk2(v[0], v[1]), pk2(v[2], v[3])};
    }
    for (int r = gw; r < (NGW >= 2 * 8 * NS ? MP : MV); r += NGW) {
        u32x2* o8 = (u32x2*)(U + (size_t)r * D) + lane;
        const f32x4* xr = (const f32x4*)x_rowp(a.x_prompt, a.x_sample, r) + lane;
        const float* ar = ada + (size_t)cond_row(r) * NADAP;
#pragma unroll
        for (int j = 0; j < 8; ++j) { const int c = 4 * (lane + 64 * j); const f32x4 v = __builtin_nontemporal_load(xr + 64 * j) * (*(const f32x4*)(ar + adac(D + c)) + 1.f) + *(const f32x4*)(ar + adac(c));
            o8[64 * j] = (u32x2){pk2(v[0], v[1]), pk2(v[2], v[3])}; }
    }
}

__device__ __forceinline__ void p3_mixer(const Args& a, const bf16_t* proj, bf16_t* PRE, bf16_t* CIN, int tid) {
    const int j0 = 2 * tid, wave = tid >> 6, W = 2 << (wave >> 1);
    const f32x2 cw0 = *(const f32x2*)(a.conv_w + j0), cw1 = *(const f32x2*)(a.conv_w + CW + j0), cw2 = *(const f32x2*)(a.conv_w + 2 * CW + j0);
    float* const npp = a.out + O_NPP; float* const ncp = a.out + O_NCP; float* const nps = a.out + O_NPS; float* const ncs = a.out + O_NCS;
    for (int it = blockIdx.x; it < 384; it += gridDim.x) {
        if (it < 256) {
            const int b = it >> 6, s0 = (it & 63) * 32;
            const bf16_t* pb = proj + (size_t)(b * SEQ) * INW + j0;
            float S0 = 0.f, S1 = 0.f;
            for (int i = 1; i < W; ++i) { const int s = s0 - i; if (s >= 0) { const unsigned w = *(const unsigned*)(pb + (size_t)s * INW); S0 += bflo(w); S1 += bfhi(w); } }
            float v1a = 0.f, v1b = 0.f, v2a = 0.f, v2b = 0.f;
            if (s0 >= 1) { const bf16_t* p = pb + (size_t)(s0 - 1) * INW; const unsigned wx = *(const unsigned*)(p + 1024), wc = *(const unsigned*)(p + 3072); v1a = bflo(wc) * bflo(wx); v1b = bfhi(wc) * bfhi(wx); }
            if (s0 >= 2) { const bf16_t* p = pb + (size_t)(s0 - 2) * INW; const unsigned wx = *(const unsigned*)(p + 1024), wc = *(const unsigned*)(p + 3072); v2a = bflo(wc) * bflo(wx); v2b = bfhi(wc) * bfhi(wx); }
#pragma unroll 4
            for (int s = s0; s < s0 + 32; ++s) {
                const bf16_t* p = pb + (size_t)s * INW;
                const unsigned wz = *(const unsigned*)p, wx = *(const unsigned*)(p + 1024), wb = *(const unsigned*)(p + 2048), wc = *(const unsigned*)(p + 3072);
                const float z0 = bflo(wz), z1 = bfhi(wz);
                S0 += z0; S1 += z1;
                const int cnt = (s + 1 < W) ? s + 1 : W; const float fc = (float)cnt;
                const float p0 = S0 / fc - z0, p1 = S1 / fc - z1;
                const int so = s - W + 1;
                if (so >= 0) { const unsigned wo = *(const unsigned*)(pb + (size_t)so * INW); S0 -= bflo(wo); S1 -= bfhi(wo); }
                const float va = bflo(wc) * bflo(wx), vb = bfhi(wc) * bfhi(wx);
                const float ya = cw0[0] * v2a + cw1[0] * v1a + cw2[0] * va, yb = cw0[1] * v2b + cw1[1] * v1b + cw2[1] * vb;
                const size_t row = (size_t)(b * SEQ + s);
                *(unsigned*)(PRE + row * PW + j0) = pk2(p0, p1);
                *(unsigned*)(CIN + row * CW + j0) = pk2(bflo(wb) * ya, bfhi(wb) * yb);
                if (s >= SEQ - 15) *(f32x2*)(npp + ((size_t)(b * 15 + s - (SEQ - 15))) * PW + j0) = (f32x2){z0, z1};
                if (s >= SEQ - 2) *(f32x2*)(ncp + ((size_t)(b * 2 + s - (SEQ - 2))) * CW + j0) = (f32x2){va, vb};
                v2a = v1a; v2b = v1b; v1a = va; v1b = vb;
            }
        } else {
            const int b = it - 256; const size_t row = (size_t)(MP + b);
            const bf16_t* p = proj + row * INW + j0;
            const unsigned wz = *(const unsigned*)p, wx = *(const unsigned*)(p + 1024), wb = *(const unsigned*)(p + 2048), wc = *(const unsigned*)(p + 3072);
            const float z0 = bflo(wz), z1 = bfhi(wz);
            const float* sp = a.state_pool + (size_t)b * 15 * PW + j0;
            float S0 = z0, S1 = z1;
            for (int i = 1; i < W; ++i) { const f32x2 h = *(const f32x2*)(sp + (size_t)(15 - i) * PW); S0 += h[0]; S1 += h[1]; }
            const float fc = (float)W;
            *(unsigned*)(PRE + row * PW + j0) = pk2(S0 / fc - z0, S1 / fc - z1);
            const f32x2 h0 = *(const f32x2*)(a.state_conv + (size_t)(b * 2) * CW + j0), h1 = *(const f32x2*)(a.state_conv + (size_t)(b * 2 + 1) * CW + j0);
            const float va = bflo(wc) * bflo(wx), vb = bfhi(wc) * bfhi(wx);
            const float ya = cw0[0] * h0[0] + cw1[0] * h1[0] + cw2[0] * va, yb = cw0[1] * h0[1] + cw1[1] * h1[1] + cw2[1] * vb;
            *(unsigned*)(CIN + row * CW + j0) = pk2(bflo(wb) * ya, bfhi(wb) * yb);
#pragma unroll
            for (int r = 0; r < 14; ++r) *(f32x2*)(nps + ((size_t)(b * 15 + r)) * PW + j0) = *(const f32x2*)(sp + (size_t)(r + 1) * PW);
            *(f32x2*)(nps + ((size_t)(b * 15 + 14)) * PW + j0) = (f32x2){z0, z1};
            *(f32x2*)(ncs + ((size_t)(b * 2)) * CW + j0) = h1;
            *(f32x2*)(ncs + ((size_t)(b * 2 + 1)) * CW + j0) = (f32x2){va, vb};
        }
    }
}

__device__ __forceinline__ void ln_row(f32x4 (&v)[8], const f32x4 (&g4)[8], const f32x4 (&b4)[8]) {
    float s = 0.f;
#pragma unroll
    for (int j = 0; j < 8; ++j) s += (v[j][0] + v[j][1]) + (v[j][2] + v[j][3]);
    const float mean = wave_sum(s) * (1.f / D); float s2 = 0.f;
#pragma unroll
    for (int j = 0; j < 8; ++j) { v[j] = v[j] - mean; s2 += (v[j][0] * v[j][0] + v[j][1] * v[j][1]) + (v[j][2] * v[j][2] + v[j][3] * v[j][3]); }
    const float rstd = 1.f / sqrtf(wave_sum(s2) * (1.f / D) + LN_EPS);
#pragma unroll
    for (int j = 0; j < 8; ++j) v[j] = v[j] * rstd * g4[j] + b4[j];
}
__device__ __forceinline__ void p6_ln1(const Args& a, const float* ada, float* res, const float* part, bf16_t* U, int gw, int NGW, int lane) {
    f32x4 lg[8], lb[8];
#pragma unroll
    for (int j = 0; j < 8; ++j) { lg[j] = ((const f32x4*)a.ln1_g + lane)[64 * j]; lb[j] = ((const f32x4*)a.ln1_b + lane)[64 * j]; }
    for (int r = gw, nr; r >= 0; r = nr) { nr = -1; if (r < MP) { nr = r + NGW; if (nr >= MP) nr = ((gw & 15) == 0 && (gw >> 4) < NS && NGW >= 16 * NS) ? MP + (gw >> 4) : ((NGW >= 16 * NS) ? -1 : (nr < MV ? nr : -1)); } else if (NGW < 16 * NS) { nr = r + NGW; if (nr >= MV) nr = -1; }
        u32x2* o8 = (u32x2*)(U + (size_t)r * D) + lane;
        f32x4* rr = (f32x4*)(res + (size_t)r * D) + lane;
        const float* ar = ada + (size_t)cond_row(r) * NADAP;
        f32x4 v[8];
        if (r < MP) {
#pragma unroll
            for (int j = 0; j < 8; ++j) v[j] = rr[64 * j];
        } else {
            const f32x4* xr = (const f32x4*)(a.x_sample + (size_t)(r - MP) * D) + lane;
#pragma unroll
            for (int j = 0; j < 8; ++j) { f32x4 sum = (f32x4){0.f, 0.f, 0.f, 0.f};
#pragma unroll
                for (int sl = 0; sl < 8; ++sl) sum += ((const f32x4*)(part + ((size_t)sl * NS + (r - MP)) * D) + lane)[64 * j];
                v[j] = xr[64 * j] * ALPHA + *(const f32x4*)(ar + adac(2 * D + 4 * (lane + 64 * j))) * sum; }
        }
        ln_row(v, lg, lb);
#pragma unroll
        for (int j = 0; j < 8; ++j) { const int c = 4 * (lane + 64 * j); rr[64 * j] = v[j]; const f32x4 t = v[j] * (*(const f32x4*)(ar + adac(4 * D + c)) + 1.f) + *(const f32x4*)(ar + adac(3 * D + c));
            o8[64 * j] = (u32x2){pk2(t[0], t[1]), pk2(t[2], t[3])}; }
    }
}
__device__ __forceinline__ void p9_ln2(const Args& a, const float* ada, const float* res, const float* part, int gw, int NGW, int lane) {
    f32x4 lg[8], lb[8];
#pragma unroll
    for (int j = 0; j < 8; ++j) { lg[j] = ((const f32x4*)a.ln2_g + lane)[64 * j]; lb[j] = ((const f32x4*)a.ln2_b + lane)[64 * j]; }
    for (int r = gw, nr; r >= 0; r = nr) { nr = -1; if (r < MP) { nr = r + NGW; if (nr >= MP) nr = ((gw & 15) == 0 && (gw >> 4) < NS && NGW >= 16 * NS) ? MP + (gw >> 4) : ((NGW >= 16 * NS) ? -1 : (nr < MV ? nr : -1)); } else if (NGW < 16 * NS) { nr = r + NGW; if (nr >= MV) nr = -1; }
        const f32x4* rr = (const f32x4*)(res + (size_t)r * D) + lane;
        f32x4 v[8];
#pragma unroll
        for (int j = 0; j < 8; ++j) v[j] = rr[64 * j];
        if (r >= MP) {
            const float* ar = ada + (size_t)cond_row(r) * NADAP;
#pragma unroll
            for (int j = 0; j < 8; ++j) { f32x4 sum = *((const f32x4*)a.b_ff2 + lane + 64 * j);
#pragma unroll
                for (int sl = 0; sl < 8; ++sl) sum += ((const f32x4*)(part + ((size_t)sl * NS + (r - MP)) * D) + lane)[64 * j];
                v[j] = v[j] * ALPHA + *(const f32x4*)(ar + adac(5 * D + 4 * (lane + 64 * j))) * sum; }
        }
        ln_row(v, lg, lb);
        f32x4* o = (f32x4*)(a.out + (r < MP ? O_YP + (size_t)r * D : O_YS + (size_t)(r - MP) * D)) + lane;
#pragma unroll
        for (int j = 0; j < 8; ++j) o[64 * j] = v[j];
    }
}

typedef f32x4 Acc128[4][2];
__device__ __forceinline__ void gemm128_core(Acc128& acc, LAS unsigned char* lds, const bf16_t* A, const bf16_t* Bt, const int K  , const int klen  ) {
    using namespace pg8;
    const int tid = threadIdx.x, wid = __builtin_amdgcn_readfirstlane(tid >> 6), lane = tid & 63, wr = wid >> 2, wc = wid & 3, fr = lane & 15, fq = lane >> 4;
    const int nt = klen / 64;
    unsigned voff[2];
#pragma unroll
    for (int i = 0; i < 2; ++i) { int R, C; stage_rc(tid * 16 + i * 8192, R, C); voff[i] = (unsigned)(R * K + C) * 2u; }
    const unsigned ldsw = (unsigned)wid * 1024u;
    const int aoff = lds_byte(wr * 64 + fr, fq * 8), boff = lds_byte(wc * 32 + fr, fq * 8);
    const char* pa = (const char*)A; const char* pb = (const char*)Bt;
#define G128_STAGE(st, kt) do { _Pragma("unroll") for (int _i = 0; _i < 2; ++_i) { \
        __builtin_amdgcn_global_load_lds((const unsigned*)(pa + (size_t)(kt) * 128 + voff[_i]), (LAS unsigned*)(lds + (st) * 32768 + ldsw + _i * 8192), 16, 0, 0); \
        __builtin_amdgcn_global_load_lds((const unsigned*)(pb + (size_t)(kt) * 128 + voff[_i]), (LAS unsigned*)(lds + (st) * 32768 + 16384 + ldsw + _i * 8192), 16, 0, 0); } } while (0)
    G128_STAGE(0, 0); G128_STAGE(1, 1 < nt ? 1 : nt - 1); G128_STAGE(2, 2 < nt ? 2 : nt - 1);
#pragma unroll 1
    for (int t = 0; t < nt; ++t) {
        asm volatile("s_waitcnt vmcnt(8)" ::: "memory");
        __builtin_amdgcn_s_barrier();
        asm volatile("" ::: "memory");
        { const int kt = t + 3 < nt ? t + 3 : nt - 1; G128_STAGE((t + 3) & 3, kt); }
        const LAS unsigned char* sa = lds + (t & 3) * 32768; const LAS unsigned char* sb = sa + 16384;
        bf16x8 af[4][2], bfr[2][2];
#pragma unroll
        for (int m = 0; m < 4; ++m)
#pragma unroll
            for (int k = 0; k < 2; ++k) af[m][k] = *(const LAS bf16x8*)(sa + aoff + m * 2048 + k * 1024);
#pragma unroll
        for (int n = 0; n < 2; ++n)
#pragma unroll
            for (int k = 0; k < 2; ++k) bfr[n][k] = *(const LAS bf16x8*)(sb + boff + n * 2048 + k * 1024);
#pragma unroll
        for (int m = 0; m < 4; ++m)
#pragma unroll
            for (int n = 0; n < 2; ++n)
#pragma unroll
                for (int k = 0; k < 2; ++k) acc[m][n] = __builtin_amdgcn_mfma_f32_16x16x32_bf16(bfr[n][k], af[m][k], acc[m][n], 0, 0, 0);
        asm volatile("s_waitcnt lgkmcnt(0)" ::: "memory");
    }
    asm volatile("s_waitcnt vmcnt(0)" ::: "memory");
    __builtin_amdgcn_s_barrier();
    asm volatile("" ::: "memory");
#undef G128_STAGE
}
__device__ __forceinline__ void zero128(Acc128& acc) {
#pragma unroll
    for (int m = 0; m < 4; ++m)
#pragma unroll
        for (int n = 0; n < 2; ++n) acc[m][n] = (f32x4){0.f, 0.f, 0.f, 0.f};
}
template <int MODE>
__device__ __forceinline__ void sample_gemm(const Args& a, LAS unsigned char* lds, const bf16_t* A0, const bf16_t* B0, const bf16_t* A1, const bf16_t* B1, const int K, const int N,
                                            const bf16_t* proj, bf16_t* Ob, float* res, const float* ada) {
    const int tid = threadIdx.x, wid = __builtin_amdgcn_readfirstlane(tid >> 6), lane = tid & 63, wr = wid >> 2, wc = wid & 3, fr = lane & 15, fq = lane >> 4;
    constexpr int NSL = (MODE >= 3) ? 8 : 1;
    for (int unit = blockIdx.x; unit < (N / 128) * NSL; unit += gridDim.x) {
        const int n0 = (unit / NSL) * 128, sl = unit % NSL, klen = K / NSL;
        Acc128 acc, acc2;
        zero128(acc);
        gemm128_core(acc, lds, A0 + (size_t)MP * K + sl * klen, B0 + (size_t)n0 * K + sl * klen, K, klen);
        if (MODE == 2) { zero128(acc2); gemm128_core(acc2, lds, A1 + (size_t)MP * K, B1 + (size_t)n0 * K, K, K); }
#pragma unroll
        for (int m = 0; m < 4; ++m) { const int ms = wr * 64 + m * 16 + fr; const size_t row = (size_t)(MP + ms);
#pragma unroll
            for (int n = 0; n < 2; ++n) { const int c = n0 + wc * 32 + n * 16 + 4 * fq; f32x4 v = acc[m][n];
                if (MODE == 0) { *(u32x2*)(Ob + row * INW + c) = (u32x2){pk2(v[0], v[1]), pk2(v[2], v[3])}; }
                else if (MODE == 1) { v = v + *(const f32x4*)(a.b_ff1 + c);
#pragma unroll
                    for (int j = 0; j < 4; ++j) { const float r = fmaxf(v[j], 0.f); v[j] = r * r; }
                    *(u32x2*)(Ob + row * DFF + c) = (u32x2){pk2(v[0], v[1]), pk2(v[2], v[3])}; }
                else if (MODE == 2) {
                    const u32x2 gpw = *(const u32x2*)(proj + row * INW + 4096 + c), gcw = *(const u32x2*)(proj + row * INW + 6144 + c);
                    const float gp[4] = {bflo(gpw.x), bfhi(gpw.x), bflo(gpw.y), bfhi(gpw.y)}, gc[4] = {bflo(gcw.x), bfhi(gcw.x), bflo(gcw.y), bfhi(gcw.y)};
                    float o[4];
#pragma unroll
                    for (int j = 0; j < 4; ++j) o[j] = v[j] / (1.f + __expf(-gp[j])) + acc2[m][n][j] / (1.f + __expf(-gc[j]));
                    *(u32x2*)(Ob + row * D + c) = (u32x2){pk2(o[0], o[1]), pk2(o[2], o[3])}; }
                else { *(f32x4*)(res + ((size_t)sl * NS + ms) * D + c) = v; }
            } }
    }
}

#define XB_TMO      128
#define XB_XCNT(j)  (256  + 64 * (j))
#define XB_XSUB(j)  (1280 + 64 * (j))
#define XB_XGEN(j)  (2304 + 64 * (j))
#define XB_TOP      3328
#define XB_TOPGEN   3392
#define XCD_BAR_WORDS 3456
#define XB_SPIN_CAP (1u << 18)
__device__ __forceinline__ unsigned xb_ld(unsigned* p)              { return __hip_atomic_load(p, __ATOMIC_RELAXED, __HIP_MEMORY_SCOPE_AGENT); }
__device__ __forceinline__ unsigned xb_add(unsigned* p, unsigned v) { return __hip_atomic_fetch_add(p, v, __ATOMIC_RELAXED, __HIP_MEMORY_SCOPE_AGENT); }
__device__ __forceinline__ unsigned xb_xcc_id() { return (unsigned)__builtin_amdgcn_s_getreg((3 << 11) | 20) & 0xFu; }
#define XB_SPIN(cond, bar) do { unsigned _sp = 0; while (cond) { __builtin_amdgcn_s_sleep(1); \
    if ((++_sp & 255u) == 0u) { if (xb_ld(&(bar)[XB_TMO])) break; if (_sp > XB_SPIN_CAP) { atomicAdd(&(bar)[XB_TMO], 1u); break; } } } } while (0)
struct XcdBarrier { unsigned* bar; unsigned x; volatile LAS unsigned* st; };
__device__ __forceinline__ XcdBarrier xcd_barrier_post(unsigned* bar, volatile LAS unsigned* st) {
    XcdBarrier b; b.bar = bar; b.x = xb_xcc_id(); b.st = st;
    if (threadIdx.x == 0) (void)xb_add(&bar[XB_XCNT(b.x)], 1u);
    return b;
}
__device__ __forceinline__ void xcd_barrier_complete(unsigned* bar, unsigned x, unsigned& nloc, unsigned& nx) {
    const unsigned G = gridDim.x * gridDim.y * gridDim.z;
    unsigned sum, cnt, mine, sp = 0u;
    for (;;) {
        sum = 0u; cnt = 0u; mine = 0u;
#pragma unroll
        for (unsigned j = 0; j < 16; ++j) { const unsigned c = xb_ld(&bar[XB_XCNT(j)]); sum += c; cnt += (c > 0u) ? 1u : 0u; mine = (j == x) ? c : mine; }
        if (sum == G) break;
        __builtin_amdgcn_s_sleep(1);
        if ((++sp & 255u) == 0u) { if (xb_ld(&bar[XB_TMO])) break; if (sp > XB_SPIN_CAP) { atomicAdd(&bar[XB_TMO], 1u); break; } }
    }
    nloc = mine > 0u ? mine : 1u; nx = cnt > 0u ? cnt : 1u;
}
__device__ __forceinline__ void xcd_barrier(const XcdBarrier& b) {
    asm volatile("s_waitcnt vmcnt(0)" ::: "memory");
    __syncthreads();
    if (threadIdx.x == 0) {
        unsigned* bar = b.bar;
        __builtin_amdgcn_s_waitcnt(0);
        unsigned nloc = b.st[0], nx = b.st[1];
        if (nloc == 0u) { xcd_barrier_complete(bar, b.x, nloc, nx); b.st[0] = nloc; b.st[1] = nx; }
        const unsigned old = xb_add(&bar[XB_XSUB(b.x)], 1u);
        const unsigned gen = old / nloc;
        if (old + 1u == (gen + 1u) * nloc) {
            __builtin_amdgcn_fence(__ATOMIC_RELEASE, "agent");
            asm volatile("s_waitcnt vmcnt(0)" ::: "memory");
            const unsigned og = xb_add(&bar[XB_TOP], 1u);
            const unsigned tg = og / nx;
            if (og + 1u == (tg + 1u) * nx) xb_add(&bar[XB_TOPGEN], 1u);
            else XB_SPIN(xb_ld(&bar[XB_TOPGEN]) == tg, bar);
            __builtin_amdgcn_fence(__ATOMIC_ACQUIRE, "agent");
            xb_add(&bar[XB_XGEN(b.x)], 1u);
            asm volatile("s_waitcnt vmcnt(0)" ::: "memory");
        } else {
            XB_SPIN(xb_ld(&bar[XB_XGEN(b.x)]) == gen, bar);
            __builtin_amdgcn_fence(__ATOMIC_ACQUIRE, "agent");
            asm volatile("s_waitcnt vmcnt(0)" ::: "memory");
        }
    }
    __syncthreads();
}

__device__ __forceinline__ void p0_all(const Args& a, LAS unsigned char* lds, int tid, int lane, int wave, int bx, int G) {
    unsigned char* ws = a.ws;
    float* ada = (float*)(ws + WS_ADA);
    bf16_t* WinT = (bf16_t*)(ws + WS_WIN); bf16_t* Wff1T = (bf16_t*)(ws + WS_WFF1); bf16_t* Wff2T = (bf16_t*)(ws + WS_WFF2); bf16_t* WoT = (bf16_t*)(ws + WS_WO);
    bf16_t* WupP = (bf16_t*)(ws + WS_WUPP); bf16_t* WupC = (bf16_t*)(ws + WS_WUPC);
    const int gw = bx * 8 + wave, NGW = G * 8;
    for (int it = bx; it < NADA / 48; it += G) p0_ada_item(a, ada, lds, it, wave, lane);
    for (int it = bx; it < 512; it += G) p0_weff_item(a, WupP, lds, it, tid);
    {
        LAS float* scr = (LAS float*)(lds + wave * 16384);
        constexpr int I_IN = (D / 64) * (INW / 32), I_F1 = (D / 64) * (DFF / 32), I_F2 = (DFF / 64) * (D / 32), I_O = (D / 64) * (D / 32), I_C = (CW / 64) * (D / 32);
        constexpr int NIT = I_IN + I_F1 + I_F2 + I_O + I_C;
        for (int it = gw; it < NIT; it += NGW) {
            int r = it;
            if (r < I_IN) { p0_transpose_item(a.w_in, D, INW, WinT, scr, r, lane); continue; } r -= I_IN;
            if (r < I_F1) { p0_transpose_item(a.w_ff1, D, DFF, Wff1T, scr, r, lane); continue; } r -= I_F1;
            if (r < I_F2) { p0_transpose_item(a.w_ff2, DFF, D, Wff2T, scr, r, lane); continue; } r -= I_F2;
            if (r < I_O) { p0_transpose_item(a.w_o, D, D, WoT, scr, r, lane); continue; } r -= I_O;
            p0_transpose_item(a.w_conv_up, CW, D, WupC, scr, r, lane);
        }
    }
}

__global__ void __launch_bounds__(512, 2) fwd_megakernel(Args a) {
    extern __shared__ __attribute__((aligned(16))) unsigned char lds_raw[];
    LAS unsigned char* lds = (LAS unsigned char*)lds_raw;
    const int tid = threadIdx.x, lane = tid & 63, wave = __builtin_amdgcn_readfirstlane(tid >> 6);
    const int G = gridDim.x, bx = blockIdx.x;
    const int gw = bx * 8 + wave, NGW = G * 8;
    unsigned char* ws = a.ws;
    float* ada = (float*)(ws + WS_ADA);
    unsigned* ctr = (unsigned*)(ws + WS_CTL);
    if (tid < 64) ((LAS unsigned*)(lds + MISC_OFF))[tid] = 0u;
    __syncthreads();
    const XcdBarrier xbar = xcd_barrier_post(ctr, (volatile LAS unsigned*)(lds + MISC_OFF));
#define GB() xcd_barrier(xbar)
    bf16_t* WinT = (bf16_t*)(ws + WS_WIN); bf16_t* Wff1T = (bf16_t*)(ws + WS_WFF1); bf16_t* Wff2T = (bf16_t*)(ws + WS_WFF2); bf16_t* WoT = (bf16_t*)(ws + WS_WO);
    bf16_t* WupP = (bf16_t*)(ws + WS_WUPP); bf16_t* WupC = (bf16_t*)(ws + WS_WUPC);
    bf16_t* U = (bf16_t*)(ws + WS_U); bf16_t* PROJ = (bf16_t*)(ws + WS_PROJ); float* RES = (float*)(ws + WS_RES);
    float* PART = (float*)(ws + WS_PART);
    bf16_t* PRE = (bf16_t*)(ws + WS_RES); bf16_t* CIN = (bf16_t*)(ws + WS_RES + WS_CIN_OFF);

    p0_all(a, lds, tid, lane, wave, bx, G);
    GB();
    p1_modulate(a, ada, U, gw, NGW, lane);
    GB();
    { pg8::Order S; S.init(MP, INW, G, bx, 1, U, WinT, U, WinT);
      pg8::EpiBf16<0> E{PROJ, INW, nullptr};
      pg8::gemm_phase(lds, D, S, E); }
    sample_gemm<0>(a, lds, U, WinT, U, WinT, D, INW, PROJ, PROJ, RES, ada);
    GB();
    p3_mixer(a, PROJ, PRE, CIN, tid);
    GB();
    { pg8::Order S; S.init(MP, D, G, bx, 2, PRE, WupP, CIN, WupC);
      pg8::EpiGate E{PROJ, U};
      pg8::gemm_phase(lds, PW, S, E); }
    sample_gemm<2>(a, lds, PRE, WupP, CIN, WupC, PW, D, PROJ, U, RES, ada);
    GB();
    { pg8::Order S; S.init(MP, D, G, bx, 1, U, WoT, U, WoT);
      pg8::EpiRes E{RES, a.x_prompt, ada, 2 * D, nullptr};
      pg8::gemm_phase(lds, D, S, E); }
    sample_gemm<3>(a, lds, U, WoT, U, WoT, D, D, PROJ, U, PART, ada);
    GB();
    p6_ln1(a, ada, RES, PART, U, gw, NGW, lane);
    GB();
    { pg8::Order S; S.init(MP, DFF, G, bx, 1, U, Wff1T, U, Wff1T);
      pg8::EpiBf16<1> E{PROJ, DFF, a.b_ff1};
      pg8::gemm_phase(lds, D, S, E); }
    sample_gemm<1>(a, lds, U, Wff1T, U, Wff1T, D, DFF, PROJ, PROJ, RES, ada);
    GB();
    { pg8::Order S; S.init(MP, D, G, bx, 1, PROJ, Wff2T, PROJ, Wff2T);
      pg8::EpiRes E{RES, RES, ada, 5 * D, a.b_ff2};
      pg8::gemm_phase(lds, DFF, S, E); }
    sample_gemm<4>(a, lds, PROJ, Wff2T, PROJ, Wff2T, DFF, D, PROJ, U, PART, ada);
    GB();
    p9_ln2(a, ada, RES, PART, gw, NGW, lane);
}

extern "C" void kernel_launch(void* const* d_in, const int* in_sizes, int n_in, void* d_out, int out_size, void* d_ws, size_t ws_size, hipStream_t stream) {
    static int grid = 0;
    if (grid == 0) {
        if (n_in != 23 || ws_size < WS_END) { fprintf(stderr, "kernel_launch: expected 23 inputs and >= %zu bytes of workspace; got %d, %zu\n", (size_t)WS_END, n_in, ws_size); grid = -1; return; }
        int dev = 0, cus = 0, per_cu = 0;
        hipGetDevice(&dev);
        hipDeviceGetAttribute(&cus, hipDeviceAttributeMultiprocessorCount, dev);
        if (hipFuncSetAttribute((const void*)fwd_megakernel, hipFuncAttributeMaxDynamicSharedMemorySize, LDS_BYTES) != hipSuccess) { fprintf(stderr, "kernel_launch: hipFuncSetAttribute failed\n"); grid = -1; return; }
        if (hipOccupancyMaxActiveBlocksPerMultiprocessor(&per_cu, (const void*)fwd_megakernel, 512, LDS_BYTES) != hipSuccess || per_cu < 1) { fprintf(stderr, "kernel_launch: occupancy query says %d blocks per CU\n", per_cu); (void)hipGetLastError(); per_cu = 1; }
        grid = cus;
        fprintf(stderr, "kernel_launch: cus %d per_cu %d grid %d\n", cus, per_cu, grid);
    }
    if (grid < 0) return;
    if (hipMemsetAsync((char*)d_ws + WS_CTL, 0, 16384, stream) != hipSuccess) { fprintf(stderr, "kernel_launch: memset failed\n"); return; }
    Args a{};
    const float** ap = (const float**)&a;
    for (int i = 0; i < 23; ++i) ap[i] = (const float*)d_in[i];
    a.out = (float*)d_out; a.ws = (unsigned char*)d_ws;
    void* args[] = {&a};
    hipError_t e = hipLaunchCooperativeKernel((const void*)fwd_megakernel, dim3(grid), dim3(512), args, LDS_BYTES, stream);
    if (e != hipSuccess) fprintf(stderr, "kernel_launch: cooperative launch failed: %s (grid %d)\n", hipGetErrorString(e), grid);
}
```

```cpp
#include <hip/hip_runtime.h>
#include <cstdio>
#include <cstdint>

#define LAS __attribute__((address_space(3)))
typedef unsigned short bf16_t;
typedef short bf16x8 __attribute__((ext_vector_type(8)));
typedef float f32x4 __attribute__((ext_vector_type(4)));
typedef float f32x2 __attribute__((ext_vector_type(2)));
typedef unsigned u32x4 __attribute__((ext_vector_type(4)));
typedef unsigned u32x2 __attribute__((ext_vector_type(2)));

constexpr int D = 2048, NB = 4, SEQ = 2048, NS = 128;
constexpr int MP = NB * SEQ;
constexpr int MV = MP + NS;
constexpr int MPAD = 8448;
constexpr int PW = 1024, CW = 1024, DFF = 8192, INW = 8192, NADA = 6 * D, NCOND = NB + NS;
constexpr float ALPHA = 1.18920711500272f;
constexpr float LN_EPS = 1e-5f;
constexpr int NADAP = 256 * 64;
__device__ __forceinline__ int adac(int n) { return n + 16 * (n / 48); }

constexpr size_t MiB = 1u << 20;
constexpr size_t WS_CTL = 0;
constexpr size_t WS_ADA = 352 * MiB;
constexpr size_t WS_WIN = 8 * MiB, WS_WFF1 = 40 * MiB, WS_WFF2 = 72 * MiB, WS_WO = 104 * MiB, WS_WUPP = 112 * MiB, WS_WUPC = 116 * MiB;
constexpr size_t WS_U = 120 * MiB;
constexpr size_t WS_PROJ = 153 * MiB;
constexpr size_t WS_RES = 285 * MiB;
constexpr size_t WS_PART = 362 * MiB;
constexpr size_t WS_END = 378 * MiB;
constexpr size_t WS_CIN_OFF = (size_t)MPAD * 1024 * 2;

constexpr size_t O_YP = 0, O_YS = (size_t)MP * D, O_NPP = O_YS + (size_t)NS * D, O_NCP = O_NPP + (size_t)NB * 15 * PW, O_NPS = O_NCP + (size_t)NB * 2 * CW, O_NCS = O_NPS + (size_t)NS * 15 * PW;

constexpr int LDS_BYTES = 131072 + 256, MISC_OFF = 131072;

__device__ __forceinline__ unsigned f2bf(float f) { unsigned u = __builtin_bit_cast(unsigned, f); return (u + 0x7fffu + ((u >> 16) & 1u)) >> 16; }
__device__ __forceinline__ unsigned pk2(float lo, float hi) { return f2bf(lo) | (f2bf(hi) << 16); }
__device__ __forceinline__ unsigned cvt_pk_bf16(float lo, float hi) { unsigned r; asm volatile("v_cvt_pk_bf16_f32 %0, %1, %2" : "=v"(r) : "v"(lo), "v"(hi)); return r; }
__device__ __forceinline__ float bflo(unsigned w) { return __builtin_bit_cast(float, w << 16); }
__device__ __forceinline__ float bfhi(unsigned w) { return __builtin_bit_cast(float, w & 0xffff0000u); }
__device__ __forceinline__ int cond_row(int r) { int s = r - MP; s = s < 0 ? 0 : (s > NS - 1 ? NS - 1 : s); return r < MP ? (r >> 11) : NB + s; }
__device__ __forceinline__ const float* x_rowp(const float* xp, const float* xs, int r) { int s = r - MP; s = s < 0 ? 0 : (s > NS - 1 ? NS - 1 : s); return r < MP ? xp + (size_t)r * D : xs + (size_t)s * D; }

namespace pg8 {
constexpr int BM = 256, BK = 64, HALF = 128, HTB = HALF * BK * 2, NXCD = 8, WGM = 4;
__device__ __forceinline__ int lds_byte(int r, int c) { const int st = (r >> 4) * 2 + (c >> 5), rr = r & 15, cc = c & 31, ob = rr * 64 + cc * 2; return st * 1024 + (ob ^ (((ob >> 9) & 1) << 5)); }
__device__ __forceinline__ void stage_rc(int b, int& R, int& C) { const int st = b / 1024, sb = b % 1024, swz = sb ^ (((sb >> 9) & 1) << 5); R = (st >> 1) * 16 + swz / 64; C = (st & 1) * 32 + (swz % 64) / 2; }
__device__ __forceinline__ int perm32(int rho) { const int n = rho >> 4, i = rho & 15; return 8 * (i >> 2) + 4 * n + (i & 3); }

struct Unit { int pm, pn, grp; };
struct Order {
    int nM, nN, nwg, G, c, rep;
    const char* A0; const char* B0; const char* A1; const char* B1;
    __device__ __forceinline__ void init(int M, int N, int G_, int c_, int rep_, const void* a0, const void* b0, const void* a1, const void* b1) {
        nM = M / BM; nN = N / BM; nwg = nM * nN; G = G_; c = c_; rep = rep_; A0 = (const char*)a0; B0 = (const char*)b0; A1 = (const char*)a1; B1 = (const char*)b1; }
    __device__ __forceinline__ bool next(int i, Unit& u) const {
        const int ti = (rep == 2) ? (i >> 1) : i; u.grp = (rep == 2) ? (i & 1) : 0;
        const long L = (long)ti * G + c; if (L >= nwg) return false;
        int wgid = (int)L; { const int q = nwg / NXCD, r = nwg % NXCD, xcd = wgid % NXCD, off = wgid / NXCD; wgid = (xcd < r ? xcd * (q + 1) : r * (q + 1) + (xcd - r) * q) + off; }
        const int nig = WGM * nN, gid = wgid / nig, fm = gid * WGM, gsz = (nM - fm) < WGM ? (nM - fm) : WGM;
        u.pm = fm + ((wgid % nig) % gsz); u.pn = (wgid % nig) / gsz; return true;
    }
    __device__ __forceinline__ const char* baseA(const Unit& u, size_t tstep) const { return (u.grp ? A1 : A0) + (size_t)u.pm * tstep; }
    __device__ __forceinline__ const char* baseB(const Unit& u, size_t tstep) const { return (u.grp ? B1 : B0) + (size_t)u.pn * tstep; }
};

typedef f32x4 Acc[2][2][4][2];

template <int ACT> struct EpiBf16 {
    static constexpr bool PERM = true;
    bf16_t* O; int ldc; const float* bias;
    __device__ __forceinline__ bool keep(const Unit&) const { return false; }
    __device__ __forceinline__ void operator()(Acc& acc, const Unit& u, int wr, int wc, int fr, int fq) const {
        const int row0 = u.pm * BM + wr * 64 + fr, col0 = u.pn * BM + wc * 32 + 8 * fq;
        f32x4 bv[2][2];
#pragma unroll
        for (int bj = 0; bj < 2; ++bj)
#pragma unroll
            for (int n = 0; n < 2; ++n) bv[bj][n] = bias ? *(const f32x4*)(bias + col0 + bj * HALF + 4 * n) : (f32x4){0.f, 0.f, 0.f, 0.f};
#pragma unroll
        for (int ai = 0; ai < 2; ++ai)
#pragma unroll
            for (int m = 0; m < 4; ++m) { bf16_t* rowp = O + (size_t)(row0 + ai * HALF + m * 16) * ldc + col0;
#pragma unroll
                for (int bj = 0; bj < 2; ++bj) { f32x4 v0 = acc[ai][bj][m][0] + bv[bj][0], v1 = acc[ai][bj][m][1] + bv[bj][1];
                    if (ACT == 1) {
#pragma unroll
                        for (int j = 0; j < 4; ++j) { const float a = fmaxf(v0[j], 0.f), b = fmaxf(v1[j], 0.f); v0[j] = a * a; v1[j] = b * b; } }
                    u32x4 w; w.x = cvt_pk_bf16(v0[0], v0[1]); w.y = cvt_pk_bf16(v0[2], v0[3]); w.z = cvt_pk_bf16(v1[0], v1[1]); w.w = cvt_pk_bf16(v1[2], v1[3]);
                    *(u32x4*)(rowp + bj * HALF) = w; } }
    }
};
__device__ __forceinline__ void unpack8(const u32x4 w, float (&e)[8]) { e[0] = bflo(w.x); e[1] = bfhi(w.x); e[2] = bflo(w.y); e[3] = bfhi(w.y); e[4] = bflo(w.z); e[5] = bfhi(w.z); e[6] = bflo(w.w); e[7] = bfhi(w.w); }
struct EpiGate {
    static constexpr bool PERM = true;
    const bf16_t* proj; bf16_t* O;
    __device__ __forceinline__ bool keep(const Unit& u) const { return u.grp == 0; }
    __device__ __forceinline__ void operator()(Acc& acc, const Unit& u, int wr, int wc, int fr, int fq) const {
        const int row0 = u.pm * BM + wr * 64 + fr, col0 = u.pn * BM + wc * 32 + 8 * fq;
        const bool g0 = (u.grp == 0);
        u32x4 gcw[2], gpw[2];
        { const bf16_t* p = proj + (size_t)row0 * INW + col0; gcw[0] = *(const u32x4*)(p + 6144); gpw[0] = g0 ? *(const u32x4*)(p + 4096) : gcw[0]; }
#pragma unroll
        for (int it = 0; it < 16; ++it) { const int ai = it >> 3, m = (it >> 1) & 3, bj = it & 1;
            const size_t row = (size_t)(row0 + ai * HALF + m * 16); const int col = col0 + bj * HALF;
            if (it < 15) { const int ai2 = (it + 1) >> 3, m2 = ((it + 1) >> 1) & 3, bj2 = (it + 1) & 1;
                const bf16_t* p = proj + (size_t)(row0 + ai2 * HALF + m2 * 16) * INW + col0 + bj2 * HALF;
                gcw[(it + 1) & 1] = *(const u32x4*)(p + 6144); gpw[(it + 1) & 1] = g0 ? *(const u32x4*)(p + 4096) : gcw[(it + 1) & 1]; }
            float ec[8]; unpack8(gcw[it & 1], ec);
#pragma unroll
            for (int j = 0; j < 8; ++j) ec[j] = 1.f + __expf(-fmaxf(ec[j], -30.f));
            if (g0) {
                float ep[8]; unpack8(gpw[it & 1], ep);
#pragma unroll
                for (int j = 0; j < 8; ++j) ep[j] = ec[j] * __builtin_amdgcn_rcpf(1.f + __expf(-ep[j]));
#pragma unroll
                for (int j = 0; j < 4; ++j) { acc[ai][bj][m][0][j] *= ep[j]; acc[ai][bj][m][1][j] *= ep[4 + j]; }
            } else {
                f32x4 v0, v1;
#pragma unroll
                for (int j = 0; j < 4; ++j) { v0[j] = acc[ai][bj][m][0][j] * __builtin_amdgcn_rcpf(ec[j]); v1[j] = acc[ai][bj][m][1][j] * __builtin_amdgcn_rcpf(ec[4 + j]); }
                u32x4 w; w.x = cvt_pk_bf16(v0[0], v0[1]); w.y = cvt_pk_bf16(v0[2], v0[3]); w.z = cvt_pk_bf16(v1[0], v1[1]); w.w = cvt_pk_bf16(v1[2], v1[3]);
                *(u32x4*)(O + row * D + col) = w;
            } }
    }
};
struct EpiRes {
    static constexpr bool PERM = false;
    float* res; const float* base; const float* ada; int gate_off; const float* bias;
    __device__ __forceinline__ bool keep(const Unit&) const { return false; }
    __device__ __forceinline__ void operator()(Acc& acc, const Unit& u, int wr, int wc, int fr, int fq) const {
        const int row0 = u.pm * BM + wr * 64 + fr, col0 = u.pn * BM + wc * 32 + 4 * fq;
        const float* gp = ada + (size_t)(u.pm >> 3) * NADAP;
        f32x4 bv[2][2], gv[2][2], xb[2][2][2];
#pragma unroll
        for (int bj = 0; bj < 2; ++bj)
#pragma unroll
            for (int n = 0; n < 2; ++n) { bv[bj][n] = bias ? *(const f32x4*)(bias + col0 + bj * HALF + n * 16) : (f32x4){0.f, 0.f, 0.f, 0.f}; gv[bj][n] = *(const f32x4*)(gp + adac(gate_off + col0 + bj * HALF + n * 16)); }
#pragma unroll
        for (int bj = 0; bj < 2; ++bj)
#pragma unroll
            for (int n = 0; n < 2; ++n) xb[0][bj][n] = *(const f32x4*)(base + (size_t)row0 * D + col0 + bj * HALF + n * 16);
#pragma unroll
        for (int it = 0; it < 8; ++it) { const int ai = it >> 2, m = it & 3;
            if (it < 7) { const float* bp = base + (size_t)(row0 + ((it + 1) >> 2) * HALF + ((it + 1) & 3) * 16) * D + col0;
#pragma unroll
                for (int bj = 0; bj < 2; ++bj)
#pragma unroll
                    for (int n = 0; n < 2; ++n) xb[(it + 1) & 1][bj][n] = *(const f32x4*)(bp + bj * HALF + n * 16); }
            float* rp = res + (size_t)(row0 + ai * HALF + m * 16) * D + col0;
#pragma unroll
            for (int bj = 0; bj < 2; ++bj)
#pragma unroll
                for (int n = 0; n < 2; ++n) *(f32x4*)(rp + bj * HALF + n * 16) = xb[it & 1][bj][n] * ALPHA + gv[bj][n] * (acc[ai][bj][m][n] + bv[bj][n]); }
    }
};

template <class Epi>
__device__ __forceinline__ void gemm_phase(LAS unsigned char* lds, const int K, const Order& S, const Epi& E) {
    const int tid = threadIdx.x, wid = __builtin_amdgcn_readfirstlane(tid >> 6), lane = tid & 63, wr = wid >> 2, wc = wid & 3, fr = lane & 15, fq = lane >> 4;
    const int nt = K / BK;
    unsigned voffA[2], voffB[2];
#pragma unroll
    for (int i = 0; i < 2; ++i) { int R, C; stage_rc(tid * 16 + i * 8192, R, C); const int Rb = Epi::PERM ? ((R & ~31) + perm32(R & 31)) : R;
        voffA[i] = (unsigned)(R * K + C) * 2u; voffB[i] = (unsigned)(Rb * K + C) * 2u; }
    const size_t kstep = (size_t)(BK * 2);
    const size_t hstep = (size_t)HALF * K * 2;
    const size_t tstep = 2 * hstep;
    const unsigned ldsw = (unsigned)wid * 1024u;
    const int aoff = lds_byte(wr * 64 + fr, fq * 8), boff = lds_byte(wc * 32 + fr, fq * 8);
#define PG8_SA(b, h) (((b) * 2 + (h)) * HTB)
#define PG8_SB(b, h) ((4 + (b) * 2 + (h)) * HTB)
#define PG8_STAGE(bufoff, gbase, voff) do { _Pragma("unroll") for (int _i = 0; _i < 2; ++_i) \
        __builtin_amdgcn_global_load_lds((const unsigned*)((const char*)(gbase) + (voff)[_i]), (LAS unsigned*)(lds + (bufoff) + ldsw + _i * 8192), 16, 0, 0); } while (0)
#define PG8_LDA(dst, b, h) do { _Pragma("unroll") for (int m = 0; m < 4; ++m) _Pragma("unroll") for (int k = 0; k < 2; ++k) dst[m][k] = *(const LAS bf16x8*)(lds + PG8_SA(b, h) + aoff + m * 2048 + k * 1024); } while (0)
#define PG8_LDB(dst, b, h) do { _Pragma("unroll") for (int n = 0; n < 2; ++n) _Pragma("unroll") for (int k = 0; k < 2; ++k) dst[n][k] = *(const LAS bf16x8*)(lds + PG8_SB(b, h) + boff + n * 2048 + k * 1024); } while (0)
#define PG8_MMA(ai, bj, At, Bt) do { __builtin_amdgcn_s_setprio(1); _Pragma("unroll") for (int m = 0; m < 4; ++m) _Pragma("unroll") for (int n = 0; n < 2; ++n) _Pragma("unroll") for (int k = 0; k < 2; ++k) \
        acc[ai][bj][m][n] = __builtin_amdgcn_mfma_f32_16x16x32_bf16(Bt[n][k], At[m][k], acc[ai][bj][m][n], 0, 0, 0); __builtin_amdgcn_s_setprio(0); } while (0)
#define PG8_WAIT_V(n) asm volatile("s_waitcnt vmcnt(" #n ")" ::: "memory")
#define PG8_WAIT_L(n) asm volatile("s_waitcnt lgkmcnt(" #n ")" ::: "memory")
#define PG8_BAR __builtin_amdgcn_s_barrier()
#define PG8_SCHED __builtin_amdgcn_sched_barrier(0)
    Unit cur, nxt; int ui = 0;
    if (!S.next(0, cur)) return;
    Acc acc;
#pragma unroll
    for (int a = 0; a < 2; ++a)
#pragma unroll
        for (int b = 0; b < 2; ++b)
#pragma unroll
            for (int m = 0; m < 4; ++m)
#pragma unroll
                for (int n = 0; n < 2; ++n) acc[a][b][m][n] = (f32x4){0.f, 0.f, 0.f, 0.f};
    bf16x8 At[4][2], B0[2][2], B1[2][2];
    const char* cA = S.baseA(cur, tstep); const char* cB = S.baseB(cur, tstep);
    PG8_STAGE(PG8_SB(0, 0), cB, voffB); PG8_STAGE(PG8_SB(0, 1), cB + hstep, voffB); PG8_STAGE(PG8_SA(0, 0), cA, voffA); PG8_STAGE(PG8_SA(0, 1), cA + hstep, voffA);
    if (wr == 1) PG8_BAR;
    PG8_WAIT_V(2); PG8_BAR;
    PG8_STAGE(PG8_SB(1, 0), cB + kstep, voffB); PG8_STAGE(PG8_SA(1, 0), cA + kstep, voffA); PG8_STAGE(PG8_SB(1, 1), cB + hstep + kstep, voffB);
    PG8_WAIT_V(6); PG8_BAR;
    for (;;) {
        const bool has_next = S.next(ui + 1, nxt);
        const char* nA = has_next ? S.baseA(nxt, tstep) : cA; const char* nB = has_next ? S.baseB(nxt, tstep) : cB;
        for (int t = 0; t < nt; t += 2) {
            const bool last = (t == nt - 2);
            const char* a1 = cA + (size_t)(t + 1) * kstep;
            const char* a2 = last ? nA : cA + (size_t)(t + 2) * kstep; const char* b2 = last ? nB : cB + (size_t)(t + 2) * kstep;
            const char* a3 = a2 + kstep; const char* b3 = b2 + kstep;
            PG8_LDB(B0, 0, 0); PG8_LDB(B1, 0, 1); PG8_SCHED; PG8_LDA(At, 0, 0); PG8_STAGE(PG8_SA(1, 1), a1 + hstep, voffA);
            PG8_WAIT_V(8); PG8_WAIT_L(0); PG8_BAR; PG8_MMA(0, 0, At, B0); PG8_MMA(0, 1, At, B1); PG8_BAR; PG8_SCHED;
            PG8_LDA(At, 0, 1); PG8_STAGE(PG8_SB(0, 0), b2, voffB); PG8_STAGE(PG8_SB(0, 1), b2 + hstep, voffB); PG8_STAGE(PG8_SA(0, 0), a2, voffA);
            PG8_WAIT_V(8); PG8_WAIT_L(0); PG8_BAR; PG8_MMA(1, 0, At, B0); PG8_MMA(1, 1, At, B1); PG8_BAR; PG8_SCHED;
            PG8_LDB(B0, 1, 0); PG8_LDB(B1, 1, 1); PG8_SCHED; PG8_LDA(At, 1, 0); PG8_STAGE(PG8_SA(0, 1), a2 + hstep, voffA);
            PG8_WAIT_V(8); PG8_WAIT_L(0); PG8_BAR; PG8_MMA(0, 0, At, B0); PG8_MMA(0, 1, At, B1); PG8_BAR; PG8_SCHED;
            PG8_LDA(At, 1, 1); PG8_STAGE(PG8_SB(1, 0), b3, voffB); PG8_STAGE(PG8_SB(1, 1), b3 + hstep, voffB); PG8_STAGE(PG8_SA(1, 0), a3, voffA);
            PG8_WAIT_V(8); PG8_WAIT_L(0); PG8_BAR; PG8_MMA(1, 0, At, B0); PG8_MMA(1, 1, At, B1); PG8_BAR; PG8_SCHED;
        }
        if (wr == 0) PG8_BAR;
        E(acc, cur, wr, wc, fr, fq);
        if (!has_next) break;
        if (!E.keep(cur)) {
#pragma unroll
            for (int a = 0; a < 2; ++a)
#pragma unroll
                for (int b = 0; b < 2; ++b)
#pragma unroll
                    for (int m = 0; m < 4; ++m)
#pragma unroll
                        for (int n = 0; n < 2; ++n) acc[a][b][m][n] = (f32x4){0.f, 0.f, 0.f, 0.f};
        }
        cur = nxt; cA = nA; cB = nB; ++ui;
        if (wr == 1) PG8_BAR;
    }
    PG8_WAIT_V(0);
    PG8_BAR;
#undef PG8_SA
#undef PG8_SB
#undef PG8_STAGE
#undef PG8_LDA
#undef PG8_LDB
#undef PG8_MMA
#undef PG8_WAIT_V
#undef PG8_WAIT_L
#undef PG8_BAR
#undef PG8_SCHED
}
}

struct Args {
    const float *x_prompt, *x_sample, *state_pool, *state_conv, *c_prompt, *c_sample, *w_ada, *b_ada, *w_in, *pool_grp_w, *pool_scale, *conv_w, *w_pool_up, *w_conv_up, *w_o,
        *ln1_g, *ln1_b, *w_ff1, *b_ff1, *w_ff2, *b_ff2, *ln2_g, *ln2_b;
    float* out; unsigned char* ws;
};

__device__ __forceinline__ float wave_sum(float v) {
#pragma unroll
    for (int o = 1; o < 64; o <<= 1) v += __shfl_xor(v, o);
    return v;
}

__device__ __forceinline__ void p0_transpose_item(const float* W, int K, int N, bf16_t* WT, LAS float* scr, int item, int lane) {
    const int nblk = N / 32, kb = item / nblk, nb = item % nblk, k0 = 64 * kb, n0 = 32 * nb;
    f32x4 v[8];
#pragma unroll
    for (int i = 0; i < 8; ++i) v[i] = __builtin_nontemporal_load((const f32x4*)(W + (size_t)(k0 + 8 * i + (lane >> 3)) * N + n0 + 4 * (lane & 7)));
#pragma unroll
    for (int i = 0; i < 8; ++i) { LAS float* d = scr + (8 * i + (lane >> 3)) * 33 + 4 * (lane & 7); d[0] = v[i][0]; d[1] = v[i][1]; d[2] = v[i][2]; d[3] = v[i][3]; }
    asm volatile("s_waitcnt lgkmcnt(0)" ::: "memory");
    const int c = lane & 7;
#pragma unroll
    for (int j = 0; j < 4; ++j) { const int n = (lane >> 3) + 8 * j; const LAS float* s = scr + (8 * c) * 33 + n;
        u32x4 o; o.x = pk2(s[0 * 33], s[1 * 33]); o.y = pk2(s[2 * 33], s[3 * 33]); o.z = pk2(s[4 * 33], s[5 * 33]); o.w = pk2(s[6 * 33], s[7 * 33]);
        *(u32x4*)(WT + (size_t)(n0 + n) * K + k0 + 8 * c) = o; }
    asm volatile("s_waitcnt lgkmcnt(0)" ::: "memory");
}

__device__ __forceinline__ void p0_ada_item(const Args& a, float* ada, LAS unsigned char* lds, int item, int wave, int lane) {
    const int n0 = item * 48, fr = lane & 15, kq = lane >> 4;
    f32x4 acc[9][3];
#pragma unroll
    for (int mt = 0; mt < 9; ++mt)
#pragma unroll
        for (int q = 0; q < 3; ++q) acc[mt][q] = (f32x4){0.f, 0.f, 0.f, 0.f};
    const float* const cr0 = fr < NB ? a.c_prompt + (size_t)fr * D : a.c_sample + (size_t)(fr - NB) * D;
    const float* const crm = a.c_sample + (size_t)(fr + 12) * D;
    const float* const cr8 = a.c_sample + (size_t)(124 + fr > NS - 1 ? NS - 1 : 124 + fr) * D;
#pragma unroll 2
    for (int ks = 0; ks < 8; ++ks) {
        const int k0 = wave * 256 + ks * 32 + kq * 8;
        float b[8][3];
#pragma unroll
        for (int j = 0; j < 8; ++j) { const float* p = a.w_ada + (size_t)(k0 + j) * NADA + n0 + 3 * fr; b[j][0] = __builtin_nontemporal_load(p); b[j][1] = __builtin_nontemporal_load(p + 1); b[j][2] = __builtin_nontemporal_load(p + 2); }
        bf16x8 bfr[3];
#pragma unroll
        for (int q = 0; q < 3; ++q) { u32x4 w; w.x = pk2(b[0][q], b[1][q]); w.y = pk2(b[2][q], b[3][q]); w.z = pk2(b[4][q], b[5][q]); w.w = pk2(b[6][q], b[7][q]); bfr[q] = __builtin_bit_cast(bf16x8, w); }
#pragma unroll
        for (int mt = 0; mt < 9; ++mt) {
            const float* cp = (mt == 0) ? cr0 : (mt == 8 ? cr8 : crm + (size_t)(mt - 1) * 16 * D);
            const f32x4 a0 = *(const f32x4*)(cp + k0), a1 = *(const f32x4*)(cp + k0 + 4);
            u32x4 w; w.x = pk2(a0[0], a0[1]); w.y = pk2(a0[2], a0[3]); w.z = pk2(a1[0], a1[1]); w.w = pk2(a1[2], a1[3]);
            const bf16x8 af = __builtin_bit_cast(bf16x8, w);
#pragma unroll
            for (int q = 0; q < 3; ++q) acc[mt][q] = __builtin_amdgcn_mfma_f32_16x16x32_bf16(af, bfr[q], acc[mt][q], 0, 0, 0);
            if (mt % 3 == 2) asm volatile("" ::: "memory");
        }
    }
    LAS float* red = (LAS float*)lds;
#pragma unroll
    for (int s = 4; s >= 1; s >>= 1) {
        if (wave >= s && wave < 2 * s) { LAS float* dst = red + (wave - s) * 6912 + lane;
#pragma unroll
            for (int mt = 0; mt < 9; ++mt)
#pragma unroll
                for (int q = 0; q < 3; ++q)
#pragma unroll
                    for (int j = 0; j < 4; ++j) dst[((mt * 3 + q) * 4 + j) * 64] = acc[mt][q][j]; }
        __syncthreads();
        if (wave < s) { const LAS float* src = red + wave * 6912 + lane;
#pragma unroll
            for (int mt = 0; mt < 9; ++mt)
#pragma unroll
                for (int q = 0; q < 3; ++q)
#pragma unroll
                    for (int j = 0; j < 4; ++j) acc[mt][q][j] += src[((mt * 3 + q) * 4 + j) * 64]; }
        __syncthreads();
    }
    if (wave == 0) {
#pragma unroll
        for (int q = 0; q < 3; ++q) { const int n = n0 + 3 * fr + q; const float bb = a.b_ada[n];
#pragma unroll
            for (int mt = 0; mt < 9; ++mt)
#pragma unroll
                for (int j = 0; j < 4; ++j) { const int r = mt * 16 + kq * 4 + j; if (r < NCOND) ada[(size_t)r * NADAP + item * 64 + 3 * fr + q] = acc[mt][q][j] + bb; } }
    }
}

__device__ __forceinline__ void p0_weff_item(const Args& a, bf16_t* WT, LAS unsigned char* lds, int item, int tid) {
    constexpr int AP = 260, BP = 80;
    const int g = item >> 7, it = (item >> 5) & 3, nt = item & 31, i0 = it * 64, n0 = nt * 64;
    LAS float* As = (LAS float*)lds;
    LAS float* Bs = (LAS float*)(lds + 66560);
#pragma unroll
    for (int r = 0; r < 8; ++r) { const int idx = tid + r * 512, row = idx >> 6, c4 = idx & 63;
        *(LAS f32x4*)(As + row * AP + c4 * 4) = *(const f32x4*)(a.pool_grp_w + ((size_t)(g * 256 + i0 + row)) * 256 + c4 * 4); }
    const int lane = tid & 63, wave = tid >> 6, fr = lane & 15, kq = lane >> 4, mt = wave >> 1, np = (wave & 1) * 2;
    f32x4 acc[2] = {(f32x4){0.f, 0.f, 0.f, 0.f}, (f32x4){0.f, 0.f, 0.f, 0.f}};
#pragma unroll 1
    for (int h = 0; h < 2; ++h) {
        __syncthreads();
#pragma unroll
        for (int r = 0; r < 4; ++r) { const int idx = tid + r * 512, o = idx >> 4, c4 = idx & 15;
            const float sc = a.pool_scale[g * 256 + h * 128 + o];
            *(LAS f32x4*)(Bs + o * BP + c4 * 4) = *(const f32x4*)(a.w_pool_up + (size_t)(g * 256 + h * 128 + o) * D + n0 + c4 * 4) * sc; }
        __syncthreads();
#pragma unroll 8
        for (int o4 = 0; o4 < 32; ++o4) {
            const float av = As[(mt * 16 + fr) * AP + h * 128 + o4 * 4 + kq];
            const float b0 = Bs[(o4 * 4 + kq) * BP + np * 16 + fr], b1 = Bs[(o4 * 4 + kq) * BP + np * 16 + 16 + fr];
            acc[0] = __builtin_amdgcn_mfma_f32_16x16x4f32(av, b0, acc[0], 0, 0, 0);
            acc[1] = __builtin_amdgcn_mfma_f32_16x16x4f32(av, b1, acc[1], 0, 0, 0);
        }
    }
#pragma unroll
    for (int t = 0; t < 2; ++t)
        *(u32x2*)(WT + (size_t)(n0 + (np + t) * 16 + fr) * PW + g * 256 + i0 + mt * 16 + kq * 4) = (u32x2){pk2(acc[t][0], acc[t][1]), pk2(acc[t][2], acc[t][3])};
    __syncthreads();
}

__device__ __forceinline__ void p1_modulate(const Args& a, const float* ada, bf16_t* U, int gw, int NGW, int lane) {
    if (NGW >= 2 * 8 * NS && (gw & 1) == 0 && (gw >> 1) < 8 * NS) {
        const int r = MP + (gw >> 4), c = ((gw >> 1) & 7) * 256 + 4 * lane;
        const float* ar = ada + (size_t)cond_row(r) * NADAP;
        const f32x4 v = *(const f32x4*)(a.x_sample + (size_t)(r - MP) * D + c) * (*(const f32x4*)(ar + adac(D + c)) + 1.f) + *(const f32x4*)(ar + adac(c));
        *(u32x2*)(U + (size_t)r * D + c) = (u32x2){pk2(v[0], v[1]), pk2(v[2], v[3])};
    }
    for (int r = gw; r < (NGW >= 2 * 8 * NS ? MP : MV); r += NGW) {
        u32x2* o8 = (u32x2*)(U + (size_t)r * D) + lane;
        const f32x4* xr = (const f32x4*)x_rowp(a.x_prompt, a.x_sample, r) + lane;
        const float* ar = ada + (size_t)cond_row(r) * NADAP;
#pragma unroll
        for (int j = 0; j < 8; ++j) { const int c = 4 * (lane + 64 * j); const f32x4 v = __builtin_nontemporal_load(xr + 64 * j) * (*(const f32x4*)(ar + adac(D + c)) + 1.f) + *(const f32x4*)(ar + adac(c));
            o8[64 * j] = (u32x2){pk2(v[0], v[1]), pk2(v[2], v[3])}; }
    }
}

__device__ __forceinline__ void p3_mixer(const Args& a, const bf16_t* proj, bf16_t* PRE, bf16_t* CIN, int tid) {
    const int j0 = 2 * tid, wave = tid >> 6, W = 2 << (wave >> 1);
    const f32x2 cw0 = *(const f32x2*)(a.conv_w + j0), cw1 = *(const f32x2*)(a.conv_w + CW + j0), cw2 = *(const f32x2*)(a.conv_w + 2 * CW + j0);
    float* const npp = a.out + O_NPP; float* const ncp = a.out + O_NCP; float* const nps = a.out + O_NPS; float* const ncs = a.out + O_NCS;
    for (int it = blockIdx.x; it < 384; it += gridDim.x) {
        if (it < 256) {
            const int b = it >> 6, s0 = (it & 63) * 32;
            const bf16_t* pb = proj + (size_t)(b * SEQ) * INW + j0;
            float S0 = 0.f, S1 = 0.f;
            for (int i = 1; i < W; ++i) { const int s = s0 - i; if (s >= 0) { const unsigned w = *(const unsigned*)(pb + (size_t)s * INW); S0 += bflo(w); S1 += bfhi(w); } }
            float v1a = 0.f, v1b = 0.f, v2a = 0.f, v2b = 0.f;
            if (s0 >= 1) { const bf16_t* p = pb + (size_t)(s0 - 1) * INW; const unsigned wx = *(const unsigned*)(p + 1024), wc = *(const unsigned*)(p + 3072); v1a = bflo(wc) * bflo(wx); v1b = bfhi(wc) * bfhi(wx); }
            if (s0 >= 2) { const bf16_t* p = pb + (size_t)(s0 - 2) * INW; const unsigned wx = *(const unsigned*)(p + 1024), wc = *(const unsigned*)(p + 3072); v2a = bflo(wc) * bflo(wx); v2b = bfhi(wc) * bfhi(wx); }
#pragma unroll 4
            for (int s = s0; s < s0 + 32; ++s) {
                const bf16_t* p = pb + (size_t)s * INW;
                const unsigned wz = *(const unsigned*)p, wx = *(const unsigned*)(p + 1024), wb = *(const unsigned*)(p + 2048), wc = *(const unsigned*)(p + 3072);
                const float z0 = bflo(wz), z1 = bfhi(wz);
                S0 += z0; S1 += z1;
                const int cnt = (s + 1 < W) ? s + 1 : W; const float fc = (float)cnt;
                const float p0 = S0 / fc - z0, p1 = S1 / fc - z1;
                const int so = s - W + 1;
                if (so >= 0) { const unsigned wo = *(const unsigned*)(pb + (size_t)so * INW); S0 -= bflo(wo); S1 -= bfhi(wo); }
                const float va = bflo(wc) * bflo(wx), vb = bfhi(wc) * bfhi(wx);
                const float ya = cw0[0] * v2a + cw1[0] * v1a + cw2[0] * va, yb = cw0[1] * v2b + cw1[1] * v1b + cw2[1] * vb;
                const size_t row = (size_t)(b * SEQ + s);
                *(unsigned*)(PRE + row * PW + j0) = pk2(p0, p1);
                *(unsigned*)(CIN + row * CW + j0) = pk2(bflo(wb) * ya, bfhi(wb) * yb);
                if (s >= SEQ - 15) *(f32x2*)(npp + ((size_t)(b * 15 + s - (SEQ - 15))) * PW + j0) = (f32x2){z0, z1};
                if (s >= SEQ - 2) *(f32x2*)(ncp + ((size_t)(b * 2 + s - (SEQ - 2))) * CW + j0) = (f32x2){va, vb};
                v2a = v1a; v2b = v1b; v1a = va; v1b = vb;
            }
        } else {
            const int b = it - 256; const size_t row = (size_t)(MP + b);
            const bf16_t* p = proj + row * INW + j0;
            const unsigned wz = *(const unsigned*)p, wx = *(const unsigned*)(p + 1024), wb = *(const unsigned*)(p + 2048), wc = *(const unsigned*)(p + 3072);
            const float z0 = bflo(wz), z1 = bfhi(wz);
            const float* sp = a.state_pool + (size_t)b * 15 * PW + j0;
            float S0 = z0, S1 = z1;
            for (int i = 1; i < W; ++i) { const f32x2 h = *(const f32x2*)(sp + (size_t)(15 - i) * PW); S0 += h[0]; S1 += h[1]; }
            const float fc = (float)W;
            *(unsigned*)(PRE + row * PW + j0) = pk2(S0 / fc - z0, S1 / fc - z1);
            const f32x2 h0 = *(const f32x2*)(a.state_conv + (size_t)(b * 2) * CW + j0), h1 = *(const f32x2*)(a.state_conv + (size_t)(b * 2 + 1) * CW + j0);
            const float va = bflo(wc) * bflo(wx), vb = bfhi(wc) * bfhi(wx);
            const float ya = cw0[0] * h0[0] + cw1[0] * h1[0] + cw2[0] * va, yb = cw0[1] * h0[1] + cw1[1] * h1[1] + cw2[1] * vb;
            *(unsigned*)(CIN + row * CW + j0) = pk2(bflo(wb) * ya, bfhi(wb) * yb);
#pragma unroll
            for (int r = 0; r < 14; ++r) *(f32x2*)(nps + ((size_t)(b * 15 + r)) * PW + j0) = *(const f32x2*)(sp + (size_t)(r + 1) * PW);
            *(f32x2*)(nps + ((size_t)(b * 15 + 14)) * PW + j0) = (f32x2){z0, z1};
            *(f32x2*)(ncs + ((size_t)(b * 2)) * CW + j0) = h1;
            *(f32x2*)(ncs + ((size_t)(b * 2 + 1)) * CW + j0) = (f32x2){va, vb};
        }
    }
}

__device__ __forceinline__ void ln_row(f32x4 (&v)[8], const f32x4 (&g4)[8], const f32x4 (&b4)[8]) {
    float s = 0.f;
#pragma unroll
    for (int j = 0; j < 8; ++j) s += (v[j][0] + v[j][1]) + (v[j][2] + v[j][3]);
    const float mean = wave_sum(s) * (1.f / D); float s2 = 0.f;
#pragma unroll
    for (int j = 0; j < 8; ++j) { v[j] = v[j] - mean; s2 += (v[j][0] * v[j][0] + v[j][1] * v[j][1]) + (v[j][2] * v[j][2] + v[j][3] * v[j][3]); }
    const float rstd = 1.f / sqrtf(wave_sum(s2) * (1.f / D) + LN_EPS);
#pragma unroll
    for (int j = 0; j < 8; ++j) v[j] = v[j] * rstd * g4[j] + b4[j];
}
__device__ __forceinline__ void p6_ln1(const Args& a, const float* ada, float* res, const float* part, bf16_t* U, int gw, int NGW, int lane) {
    f32x4 lg[8], lb[8];
#pragma unroll
    for (int j = 0; j < 8; ++j) { lg[j] = ((const f32x4*)a.ln1_g + lane)[64 * j]; lb[j] = ((const f32x4*)a.ln1_b + lane)[64 * j]; }
    for (int r = gw, nr; r >= 0; r = nr) { nr = -1; if (r < MP) { nr = r + NGW; if (nr >= MP) nr = ((gw & 15) == 0 && (gw >> 4) < NS && NGW >= 16 * NS) ? MP + (gw >> 4) : ((NGW >= 16 * NS) ? -1 : (nr < MV ? nr : -1)); } else if (NGW < 16 * NS) { nr = r + NGW; if (nr >= MV) nr = -1; }
        u32x2* o8 = (u32x2*)(U + (size_t)r * D) + lane;
        f32x4* rr = (f32x4*)(res + (size_t)r * D) + lane;
        const float* ar = ada + (size_t)cond_row(r) * NADAP;
        f32x4 v[8];
        if (r < MP) {
#pragma unroll
            for (int j = 0; j < 8; ++j) v[j] = rr[64 * j];
        } else {
            const f32x4* xr = (const f32x4*)(a.x_sample + (size_t)(r - MP) * D) + lane;
#pragma unroll
            for (int j = 0; j < 8; ++j) { f32x4 sum = (f32x4){0.f, 0.f, 0.f, 0.f};
#pragma unroll
                for (int sl = 0; sl < 8; ++sl) sum += ((const f32x4*)(part + ((size_t)sl * NS + (r - MP)) * D) + lane)[64 * j];
                v[j] = xr[64 * j] * ALPHA + *(const f32x4*)(ar + adac(2 * D + 4 * (lane + 64 * j))) * sum; }
        }
        ln_row(v, lg, lb);
#pragma unroll
        for (int j = 0; j < 8; ++j) { const int c = 4 * (lane + 64 * j); rr[64 * j] = v[j]; const f32x4 t = v[j] * (*(const f32x4*)(ar + adac(4 * D + c)) + 1.f) + *(const f32x4*)(ar + adac(3 * D + c));
            o8[64 * j] = (u32x2){pk2(t[0], t[1]), pk2(t[2], t[3])}; }
    }
}
__device__ __forceinline__ void p9_ln2(const Args& a, const float* ada, const float* res, const float* part, int gw, int NGW, int lane) {
    f32x4 lg[8], lb[8];
#pragma unroll
    for (int j = 0; j < 8; ++j) { lg[j] = ((const f32x4*)a.ln2_g + lane)[64 * j]; lb[j] = ((const f32x4*)a.ln2_b + lane)[64 * j]; }
    for (int r = gw, nr; r >= 0; r = nr) { nr = -1; if (r < MP) { nr = r + NGW; if (nr >= MP) nr = ((gw & 15) == 0 && (gw >> 4) < NS && NGW >= 16 * NS) ? MP + (gw >> 4) : ((NGW >= 16 * NS) ? -1 : (nr < MV ? nr : -1)); } else if (NGW < 16 * NS) { nr = r + NGW; if (nr >= MV) nr = -1; }
        const f32x4* rr = (const f32x4*)(res + (size_t)r * D) + lane;
        f32x4 v[8];
#pragma unroll
        for (int j = 0; j < 8; ++j) v[j] = rr[64 * j];
        if (r >= MP) {
            const float* ar = ada + (size_t)cond_row(r) * NADAP;
#pragma unroll
            for (int j = 0; j < 8; ++j) { f32x4 sum = *((const f32x4*)a.b_ff2 + lane + 64 * j);
#pragma unroll
                for (int sl = 0; sl < 8; ++sl) sum += ((const f32x4*)(part + ((size_t)sl * NS + (r - MP)) * D) + lane)[64 * j];
                v[j] = v[j] * ALPHA + *(const f32x4*)(ar + adac(5 * D + 4 * (lane + 64 * j))) * sum; }
        }
        ln_row(v, lg, lb);
        f32x4* o = (f32x4*)(a.out + (r < MP ? O_YP + (size_t)r * D : O_YS + (size_t)(r - MP) * D)) + lane;
#pragma unroll
        for (int j = 0; j < 8; ++j) o[64 * j] = v[j];
    }
}

typedef f32x4 Acc128[4][2];
__device__ __forceinline__ void gemm128_core(Acc128& acc, LAS unsigned char* lds, const bf16_t* A, const bf16_t* Bt, const int K  , const int klen  ) {
    using namespace pg8;
    const int tid = threadIdx.x, wid = __builtin_amdgcn_readfirstlane(tid >> 6), lane = tid & 63, wr = wid >> 2, wc = wid & 3, fr = lane & 15, fq = lane >> 4;
    const int nt = klen / 64;
    unsigned voff[2];
#pragma unroll
    for (int i = 0; i < 2; ++i) { int R, C; stage_rc(tid * 16 + i * 8192, R, C); voff[i] = (unsigned)(R * K + C) * 2u; }
    const unsigned ldsw = (unsigned)wid * 1024u;
    const int aoff = lds_byte(wr * 64 + fr, fq * 8), boff = lds_byte(wc * 32 + fr, fq * 8);
    const char* pa = (const char*)A; const char* pb = (const char*)Bt;
#define G128_STAGE(st, kt) do { _Pragma("unroll") for (int _i = 0; _i < 2; ++_i) { \
        __builtin_amdgcn_global_load_lds((const unsigned*)(pa + (size_t)(kt) * 128 + voff[_i]), (LAS unsigned*)(lds + (st) * 32768 + ldsw + _i * 8192), 16, 0, 0); \
        __builtin_amdgcn_global_load_lds((const unsigned*)(pb + (size_t)(kt) * 128 + voff[_i]), (LAS unsigned*)(lds + (st) * 32768 + 16384 + ldsw + _i * 8192), 16, 0, 0); } } while (0)
    G128_STAGE(0, 0); G128_STAGE(1, 1 < nt ? 1 : nt - 1); G128_STAGE(2, 2 < nt ? 2 : nt - 1);
#pragma unroll 1
    for (int t = 0; t < nt; ++t) {
        asm volatile("s_waitcnt vmcnt(8)" ::: "memory");
        __builtin_amdgcn_s_barrier();
        asm volatile("" ::: "memory");
        { const int kt = t + 3 < nt ? t + 3 : nt - 1; G128_STAGE((t + 3) & 3, kt); }
        const LAS unsigned char* sa = lds + (t & 3) * 32768; const LAS unsigned char* sb = sa + 16384;
        bf16x8 af[4][2], bfr[2][2];
#pragma unroll
        for (int m = 0; m < 4; ++m)
#pragma unroll
            for (int k = 0; k < 2; ++k) af[m][k] = *(const LAS bf16x8*)(sa + aoff + m * 2048 + k * 1024);
#pragma unroll
        for (int n = 0; n < 2; ++n)
#pragma unroll
            for (int k = 0; k < 2; ++k) bfr[n][k] = *(const LAS bf16x8*)(sb + boff + n * 2048 + k * 1024);
#pragma unroll
        for (int m = 0; m < 4; ++m)
#pragma unroll
            for (int n = 0; n < 2; ++n)
#pragma unroll
                for (int k = 0; k < 2; ++k) acc[m][n] = __builtin_amdgcn_mfma_f32_16x16x32_bf16(bfr[n][k], af[m][k], acc[m][n], 0, 0, 0);
        asm volatile("s_waitcnt lgkmcnt(0)" ::: "memory");
    }
    asm volatile("s_waitcnt vmcnt(0)" ::: "memory");
    __builtin_amdgcn_s_barrier();
    asm volatile("" ::: "memory");
#undef G128_STAGE
}
__device__ __forceinline__ void zero128(Acc128& acc) {
#pragma unroll
    for (int m = 0; m < 4; ++m)
#pragma unroll
        for (int n = 0; n < 2; ++n) acc[m][n] = (f32x4){0.f, 0.f, 0.f, 0.f};
}
template <int MODE>
__device__ __forceinline__ void sample_gemm(const Args& a, LAS unsigned char* lds, const bf16_t* A0, const bf16_t* B0, const bf16_t* A1, const bf16_t* B1, const int K, const int N,
                                            const bf16_t* proj, bf16_t* Ob, float* res, const float* ada) {
    const int tid = threadIdx.x, wid = __builtin_amdgcn_readfirstlane(tid >> 6), lane = tid & 63, wr = wid >> 2, wc = wid & 3, fr = lane & 15, fq = lane >> 4;
    constexpr int NSL = (MODE >= 3) ? 8 : 1;
    for (int unit = blockIdx.x; unit < (N / 128) * NSL; unit += gridDim.x) {
        const int n0 = (unit / NSL) * 128, sl = unit % NSL, klen = K / NSL;
        Acc128 acc, acc2;
        zero128(acc);
        gemm128_core(acc, lds, A0 + (size_t)MP * K + sl * klen, B0 + (size_t)n0 * K + sl * klen, K, klen);
        if (MODE == 2) { zero128(acc2); gemm128_core(acc2, lds, A1 + (size_t)MP * K, B1 + (size_t)n0 * K, K, K); }
#pragma unroll
        for (int m = 0; m < 4; ++m) { const int ms = wr * 64 + m * 16 + fr; const size_t row = (size_t)(MP + ms);
#pragma unroll
            for (int n = 0; n < 2; ++n) { const int c = n0 + wc * 32 + n * 16 + 4 * fq; f32x4 v = acc[m][n];
                if (MODE == 0) { *(u32x2*)(Ob + row * INW + c) = (u32x2){pk2(v[0], v[1]), pk2(v[2], v[3])}; }
                else if (MODE == 1) { v = v + *(const f32x4*)(a.b_ff1 + c);
#pragma unroll
                    for (int j = 0; j < 4; ++j) { const float r = fmaxf(v[j], 0.f); v[j] = r * r; }
                    *(u32x2*)(Ob + row * DFF + c) = (u32x2){pk2(v[0], v[1]), pk2(v[2], v[3])}; }
                else if (MODE == 2) {
                    const u32x2 gpw = *(const u32x2*)(proj + row * INW + 4096 + c), gcw = *(const u32x2*)(proj + row * INW + 6144 + c);
                    const float gp[4] = {bflo(gpw.x), bfhi(gpw.x), bflo(gpw.y), bfhi(gpw.y)}, gc[4] = {bflo(gcw.x), bfhi(gcw.x), bflo(gcw.y), bfhi(gcw.y)};
                    float o[4];
#pragma unroll
                    for (int j = 0; j < 4; ++j) o[j] = v[j] / (1.f + __expf(-gp[j])) + acc2[m][n][j] / (1.f + __expf(-gc[j]));
                    *(u32x2*)(Ob + row * D + c) = (u32x2){pk2(o[0], o[1]), pk2(o[2], o[3])}; }
                else { *(f32x4*)(res + ((size_t)sl * NS + ms) * D + c) = v; }
            } }
    }
}

#define XB_TMO      128
#define XB_XCNT(j)  (256  + 64 * (j))
#define XB_XSUB(j)  (1280 + 64 * (j))
#define XB_XGEN(j)  (2304 + 64 * (j))
#define XB_TOP      3328
#define XB_TOPGEN   3392
#define XCD_BAR_WORDS 3456
#define XB_SPIN_CAP (1u << 18)
__device__ __forceinline__ unsigned xb_ld(unsigned* p)              { return __hip_atomic_load(p, __ATOMIC_RELAXED, __HIP_MEMORY_SCOPE_AGENT); }
__device__ __forceinline__ unsigned xb_add(unsigned* p, unsigned v) { return __hip_atomic_fetch_add(p, v, __ATOMIC_RELAXED, __HIP_MEMORY_SCOPE_AGENT); }
__device__ __forceinline__ unsigned xb_xcc_id() { return (unsigned)__builtin_amdgcn_s_getreg((3 << 11) | 20) & 0xFu; }
#define XB_SPIN(cond, bar) do { unsigned _sp = 0; while (cond) { __builtin_amdgcn_s_sleep(1); \
    if ((++_sp & 255u) == 0u) { if (xb_ld(&(bar)[XB_TMO])) break; if (_sp > XB_SPIN_CAP) { atomicAdd(&(bar)[XB_TMO], 1u); break; } } } } while (0)
struct XcdBarrier { unsigned* bar; unsigned x; volatile LAS unsigned* st; };
__device__ __forceinline__ XcdBarrier xcd_barrier_post(unsigned* bar, volatile LAS unsigned* st) {
    XcdBarrier b; b.bar = bar; b.x = xb_xcc_id(); b.st = st;
    if (threadIdx.x == 0) (void)xb_add(&bar[XB_XCNT(b.x)], 1u);
    return b;
}
__device__ __forceinline__ void xcd_barrier_complete(unsigned* bar, unsigned x, unsigned& nloc, unsigned& nx) {
    const unsigned G = gridDim.x * gridDim.y * gridDim.z;
    unsigned sum, cnt, mine, sp = 0u;
    for (;;) {
        sum = 0u; cnt = 0u; mine = 0u;
#pragma unroll
        for (unsigned j = 0; j < 16; ++j) { const unsigned c = xb_ld(&bar[XB_XCNT(j)]); sum += c; cnt += (c > 0u) ? 1u : 0u; mine = (j == x) ? c : mine; }
        if (sum == G) break;
        __builtin_amdgcn_s_sleep(1);
        if ((++sp & 255u) == 0u) { if (xb_ld(&bar[XB_TMO])) break; if (sp > XB_SPIN_CAP) { atomicAdd(&bar[XB_TMO], 1u); break; } }
    }
    nloc = mine > 0u ? mine : 1u; nx = cnt > 0u ? cnt : 1u;
}
__device__ __forceinline__ void xcd_barrier(const XcdBarrier& b) {
    asm volatile("s_waitcnt vmcnt(0)" ::: "memory");
    __syncthreads();
    if (threadIdx.x == 0) {
        unsigned* bar = b.bar;
        __builtin_amdgcn_s_waitcnt(0);
        unsigned nloc = b.st[0], nx = b.st[1];
        if (nloc == 0u) { xcd_barrier_complete(bar, b.x, nloc, nx); b.st[0] = nloc; b.st[1] = nx; }
        const unsigned old = xb_add(&bar[XB_XSUB(b.x)], 1u);
        const unsigned gen = old / nloc;
        if (old + 1u == (gen + 1u) * nloc) {
            __builtin_amdgcn_fence(__ATOMIC_RELEASE, "agent");
            asm volatile("s_waitcnt vmcnt(0)" ::: "memory");
            const unsigned og = xb_add(&bar[XB_TOP], 1u);
            const unsigned tg = og / nx;
            if (og + 1u == (tg + 1u) * nx) xb_add(&bar[XB_TOPGEN], 1u);
            else XB_SPIN(xb_ld(&bar[XB_TOPGEN]) == tg, bar);
            __builtin_amdgcn_fence(__ATOMIC_ACQUIRE, "agent");
            xb_add(&bar[XB_XGEN(b.x)], 1u);
            asm volatile("s_waitcnt vmcnt(0)" ::: "memory");
        } else {
            XB_SPIN(xb_ld(&bar[XB_XGEN(b.x)]) == gen, bar);
            __builtin_amdgcn_fence(__ATOMIC_ACQUIRE, "agent");
            asm volatile("s_waitcnt vmcnt(0)" ::: "memory");
        }
    }
    __syncthreads();
}

__device__ __forceinline__ void p0_all(const Args& a, LAS unsigned char* lds, int tid, int lane, int wave, int bx, int G) {
    unsigned char* ws = a.ws;
    float* ada = (float*)(ws + WS_ADA);
    bf16_t* WinT = (bf16_t*)(ws + WS_WIN); bf16_t* Wff1T = (bf16_t*)(ws + WS_WFF1); bf16_t* Wff2T = (bf16_t*)(ws + WS_WFF2); bf16_t* WoT = (bf16_t*)(ws + WS_WO);
    bf16_t* WupP = (bf16_t*)(ws + WS_WUPP); bf16_t* WupC = (bf16_t*)(ws + WS_WUPC);
    const int gw = bx * 8 + wave, NGW = G * 8;
    if (bx & 1) {
    {
        LAS float* scr = (LAS float*)(lds + wave * 16384);
        constexpr int I_IN = (D / 64) * (INW / 32), I_F1 = (D / 64) * (DFF / 32), I_F2 = (DFF / 64) * (D / 32), I_O = (D / 64) * (D / 32), I_C = (CW / 64) * (D / 32);
        constexpr int NIT = I_IN + I_F1 + I_F2 + I_O + I_C;
        for (int it = gw; it < NIT; it += NGW) {
            int r = it;
            if (r < I_IN) { p0_transpose_item(a.w_in, D, INW, WinT, scr, r, lane); continue; } r -= I_IN;
            if (r < I_F1) { p0_transpose_item(a.w_ff1, D, DFF, Wff1T, scr, r, lane); continue; } r -= I_F1;
            if (r < I_F2) { p0_transpose_item(a.w_ff2, DFF, D, Wff2T, scr, r, lane); continue; } r -= I_F2;
            if (r < I_O) { p0_transpose_item(a.w_o, D, D, WoT, scr, r, lane); continue; } r -= I_O;
            p0_transpose_item(a.w_conv_up, CW, D, WupC, scr, r, lane);
        }
    }
    __syncthreads();
    for (int it = bx; it < NADA / 48; it += G) p0_ada_item(a, ada, lds, it, wave, lane);
    for (int it = bx; it < 512; it += G) p0_weff_item(a, WupP, lds, it, tid);
    } else {
    for (int it = bx; it < NADA / 48; it += G) p0_ada_item(a, ada, lds, it, wave, lane);
    for (int it = bx; it < 512; it += G) p0_weff_item(a, WupP, lds, it, tid);
    {
        LAS float* scr = (LAS float*)(lds + wave * 16384);
        constexpr int I_IN = (D / 64) * (INW / 32), I_F1 = (D / 64) * (DFF / 32), I_F2 = (DFF / 64) * (D / 32), I_O = (D / 64) * (D / 32), I_C = (CW / 64) * (D / 32);
        constexpr int NIT = I_IN + I_F1 + I_F2 + I_O + I_C;
        for (int it = gw; it < NIT; it += NGW) {
            int r = it;
            if (r < I_IN) { p0_transpose_item(a.w_in, D, INW, WinT, scr, r, lane); continue; } r -= I_IN;
            if (r < I_F1) { p0_transpose_item(a.w_ff1, D, DFF, Wff1T, scr, r, lane); continue; } r -= I_F1;
            if (r < I_F2) { p0_transpose_item(a.w_ff2, DFF, D, Wff2T, scr, r, lane); continue; } r -= I_F2;
            if (r < I_O) { p0_transpose_item(a.w_o, D, D, WoT, scr, r, lane); continue; } r -= I_O;
            p0_transpose_item(a.w_conv_up, CW, D, WupC, scr, r, lane);
        }
    }
    }
}

__global__ void __launch_bounds__(512, 2) fwd_megakernel(Args a) {
    extern __shared__ __attribute__((aligned(16))) unsigned char lds_raw[];
    LAS unsigned char* lds = (LAS unsigned char*)lds_raw;
    const int tid = threadIdx.x, lane = tid & 63, wave = __builtin_amdgcn_readfirstlane(tid >> 6);
    const int G = gridDim.x, bx = blockIdx.x;
    const int gw = bx * 8 + wave, NGW = G * 8;
    unsigned char* ws = a.ws;
    float* ada = (float*)(ws + WS_ADA);
    unsigned* ctr = (unsigned*)(ws + WS_CTL);
    if (tid < 64) ((LAS unsigned*)(lds + MISC_OFF))[tid] = 0u;
    __syncthreads();
    const XcdBarrier xbar = xcd_barrier_post(ctr, (volatile LAS unsigned*)(lds + MISC_OFF));
#define GB() xcd_barrier(xbar)
    bf16_t* WinT = (bf16_t*)(ws + WS_WIN); bf16_t* Wff1T = (bf16_t*)(ws + WS_WFF1); bf16_t* Wff2T = (bf16_t*)(ws + WS_WFF2); bf16_t* WoT = (bf16_t*)(ws + WS_WO);
    bf16_t* WupP = (bf16_t*)(ws + WS_WUPP); bf16_t* WupC = (bf16_t*)(ws + WS_WUPC);
    bf16_t* U = (bf16_t*)(ws + WS_U); bf16_t* PROJ = (bf16_t*)(ws + WS_PROJ); float* RES = (float*)(ws + WS_RES);
    float* PART = (float*)(ws + WS_PART);
    bf16_t* PRE = (bf16_t*)(ws + WS_RES); bf16_t* CIN = (bf16_t*)(ws + WS_RES + WS_CIN_OFF);

    p0_all(a, lds, tid, lane, wave, bx, G);
    GB();
    p1_modulate(a, ada, U, gw, NGW, lane);
    GB();
    { pg8::Order S; S.init(MP, INW, G, bx, 1, U, WinT, U, WinT);
      pg8::EpiBf16<0> E{PROJ, INW, nullptr};
      pg8::gemm_phase(lds, D, S, E); }
    sample_gemm<0>(a, lds, U, WinT, U, WinT, D, INW, PROJ, PROJ, RES, ada);
    GB();
    p3_mixer(a, PROJ, PRE, CIN, tid);
    GB();
    { pg8::Order S; S.init(MP, D, G, bx, 2, PRE, WupP, CIN, WupC);
      pg8::EpiGate E{PROJ, U};
      pg8::gemm_phase(lds, PW, S, E); }
    sample_gemm<2>(a, lds, PRE, WupP, CIN, WupC, PW, D, PROJ, U, RES, ada);
    GB();
    { pg8::Order S; S.init(MP, D, G, bx, 1, U, WoT, U, WoT);
      pg8::EpiRes E{RES, a.x_prompt, ada, 2 * D, nullptr};
      pg8::gemm_phase(lds, D, S, E); }
    sample_gemm<3>(a, lds, U, WoT, U, WoT, D, D, PROJ, U, PART, ada);
    GB();
    p6_ln1(a, ada, RES, PART, U, gw, NGW, lane);
    GB();
    { pg8::Order S; S.init(MP, DFF, G, bx, 1, U, Wff1T, U, Wff1T);
      pg8::EpiBf16<1> E{PROJ, DFF, a.b_ff1};
      pg8::gemm_phase(lds, D, S, E); }
    sample_gemm<1>(a, lds, U, Wff1T, U, Wff1T, D, DFF, PROJ, PROJ, RES, ada);
    GB();
    { pg8::Order S; S.init(MP, D, G, bx, 1, PROJ, Wff2T, PROJ, Wff2T);
      pg8::EpiRes E{RES, RES, ada, 5 * D, a.b_ff2};
      pg8::gemm_phase(lds, DFF, S, E); }
    sample_gemm<4>(a, lds, PROJ, Wff2T, PROJ, Wff2T, DFF, D, PROJ, U, PART, ada);
    GB();
    p9_ln2(a, ada, RES, PART, gw, NGW, lane);
}

extern "C" void kernel_launch(void* const* d_in, const int* in_sizes, int n_in, void* d_out, int out_size, void* d_ws, size_t ws_size, hipStream_t stream) {
    static int grid = 0;
    if (grid == 0) {
        if (n_in != 23 || ws_size < WS_END) { fprintf(stderr, "kernel_launch: expected 23 inputs and >= %zu bytes of workspace; got %d, %zu\n", (size_t)WS_END, n_in, ws_size); grid = -1; return; }
        int dev = 0, cus = 0, per_cu = 0;
        hipGetDevice(&dev);
        hipDeviceGetAttribute(&cus, hipDeviceAttributeMultiprocessorCount, dev);
        if (hipFuncSetAttribute((const void*)fwd_megakernel, hipFuncAttributeMaxDynamicSharedMemorySize, LDS_BYTES) != hipSuccess) { fprintf(stderr, "kernel_launch: hipFuncSetAttribute failed\n"); grid = -1; return; }
        if (hipOccupancyMaxActiveBlocksPerMultiprocessor(&per_cu, (const void*)fwd_megakernel, 512, LDS_BYTES) != hipSuccess || per_cu < 1) { fprintf(stderr, "kernel_launch: occupancy query says %d blocks per CU\n", per_cu); (void)hipGetLastError(); per_cu = 1; }
        grid = cus;
        fprintf(stderr, "kernel_launch: cus %d per_cu %d grid %d\n", cus, per_cu, grid);
    }
    if (grid < 0) return;
    if (hipMemsetAsync((char*)d_ws + WS_CTL, 0, 16384, stream) != hipSuccess) { fprintf(stderr, "kernel_launch: memset failed\n"); return; }
    Args a{};
    const float** ap = (const float**)&a;
    for (int i = 0; i < 23; ++i) ap[i] = (const float*)d_in[i];
    a.out = (float*)d_out; a.ws = (unsigned char*)d_ws;
    void* args[] = {&a};
    hipError_t e = hipLaunchCooperativeKernel((const void*)fwd_megakernel, dim3(grid), dim3(512), args, LDS_BYTES, stream);
    if (e != hipSuccess) fprintf(stderr, "kernel_launch: cooperative launch failed: %s (grid %d)\n", hipGetErrorString(e), grid);
}
```

```cpp
#include <hip/hip_runtime.h>
#include <cstdio>
#include <cstdint>

#define LAS __attribute__((address_space(3)))
typedef unsigned short bf16_t;
typedef short bf16x8 __attribute__((ext_vector_type(8)));
typedef float f32x4 __attribute__((ext_vector_type(4)));
typedef float f32x2 __attribute__((ext_vector_type(2)));
typedef unsigned u32x4 __attribute__((ext_vector_type(4)));
typedef unsigned u32x2 __attribute__((ext_vector_type(2)));

constexpr int D = 2048, NB = 4, SEQ = 2048, NS = 128;
constexpr int MP = NB * SEQ;
constexpr int MV = MP + NS;
constexpr int MPAD = 8448;
constexpr int PW = 1024, CW = 1024, DFF = 8192, INW = 8192, NADA = 6 * D, NCOND = NB + NS;
constexpr float ALPHA = 1.18920711500272f;
constexpr float LN_EPS = 1e-5f;
constexpr int NADAP = 256 * 64;
__device__ __forceinline__ int adac(int n) { return n + 16 * (n / 48); }

constexpr size_t MiB = 1u << 20;
constexpr size_t WS_CTL = 0;
constexpr size_t WS_ADA = 352 * MiB;
constexpr size_t WS_WIN = 8 * MiB, WS_WFF1 = 40 * MiB, WS_WFF2 = 72 * MiB, WS_WO = 104 * MiB, WS_WUPP = 112 * MiB, WS_WUPC = 116 * MiB;
constexpr size_t WS_U = 120 * MiB;
constexpr size_t WS_PROJ = 153 * MiB;
constexpr size_t WS_RES = 285 * MiB;
constexpr size_t WS_PART = 362 * MiB;
constexpr size_t WS_END = 378 * MiB;
constexpr size_t WS_CIN_OFF = (size_t)MPAD * 1024 * 2;

constexpr size_t O_YP = 0, O_YS = (size_t)MP * D, O_NPP = O_YS + (size_t)NS * D, O_NCP = O_NPP + (size_t)NB * 15 * PW, O_NPS = O_NCP + (size_t)NB * 2 * CW, O_NCS = O_NPS + (size_t)NS * 15 * PW;

constexpr int LDS_BYTES = 131072 + 256, MISC_OFF = 131072;

__device__ __forceinline__ unsigned f2bf(float f) { unsigned u = __builtin_bit_cast(unsigned, f); return (u + 0x7fffu + ((u >> 16) & 1u)) >> 16; }
__device__ __forceinline__ unsigned pk2(float lo, float hi) { return f2bf(lo) | (f2bf(hi) << 16); }
__device__ __forceinline__ unsigned cvt_pk_bf16(float lo, float hi) { unsigned r; asm volatile("v_cvt_pk_bf16_f32 %0, %1, %2" : "=v"(r) : "v"(lo), "v"(hi)); return r; }
__device__ __forceinline__ float bflo(unsigned w) { return __builtin_bit_cast(float, w << 16); }
__device__ __forceinline__ float bfhi(unsigned w) { return __builtin_bit_cast(float, w & 0xffff0000u); }
__device__ __forceinline__ int cond_row(int r) { int s = r - MP; s = s < 0 ? 0 : (s > NS - 1 ? NS - 1 : s); return r < MP ? (r >> 11) : NB + s; }
__device__ __forceinline__ const float* x_rowp(const float* xp, const float* xs, int r) { int s = r - MP; s = s < 0 ? 0 : (s > NS - 1 ? NS - 1 : s); return r < MP ? xp + (size_t)r * D : xs + (size_t)s * D; }

namespace pg8 {
constexpr int BM = 256, BK = 64, HALF = 128, HTB = HALF * BK * 2, NXCD = 8, WGM = 4;
__device__ __forceinline__ int lds_byte(int r, int c) { const int st = (r >> 4) * 2 + (c >> 5), rr = r & 15, cc = c & 31, ob = rr * 64 + cc * 2; return st * 1024 + (ob ^ (((ob >> 9) & 1) << 5)); }
__device__ __forceinline__ void stage_rc(int b, int& R, int& C) { const int st = b / 1024, sb = b % 1024, swz = sb ^ (((sb >> 9) & 1) << 5); R = (st >> 1) * 16 + swz / 64; C = (st & 1) * 32 + (swz % 64) / 2; }
__device__ __forceinline__ int perm32(int rho) { const int n = rho >> 4, i = rho & 15; return 8 * (i >> 2) + 4 * n + (i & 3); }

struct Unit { int pm, pn, grp; };
struct Order {
    int nM, nN, nwg, G, c, rep;
    const char* A0; const char* B0; const char* A1; const char* B1;
    __device__ __forceinline__ void init(int M, int N, int G_, int c_, int rep_, const void* a0, const void* b0, const void* a1, const void* b1) {
        nM = M / BM; nN = N / BM; nwg = nM * nN; G = G_; c = c_; rep = rep_; A0 = (const char*)a0; B0 = (const char*)b0; A1 = (const char*)a1; B1 = (const char*)b1; }
    __device__ __forceinline__ bool next(int i, Unit& u) const {
        const int ti = (rep == 2) ? (i >> 1) : i; u.grp = (rep == 2) ? (i & 1) : 0;
        const long L = (long)ti * G + c; if (L >= nwg) return false;
        int wgid = (int)L; { const int q = nwg / NXCD, r = nwg % NXCD, xcd = wgid % NXCD, off = wgid / NXCD; wgid = (xcd < r ? xcd * (q + 1) : r * (q + 1) + (xcd - r) * q) + off; }
        const int nig = WGM * nN, gid = wgid / nig, fm = gid * WGM, gsz = (nM - fm) < WGM ? (nM - fm) : WGM;
        u.pm = fm + ((wgid % nig) % gsz); u.pn = (wgid % nig) / gsz; return true;
    }
    __device__ __forceinline__ const char* baseA(const Unit& u, size_t tstep) const { return (u.grp ? A1 : A0) + (size_t)u.pm * tstep; }
    __device__ __forceinline__ const char* baseB(const Unit& u, size_t tstep) const { return (u.grp ? B1 : B0) + (size_t)u.pn * tstep; }
};

typedef f32x4 Acc[2][2][4][2];

template <int ACT> struct EpiBf16 {
    static constexpr bool PERM = true;
    bf16_t* O; int ldc; const float* bias;
    __device__ __forceinline__ bool keep(const Unit&) const { return false; }
    __device__ __forceinline__ void operator()(Acc& acc, const Unit& u, int wr, int wc, int fr, int fq) const {
        const int row0 = u.pm * BM + wr * 64 + fr, col0 = u.pn * BM + wc * 32 + 8 * fq;
        f32x4 bv[2][2];
#pragma unroll
        for (int bj = 0; bj < 2; ++bj)
#pragma unroll
            for (int n = 0; n < 2; ++n) bv[bj][n] = bias ? *(const f32x4*)(bias + col0 + bj * HALF + 4 * n) : (f32x4){0.f, 0.f, 0.f, 0.f};
#pragma unroll
        for (int ai = 0; ai < 2; ++ai)
#pragma unroll
            for (int m = 0; m < 4; ++m) { bf16_t* rowp = O + (size_t)(row0 + ai * HALF + m * 16) * ldc + col0;
#pragma unroll
                for (int bj = 0; bj < 2; ++bj) { f32x4 v0 = acc[ai][bj][m][0] + bv[bj][0], v1 = acc[ai][bj][m][1] + bv[bj][1];
                    if (ACT == 1) {
#pragma unroll
                        for (int j = 0; j < 4; ++j) { const float a = fmaxf(v0[j], 0.f), b = fmaxf(v1[j], 0.f); v0[j] = a * a; v1[j] = b * b; } }
                    u32x4 w; w.x = cvt_pk_bf16(v0[0], v0[1]); w.y = cvt_pk_bf16(v0[2], v0[3]); w.z = cvt_pk_bf16(v1[0], v1[1]); w.w = cvt_pk_bf16(v1[2], v1[3]);
                    *(u32x4*)(rowp + bj * HALF) = w; } }
    }
};
__device__ __forceinline__ void unpack8(const u32x4 w, float (&e)[8]) { e[0] = bflo(w.x); e[1] = bfhi(w.x); e[2] = bflo(w.y); e[3] = bfhi(w.y); e[4] = bflo(w.z); e[5] = bfhi(w.z); e[6] = bflo(w.w); e[7] = bfhi(w.w); }
struct EpiGate {
    static constexpr bool PERM = true;
    const bf16_t* proj; bf16_t* O;
    __device__ __forceinline__ bool keep(const Unit& u) const { return u.grp == 0; }
    __device__ __forceinline__ void operator()(Acc& acc, const Unit& u, int wr, int wc, int fr, int fq) const {
        const int row0 = u.pm * BM + wr * 64 + fr, col0 = u.pn * BM + wc * 32 + 8 * fq;
        const bool g0 = (u.grp == 0);
        u32x4 gcw[2], gpw[2];
        { const bf16_t* p = proj + (size_t)row0 * INW + col0; gcw[0] = *(const u32x4*)(p + 6144); gpw[0] = g0 ? *(const u32x4*)(p + 4096) : gcw[0]; }
#pragma unroll
        for (int it = 0; it < 16; ++it) { const int ai = it >> 3, m = (it >> 1) & 3, bj = it & 1;
            const size_t row = (size_t)(row0 + ai * HALF + m * 16); const int col = col0 + bj * HALF;
            if (it < 15) { const int ai2 = (it + 1) >> 3, m2 = ((it + 1) >> 1) & 3, bj2 = (it + 1) & 1;
                const bf16_t* p = proj + (size_t)(row0 + ai2 * HALF + m2 * 16) * INW + col0 + bj2 * HALF;
                gcw[(it + 1) & 1] = *(const u32x4*)(p + 6144); gpw[(it + 1) & 1] = g0 ? *(const u32x4*)(p + 4096) : gcw[(it + 1) & 1]; }
            float ec[8]; unpack8(gcw[it & 1], ec);
#pragma unroll
            for (int j = 0; j < 8; ++j) ec[j] = 1.f + __expf(-fmaxf(ec[j], -30.f));
            if (g0) {
                float ep[8]; unpack8(gpw[it & 1], ep);
#pragma unroll
                for (int j = 0; j < 8; ++j) ep[j] = ec[j] * __builtin_amdgcn_rcpf(1.f + __expf(-ep[j]));
#pragma unroll
                for (int j = 0; j < 4; ++j) { acc[ai][bj][m][0][j] *= ep[j]; acc[ai][bj][m][1][j] *= ep[4 + j]; }
            } else {
                f32x4 v0, v1;
#pragma unroll
                for (int j = 0; j < 4; ++j) { v0[j] = acc[ai][bj][m][0][j] * __builtin_amdgcn_rcpf(ec[j]); v1[j] = acc[ai][bj][m][1][j] * __builtin_amdgcn_rcpf(ec[4 + j]); }
                u32x4 w; w.x = cvt_pk_bf16(v0[0], v0[1]); w.y = cvt_pk_bf16(v0[2], v0[3]); w.z = cvt_pk_bf16(v1[0], v1[1]); w.w = cvt_pk_bf16(v1[2], v1[3]);
                *(u32x4*)(O + row * D + col) = w;
            } }
    }
};
struct EpiRes {
    static constexpr bool PERM = false;
    float* res; const float* base; const float* ada; int gate_off; const float* bias;
    __device__ __forceinline__ bool keep(const Unit&) const { return false; }
    __device__ __forceinline__ void operator()(Acc& acc, const Unit& u, int wr, int wc, int fr, int fq) const {
        const int row0 = u.pm * BM + wr * 64 + fr, col0 = u.pn * BM + wc * 32 + 4 * fq;
        const float* gp = ada + (size_t)(u.pm >> 3) * NADAP;
        f32x4 bv[2][2], gv[2][2], xb[2][2][2];
#pragma unroll
        for (int bj = 0; bj < 2; ++bj)
#pragma unroll
            for (int n = 0; n < 2; ++n) { bv[bj][n] = bias ? *(const f32x4*)(bias + col0 + bj * HALF + n * 16) : (f32x4){0.f, 0.f, 0.f, 0.f}; gv[bj][n] = *(const f32x4*)(gp + adac(gate_off + col0 + bj * HALF + n * 16)); }
#pragma unroll
        for (int bj = 0; bj < 2; ++bj)
#pragma unroll
            for (int n = 0; n < 2; ++n) xb[0][bj][n] = *(const f32x4*)(base + (size_t)row0 * D + col0 + bj * HALF + n * 16);
#pragma unroll
        for (int it = 0; it < 8; ++it) { const int ai = it >> 2, m = it & 3;
            if (it < 7) { const float* bp = base + (size_t)(row0 + ((it + 1) >> 2) * HALF + ((it + 1) & 3) * 16) * D + col0;
#pragma unroll
                for (int bj = 0; bj < 2; ++bj)
#pragma unroll
                    for (int n = 0; n < 2; ++n) xb[(it + 1) & 1][bj][n] = *(const f32x4*)(bp + bj * HALF + n * 16); }
            float* rp = res + (size_t)(row0 + ai * HALF + m * 16) * D + col0;
#pragma unroll
            for (int bj = 0; bj < 2; ++bj)
#pragma unroll
                for (int n = 0; n < 2; ++n) *(f32x4*)(rp + bj * HALF + n * 16) = xb[it & 1][bj][n] * ALPHA + gv[bj][n] * (acc[ai][bj][m][n] + bv[bj][n]); }
    }
};

template <class Epi>
__device__ __forceinline__ void gemm_phase(LAS unsigned char* lds, const int K, const Order& S, const Epi& E) {
    const int tid = threadIdx.x, wid = __builtin_amdgcn_readfirstlane(tid >> 6), lane = tid & 63, wr = wid >> 2, wc = wid & 3, fr = lane & 15, fq = lane >> 4;
    const int nt = K / BK;
    unsigned voffA[2], voffB[2];
#pragma unroll
    for (int i = 0; i < 2; ++i) { int R, C; stage_rc(tid * 16 + i * 8192, R, C); const int Rb = Epi::PERM ? ((R & ~31) + perm32(R & 31)) : R;
        voffA[i] = (unsigned)(R * K + C) * 2u; voffB[i] = (unsigned)(Rb * K + C) * 2u; }
    const size_t kstep = (size_t)(BK * 2);
    const size_t hstep = (size_t)HALF * K * 2;
    const size_t tstep = 2 * hstep;
    const unsigned ldsw = (unsigned)wid * 1024u;
    const int aoff = lds_byte(wr * 64 + fr, fq * 8), boff = lds_byte(wc * 32 + fr, fq * 8);
#define PG8_SA(b, h) (((b) * 2 + (h)) * HTB)
#define PG8_SB(b, h) ((4 + (b) * 2 + (h)) * HTB)
#define PG8_STAGE(bufoff, gbase, voff) do { _Pragma("unroll") for (int _i = 0; _i < 2; ++_i) \
        __builtin_amdgcn_global_load_lds((const unsigned*)((const char*)(gbase) + (voff)[_i]), (LAS unsigned*)(lds + (bufoff) + ldsw + _i * 8192), 16, 0, 0); } while (0)
#define PG8_LDA(dst, b, h) do { _Pragma("unroll") for (int m = 0; m < 4; ++m) _Pragma("unroll") for (int k = 0; k < 2; ++k) dst[m][k] = *(const LAS bf16x8*)(lds + PG8_SA(b, h) + aoff + m * 2048 + k * 1024); } while (0)
#define PG8_LDB(dst, b, h) do { _Pragma("unroll") for (int n = 0; n < 2; ++n) _Pragma("unroll") for (int k = 0; k < 2; ++k) dst[n][k] = *(const LAS bf16x8*)(lds + PG8_SB(b, h) + boff + n * 2048 + k * 1024); } while (0)
#define PG8_MMA(ai, bj, At, Bt) do { __builtin_amdgcn_s_setprio(1); _Pragma("unroll") for (int m = 0; m < 4; ++m) _Pragma("unroll") for (int n = 0; n < 2; ++n) _Pragma("unroll") for (int k = 0; k < 2; ++k) \
        acc[ai][bj][m][n] = __builtin_amdgcn_mfma_f32_16x16x32_bf16(Bt[n][k], At[m][k], acc[ai][bj][m][n], 0, 0, 0); __builtin_amdgcn_s_setprio(0); } while (0)
#define PG8_WAIT_V(n) asm volatile("s_waitcnt vmcnt(" #n ")" ::: "memory")
#define PG8_WAIT_L(n) asm volatile("s_waitcnt lgkmcnt(" #n ")" ::: "memory")
#define PG8_BAR __builtin_amdgcn_s_barrier()
#define PG8_SCHED __builtin_amdgcn_sched_barrier(0)
    Unit cur, nxt; int ui = 0;
    if (!S.next(0, cur)) return;
    Acc acc;
#pragma unroll
    for (int a = 0; a < 2; ++a)
#pragma unroll
        for (int b = 0; b < 2; ++b)
#pragma unroll
            for (int m = 0; m < 4; ++m)
#pragma unroll
                for (int n = 0; n < 2; ++n) acc[a][b][m][n] = (f32x4){0.f, 0.f, 0.f, 0.f};
    bf16x8 At[4][2], B0[2][2], B1[2][2];
    const char* cA = S.baseA(cur, tstep); const char* cB = S.baseB(cur, tstep);
    PG8_STAGE(PG8_SB(0, 0), cB, voffB); PG8_STAGE(PG8_SB(0, 1), cB + hstep, voffB); PG8_STAGE(PG8_SA(0, 0), cA, voffA); PG8_STAGE(PG8_SA(0, 1), cA + hstep, voffA);
    if (wr == 1) PG8_BAR;
    PG8_WAIT_V(2); PG8_BAR;
    PG8_STAGE(PG8_SB(1, 0), cB + kstep, voffB); PG8_STAGE(PG8_SA(1, 0), cA + kstep, voffA); PG8_STAGE(PG8_SB(1, 1), cB + hstep + kstep, voffB);
    PG8_WAIT_V(6); PG8_BAR;
    for (;;) {
        const bool has_next = S.next(ui + 1, nxt);
        const char* nA = has_next ? S.baseA(nxt, tstep) : cA; const char* nB = has_next ? S.baseB(nxt, tstep) : cB;
        for (int t = 0; t < nt; t += 2) {
            const bool last = (t == nt - 2);
            const char* a1 = cA + (size_t)(t + 1) * kstep;
            const char* a2 = last ? nA : cA + (size_t)(t + 2) * kstep; const char* b2 = last ? nB : cB + (size_t)(t + 2) * kstep;
            const char* a3 = a2 + kstep; const char* b3 = b2 + kstep;
            PG8_LDB(B0, 0, 0); PG8_LDB(B1, 0, 1); PG8_SCHED; PG8_LDA(At, 0, 0); PG8_STAGE(PG8_SA(1, 1), a1 + hstep, voffA);
            PG8_WAIT_V(8); PG8_WAIT_L(0); PG8_BAR; PG8_MMA(0, 0, At, B0); PG8_MMA(0, 1, At, B1); PG8_BAR; PG8_SCHED;
            PG8_LDA(At, 0, 1); PG8_STAGE(PG8_SB(0, 0), b2, voffB); PG8_STAGE(PG8_SB(0, 1), b2 + hstep, voffB); PG8_STAGE(PG8_SA(0, 0), a2, voffA);
            PG8_WAIT_V(8); PG8_WAIT_L(0); PG8_BAR; PG8_MMA(1, 0, At, B0); PG8_MMA(1, 1, At, B1); PG8_BAR; PG8_SCHED;
            PG8_LDB(B0, 1, 0); PG8_LDB(B1, 1, 1); PG8_SCHED; PG8_LDA(At, 1, 0); PG8_STAGE(PG8_SA(0, 1), a2 + hstep, voffA);
            PG8_WAIT_V(8); PG8_WAIT_L(0); PG8_BAR; PG8_MMA(0, 0, At, B0); PG8_MMA(0, 1, At, B1); PG8_BAR; PG8_SCHED;
            PG8_LDA(At, 1, 1); PG8_STAGE(PG8_SB(1, 0), b3, voffB); PG8_STAGE(PG8_SB(1, 1), b3 + hstep, voffB); PG8_STAGE(PG8_SA(1, 0), a3, voffA);
            PG8_WAIT_V(8); PG8_WAIT_L(0); PG8_BAR; PG8_MMA(1, 0, At, B0); PG8_MMA(1, 1, At, B1); PG8_BAR; PG8_SCHED;
        }
        if (wr == 0) PG8_BAR;
        E(acc, cur, wr, wc, fr, fq);
        if (!has_next) break;
        if (!E.keep(cur)) {
#pragma unroll
            for (int a = 0; a < 2; ++a)
#pragma unroll
                for (int b = 0; b < 2; ++b)
#pragma unroll
                    for (int m = 0; m < 4; ++m)
#pragma unroll
                        for (int n = 0; n < 2; ++n) acc[a][b][m][n] = (f32x4){0.f, 0.f, 0.f, 0.f};
        }
        cur = nxt; cA = nA; cB = nB; ++ui;
        if (wr == 1) PG8_BAR;
    }
    PG8_WAIT_V(0);
    PG8_BAR;
#undef PG8_SA
#undef PG8_SB
#undef PG8_STAGE
#undef PG8_LDA
#undef PG8_LDB
#undef PG8_MMA
#undef PG8_WAIT_V
#undef PG8_WAIT_L
#undef PG8_BAR
#undef PG8_SCHED
}
}

struct Args {
    const float *x_prompt, *x_sample, *state_pool, *state_conv, *c_prompt, *c_sample, *w_ada, *b_ada, *w_in, *pool_grp_w, *pool_scale, *conv_w, *w_pool_up, *w_conv_up, *w_o,
        *ln1_g, *ln1_b, *w_ff1, *b_ff1, *w_ff2, *b_ff2, *ln2_g, *ln2_b;
    float* out; unsigned char* ws;
};

__device__ __forceinline__ float wave_sum(float v) {
#pragma unroll
    for (int o = 1; o < 64; o <<= 1) v += __shfl_xor(v, o);
    return v;
}

__device__ __forceinline__ void p0_transpose_item(const float* W, int K, int N, bf16_t* WT, LAS float* scr, int item, int lane) {
    const int nblk = N / 32, kb = item / nblk, nb = item % nblk, k0 = 64 * kb, n0 = 32 * nb;
    f32x4 v[8];
#pragma unroll
    for (int i = 0; i < 8; ++i) v[i] = __builtin_nontemporal_load((const f32x4*)(W + (size_t)(k0 + 8 * i + (lane >> 3)) * N + n0 + 4 * (lane & 7)));
#pragma unroll
    for (int i = 0; i < 8; ++i) { LAS float* d = scr + (8 * i + (lane >> 3)) * 33 + 4 * (lane & 7); d[0] = v[i][0]; d[1] = v[i][1]; d[2] = v[i][2]; d[3] = v[i][3]; }
    asm volatile("s_waitcnt lgkmcnt(0)" ::: "memory");
    const int c = lane & 7;
#pragma unroll
    for (int j = 0; j < 4; ++j) { const int n = (lane >> 3) + 8 * j; const LAS float* s = scr + (8 * c) * 33 + n;
        u32x4 o; o.x = pk2(s[0 * 33], s[1 * 33]); o.y = pk2(s[2 * 33], s[3 * 33]); o.z = pk2(s[4 * 33], s[5 * 33]); o.w = pk2(s[6 * 33], s[7 * 33]);
        *(u32x4*)(WT + (size_t)(n0 + n) * K + k0 + 8 * c) = o; }
    asm volatile("s_waitcnt lgkmcnt(0)" ::: "memory");
}

__device__ __forceinline__ void p0_ada_item(const Args& a, float* ada, LAS unsigned char* lds, int item, int wave, int lane) {
    const int n0 = item * 48, fr = lane & 15, kq = lane >> 4;
    f32x4 acc[9][3];
#pragma unroll
    for (int mt = 0; mt < 9; ++mt)
#pragma unroll
        for (int q = 0; q < 3; ++q) acc[mt][q] = (f32x4){0.f, 0.f, 0.f, 0.f};
    const float* const cr0 = fr < NB ? a.c_prompt + (size_t)fr * D : a.c_sample + (size_t)(fr - NB) * D;
    const float* const crm = a.c_sample + (size_t)(fr + 12) * D;
    const float* const cr8 = a.c_sample + (size_t)(124 + fr > NS - 1 ? NS - 1 : 124 + fr) * D;
#pragma unroll 2
    for (int ks = 0; ks < 8; ++ks) {
        const int k0 = wave * 256 + ks * 32 + kq * 8;
        float b[8][3];
#pragma unroll
        for (int j = 0; j < 8; ++j) { const float* p = a.w_ada + (size_t)(k0 + j) * NADA + n0 + 3 * fr; b[j][0] = __builtin_nontemporal_load(p); b[j][1] = __builtin_nontemporal_load(p + 1); b[j][2] = __builtin_nontemporal_load(p + 2); }
        bf16x8 bfr[3];
#pragma unroll
        for (int q = 0; q < 3; ++q) { u32x4 w; w.x = pk2(b[0][q], b[1][q]); w.y = pk2(b[2][q], b[3][q]); w.z = pk2(b[4][q], b[5][q]); w.w = pk2(b[6][q], b[7][q]); bfr[q] = __builtin_bit_cast(bf16x8, w); }
#pragma unroll
        for (int mt = 0; mt < 9; ++mt) {
            const float* cp = (mt == 0) ? cr0 : (mt == 8 ? cr8 : crm + (size_t)(mt - 1) * 16 * D);
            const f32x4 a0 = *(const f32x4*)(cp + k0), a1 = *(const f32x4*)(cp + k0 + 4);
            u32x4 w; w.x = pk2(a0[0], a0[1]); w.y = pk2(a0[2], a0[3]); w.z = pk2(a1[0], a1[1]); w.w = pk2(a1[2], a1[3]);
            const bf16x8 af = __builtin_bit_cast(bf16x8, w);
#pragma unroll
            for (int q = 0; q < 3; ++q) acc[mt][q] = __builtin_amdgcn_mfma_f32_16x16x32_bf16(af, bfr[q], acc[mt][q], 0, 0, 0);
            if (mt % 3 == 2) asm volatile("" ::: "memory");
        }
    }
    LAS float* red = (LAS float*)lds;
#pragma unroll
    for (int s = 4; s >= 1; s >>= 1) {
        if (wave >= s && wave < 2 * s) { LAS float* dst = red + (wave - s) * 6912 + lane;
#pragma unroll
            for (int mt = 0; mt < 9; ++mt)
#pragma unroll
                for (int q = 0; q < 3; ++q)
#pragma unroll
                    for (int j = 0; j < 4; ++j) dst[((mt * 3 + q) * 4 + j) * 64] = acc[mt][q][j]; }
        __syncthreads();
        if (wave < s) { const LAS float* src = red + wave * 6912 + lane;
#pragma unroll
            for (int mt = 0; mt < 9; ++mt)
#pragma unroll
                for (int q = 0; q < 3; ++q)
#pragma unroll
                    for (int j = 0; j < 4; ++j) acc[mt][q][j] += src[((mt * 3 + q) * 4 + j) * 64]; }
        __syncthreads();
    }
    if (wave == 0) {
#pragma unroll
        for (int q = 0; q < 3; ++q) { const int n = n0 + 3 * fr + q; const float bb = a.b_ada[n];
#pragma unroll
            for (int mt = 0; mt < 9; ++mt)
#pragma unroll
                for (int j = 0; j < 4; ++j) { const int r = mt * 16 + kq * 4 + j; if (r < NCOND) ada[(size_t)r * NADAP + item * 64 + 3 * fr + q] = acc[mt][q][j] + bb; } }
    }
}

__device__ __forceinline__ void p0_weff_item(const Args& a, bf16_t* WT, LAS unsigned char* lds, int item, int tid) {
    constexpr int AP = 260, BP = 80;
    const int g = item >> 7, it = (item >> 5) & 3, nt = item & 31, i0 = it * 64, n0 = nt * 64;
    LAS float* As = (LAS float*)lds;
    LAS float* Bs = (LAS float*)(lds + 66560);
#pragma unroll
    for (int r = 0; r < 8; ++r) { const int idx = tid + r * 512, row = idx >> 6, c4 = idx & 63;
        *(LAS f32x4*)(As + row * AP + c4 * 4) = *(const f32x4*)(a.pool_grp_w + ((size_t)(g * 256 + i0 + row)) * 256 + c4 * 4); }
    const int lane = tid & 63, wave = tid >> 6, fr = lane & 15, kq = lane >> 4, mt = wave >> 1, np = (wave & 1) * 2;
    f32x4 acc[2] = {(f32x4){0.f, 0.f, 0.f, 0.f}, (f32x4){0.f, 0.f, 0.f, 0.f}};
#pragma unroll 1
    for (int h = 0; h < 2; ++h) {
        __syncthreads();
#pragma unroll
        for (int r = 0; r < 4; ++r) { const int idx = tid + r * 512, o = idx >> 4, c4 = idx & 15;
            const float sc = a.pool_scale[g * 256 + h * 128 + o];
            *(LAS f32x4*)(Bs + o * BP + c4 * 4) = *(const f32x4*)(a.w_pool_up + (size_t)(g * 256 + h * 128 + o) * D + n0 + c4 * 4) * sc; }
        __syncthreads();
#pragma unroll 8
        for (int o4 = 0; o4 < 32; ++o4) {
            const float av = As[(mt * 16 + fr) * AP + h * 128 + o4 * 4 + kq];
            const float b0 = Bs[(o4 * 4 + kq) * BP + np * 16 + fr], b1 = Bs[(o4 * 4 + kq) * BP + np * 16 + 16 + fr];
            acc[0] = __builtin_amdgcn_mfma_f32_16x16x4f32(av, b0, acc[0], 0, 0, 0);
            acc[1] = __builtin_amdgcn_mfma_f32_16x16x4f32(av, b1, acc[1], 0, 0, 0);
        }
    }
#pragma unroll
    for (int t = 0; t < 2; ++t)
        *(u32x2*)(WT + (size_t)(n0 + (np + t) * 16 + fr) * PW + g * 256 + i0 + mt * 16 + kq * 4) = (u32x2){pk2(acc[t][0], acc[t][1]), pk2(acc[t][2], acc[t][3])};
    __syncthreads();
}

__device__ __forceinline__ void p1_modulate(const Args& a, const float* ada, bf16_t* U, int gw, int NGW, int lane) {
    if (NGW >= 2 * 8 * NS && (gw & 1) == 0 && (gw >> 1) < 8 * NS) {
        const int r = MP + (gw >> 4), c = ((gw >> 1) & 7) * 256 + 4 * lane;
        const float* ar = ada + (size_t)cond_row(r) * NADAP;
        const f32x4 v = *(const f32x4*)(a.x_sample + (size_t)(r - MP) * D + c) * (*(const f32x4*)(ar + adac(D + c)) + 1.f) + *(const f32x4*)(ar + adac(c));
        *(u32x2*)(U + (size_t)r * D + c) = (u32x2){pk2(v[0], v[1]), pk2(v[2], v[3])};
    }
    for (int r = gw; r < (NGW >= 2 * 8 * NS ? MP : MV); r += NGW) {
        u32x2* o8 = (u32x2*)(U + (size_t)r * D) + lane;
        const f32x4* xr = (const f32x4*)x_rowp(a.x_prompt, a.x_sample, r) + lane;
        const float* ar = ada + (size_t)cond_row(r) * NADAP;
#pragma unroll
        for (int j = 0; j < 8; ++j) { const int c = 4 * (lane + 64 * j); const f32x4 v = __builtin_nontemporal_load(xr + 64 * j) * (*(const f32x4*)(ar + adac(D + c)) + 1.f) + *(const f32x4*)(ar + adac(c));
            o8[64 * j] = (u32x2){pk2(v[0], v[1]), pk2(v[2], v[3])}; }
    }
}

__device__ __forceinline__ void p3_mixer(const Args& a, const bf16_t* proj, bf16_t* PRE, bf16_t* CIN, int tid) {
    const int j0 = 2 * tid, wave = tid >> 6, W = 2 << (wave >> 1);
    const f32x2 cw0 = *(const f32x2*)(a.conv_w + j0), cw1 = *(const f32x2*)(a.conv_w + CW + j0), cw2 = *(const f32x2*)(a.conv_w + 2 * CW + j0);
    float* const npp = a.out + O_NPP; float* const ncp = a.out + O_NCP; float* const nps = a.out + O_NPS; float* const ncs = a.out + O_NCS;
    for (int it = blockIdx.x; it < 384; it += gridDim.x) {
        if (it < 256) {
            const int b = it >> 6, s0 = (it & 63) * 32;
            const bf16_t* pb = proj + (size_t)(b * SEQ) * INW + j0;
            float S0 = 0.f, S1 = 0.f;
            for (int i = 1; i < W; ++i) { const int s = s0 - i; if (s >= 0) { const unsigned w = *(const unsigned*)(pb + (size_t)s * INW); S0 += bflo(w); S1 += bfhi(w); } }
            float v1a = 0.f, v1b = 0.f, v2a = 0.f, v2b = 0.f;
            if (s0 >= 1) { const bf16_t* p = pb + (size_t)(s0 - 1) * INW; const unsigned wx = *(const unsigned*)(p + 1024), wc = *(const unsigned*)(p + 3072); v1a = bflo(wc) * bflo(wx); v1b = bfhi(wc) * bfhi(wx); }
            if (s0 >= 2) { const bf16_t* p = pb + (size_t)(s0 - 2) * INW; const unsigned wx = *(const unsigned*)(p + 1024), wc = *(const unsigned*)(p + 3072); v2a = bflo(wc) * bflo(wx); v2b = bfhi(wc) * bfhi(wx); }
#pragma unroll 4
            for (int s = s0; s < s0 + 32; ++s) {
                const bf16_t* p = pb + (size_t)s * INW;
                const unsigned wz = *(const unsigned*)p, wx = *(const unsigned*)(p + 1024), wb = *(const unsigned*)(p + 2048), wc = *(const unsigned*)(p + 3072);
                const float z0 = bflo(wz), z1 = bfhi(wz);
                S0 += z0; S1 += z1;
                const int cnt = (s + 1 < W) ? s + 1 : W; const float fc = (float)cnt;
                const float p0 = S0 / fc - z0, p1 = S1 / fc - z1;
                const int so = s - W + 1;
                if (so >= 0) { const unsigned wo = *(const unsigned*)(pb + (size_t)so * INW); S0 -= bflo(wo); S1 -= bfhi(wo); }
                const float va = bflo(wc) * bflo(wx), vb = bfhi(wc) * bfhi(wx);
                const float ya = cw0[0] * v2a + cw1[0] * v1a + cw2[0] * va, yb = cw0[1] * v2b + cw1[1] * v1b + cw2[1] * vb;
                const size_t row = (size_t)(b * SEQ + s);
                *(unsigned*)(PRE + row * PW + j0) = pk2(p0, p1);
                *(unsigned*)(CIN + row * CW + j0) = pk2(bflo(wb) * ya, bfhi(wb) * yb);
                if (s >= SEQ - 15) *(f32x2*)(npp + ((size_t)(b * 15 + s - (SEQ - 15))) * PW + j0) = (f32x2){z0, z1};
                if (s >= SEQ - 2) *(f32x2*)(ncp + ((size_t)(b * 2 + s - (SEQ - 2))) * CW + j0) = (f32x2){va, vb};
                v2a = v1a; v2b = v1b; v1a = va; v1b = vb;
            }
        } else {
            const int b = it - 256; const size_t row = (size_t)(MP + b);
            const bf16_t* p = proj + row * INW + j0;
            const unsigned wz = *(const unsigned*)p, wx = *(const unsigned*)(p + 1024), wb = *(const unsigned*)(p + 2048), wc = *(const unsigned*)(p + 3072);
            const float z0 = bflo(wz), z1 = bfhi(wz);
            const float* sp = a.state_pool + (size_t)b * 15 * PW + j0;
            float S0 = z0, S1 = z1;
            for (int i = 1; i < W; ++i) { const f32x2 h = *(const f32x2*)(sp + (size_t)(15 - i) * PW); S0 += h[0]; S1 += h[1]; }
            const float fc = (float)W;
            *(unsigned*)(PRE + row * PW + j0) = pk2(S0 / fc - z0, S1 / fc - z1);
            const f32x2 h0 = *(const f32x2*)(a.state_conv + (size_t)(b * 2) * CW + j0), h1 = *(const f32x2*)(a.state_conv + (size_t)(b * 2 + 1) * CW + j0);
            const float va = bflo(wc) * bflo(wx), vb = bfhi(wc) * bfhi(wx);
            const float ya = cw0[0] * h0[0] + cw1[0] * h1[0] + cw2[0] * va, yb = cw0[1] * h0[1] + cw1[1] * h1[1] + cw2[1] * vb;
            *(unsigned*)(CIN + row * CW + j0) = pk2(bflo(wb) * ya, bfhi(wb) * yb);
#pragma unroll
            for (int r = 0; r < 14; ++r) *(f32x2*)(nps + ((size_t)(b * 15 + r)) * PW + j0) = *(const f32x2*)(sp + (size_t)(r + 1) * PW);
            *(f32x2*)(nps + ((size_t)(b * 15 + 14)) * PW + j0) = (f32x2){z0, z1};
            *(f32x2*)(ncs + ((size_t)(b * 2)) * CW + j0) = h1;
            *(f32x2*)(ncs + ((size_t)(b * 2 + 1)) * CW + j0) = (f32x2){va, vb};
        }
    }
}

__device__ __forceinline__ void ln_row(f32x4 (&v)[8], const f32x4 (&g4)[8], const f32x4 (&b4)[8]) {
    float s = 0.f;
#pragma unroll
    for (int j = 0; j < 8; ++j) s += (v[j][0] + v[j][1]) + (v[j][2] + v[j][3]);
    const float mean = wave_sum(s) * (1.f / D); float s2 = 0.f;
#pragma unroll
    for (int j = 0; j < 8; ++j) { v[j] = v[j] - mean; s2 += (v[j][0] * v[j][0] + v[j][1] * v[j][1]) + (v[j][2] * v[j][2] + v[j][3] * v[j][3]); }
    const float rstd = 1.f / sqrtf(wave_sum(s2) * (1.f / D) + LN_EPS);
#pragma unroll
    for (int j = 0; j < 8; ++j) v[j] = v[j] * rstd * g4[j] + b4[j];
}
__device__ __forceinline__ void p6_ln1(const Args& a, const float* ada, float* res, const float* part, bf16_t* U, int gw, int NGW, int lane) {
    f32x4 lg[8], lb[8];
#pragma unroll
    for (int j = 0; j < 8; ++j) { lg[j] = ((const f32x4*)a.ln1_g + lane)[64 * j]; lb[j] = ((const f32x4*)a.ln1_b + lane)[64 * j]; }
    for (int r = gw, nr; r >= 0; r = nr) { nr = -1; if (r < MP) { nr = r + NGW; if (nr >= MP) nr = ((gw & 15) == 0 && (gw >> 4) < NS && NGW >= 16 * NS) ? MP + (gw >> 4) : ((NGW >= 16 * NS) ? -1 : (nr < MV ? nr : -1)); } else if (NGW < 16 * NS) { nr = r + NGW; if (nr >= MV) nr = -1; }
        u32x2* o8 = (u32x2*)(U + (size_t)r * D) + lane;
        f32x4* rr = (f32x4*)(res + (size_t)r * D) + lane;
        const float* ar = ada + (size_t)cond_row(r) * NADAP;
        f32x4 v[8];
        if (r < MP) {
#pragma unroll
            for (int j = 0; j < 8; ++j) v[j] = rr[64 * j];
        } else {
            const f32x4* xr = (const f32x4*)(a.x_sample + (size_t)(r - MP) * D) + lane;
#pragma unroll
            for (int j = 0; j < 8; ++j) { f32x4 sum = (f32x4){0.f, 0.f, 0.f, 0.f};
#pragma unroll
                for (int sl = 0; sl < 8; ++sl) sum += ((const f32x4*)(part + ((size_t)sl * NS + (r - MP)) * D) + lane)[64 * j];
                v[j] = xr[64 * j] * ALPHA + *(const f32x4*)(ar + adac(2 * D + 4 * (lane + 64 * j))) * sum; }
        }
        ln_row(v, lg, lb);
#pragma unroll
        for (int j = 0; j < 8; ++j) { const int c = 4 * (lane + 64 * j); rr[64 * j] = v[j]; const f32x4 t = v[j] * (*(const f32x4*)(ar + adac(4 * D + c)) + 1.f) + *(const f32x4*)(ar + adac(3 * D + c));
            o8[64 * j] = (u32x2){pk2(t[0], t[1]), pk2(t[2], t[3])}; }
    }
}
__device__ __forceinline__ void p9_ln2(const Args& a, const float* ada, const float* res, const float* part, int gw, int NGW, int lane) {
    f32x4 lg[8], lb[8];
#pragma unroll
    for (int j = 0; j < 8; ++j) { lg[j] = ((const f32x4*)a.ln2_g + lane)[64 * j]; lb[j] = ((const f32x4*)a.ln2_b + lane)[64 * j]; }
    for (int r = gw, nr; r >= 0; r = nr) { nr = -1; if (r < MP) { nr = r + NGW; if (nr >= MP) nr = ((gw & 15) == 0 && (gw >> 4) < NS && NGW >= 16 * NS) ? MP + (gw >> 4) : ((NGW >= 16 * NS) ? -1 : (nr < MV ? nr : -1)); } else if (NGW < 16 * NS) { nr = r + NGW; if (nr >= MV) nr = -1; }
        const f32x4* rr = (const f32x4*)(res + (size_t)r * D) + lane;
        f32x4 v[8];
#pragma unroll
        for (int j = 0; j < 8; ++j) v[j] = rr[64 * j];
        if (r >= MP) {
            const float* ar = ada + (size_t)cond_row(r) * NADAP;
#pragma unroll
            for (int j = 0; j < 8; ++j) { f32x4 sum = *((const f32x4*)a.b_ff2 + lane + 64 * j);
#pragma unroll
                for (int sl = 0; sl < 8; ++sl) sum += ((const f32x4*)(part + ((size_t)sl * NS + (r - MP)) * D) + lane)[64 * j];
                v[j] = v[j] * ALPHA + *(const f32x4*)(ar + adac(5 * D + 4 * (lane + 64 * j))) * sum; }
        }
        ln_row(v, lg, lb);
        f32x4* o = (f32x4*)(a.out + (r < MP ? O_YP + (size_t)r * D : O_YS + (size_t)(r - MP) * D)) + lane;
#pragma unroll
        for (int j = 0; j < 8; ++j) o[64 * j] = v[j];
    }
}

typedef f32x4 Acc128[4][2];
__device__ __forceinline__ void gemm128_core(Acc128& acc, LAS unsigned char* lds, const bf16_t* A, const bf16_t* Bt, const int K  , const int klen  ) {
    using namespace pg8;
    const int tid = threadIdx.x, wid = __builtin_amdgcn_readfirstlane(tid >> 6), lane = tid & 63, wr = wid >> 2, wc = wid & 3, fr = lane & 15, fq = lane >> 4;
    const int nt = klen / 64;
    unsigned voff[2];
#pragma unroll
    for (int i = 0; i < 2; ++i) { int R, C; stage_rc(tid * 16 + i * 8192, R, C); voff[i] = (unsigned)(R * K + C) * 2u; }
    const unsigned ldsw = (unsigned)wid * 1024u;
    const int aoff = lds_byte(wr * 64 + fr, fq * 8), boff = lds_byte(wc * 32 + fr, fq * 8);
    const char* pa = (const char*)A; const char* pb = (const char*)Bt;
#define G128_STAGE(st, kt) do { _Pragma("unroll") for (int _i = 0; _i < 2; ++_i) { \
        __builtin_amdgcn_global_load_lds((const unsigned*)(pa + (size_t)(kt) * 128 + voff[_i]), (LAS unsigned*)(lds + (st) * 32768 + ldsw + _i * 8192), 16, 0, 0); \
        __builtin_amdgcn_global_load_lds((const unsigned*)(pb + (size_t)(kt) * 128 + voff[_i]), (LAS unsigned*)(lds + (st) * 32768 + 16384 + ldsw + _i * 8192), 16, 0, 0); } } while (0)
    G128_STAGE(0, 0); G128_STAGE(1, 1 < nt ? 1 : nt - 1); G128_STAGE(2, 2 < nt ? 2 : nt - 1);
#pragma unroll 1
    for (int t = 0; t < nt; ++t) {
        asm volatile("s_waitcnt vmcnt(8)" ::: "memory");
        __builtin_amdgcn_s_barrier();
        asm volatile("" ::: "memory");
        { const int kt = t + 3 < nt ? t + 3 : nt - 1; G128_STAGE((t + 3) & 3, kt); }
        const LAS unsigned char* sa = lds + (t & 3) * 32768; const LAS unsigned char* sb = sa + 16384;
        bf16x8 af[4][2], bfr[2][2];
#pragma unroll
        for (int m = 0; m < 4; ++m)
#pragma unroll
            for (int k = 0; k < 2; ++k) af[m][k] = *(const LAS bf16x8*)(sa + aoff + m * 2048 + k * 1024);
#pragma unroll
        for (int n = 0; n < 2; ++n)
#pragma unroll
            for (int k = 0; k < 2; ++k) bfr[n][k] = *(const LAS bf16x8*)(sb + boff + n * 2048 + k * 1024);
#pragma unroll
        for (int m = 0; m < 4; ++m)
#pragma unroll
            for (int n = 0; n < 2; ++n)
#pragma unroll
                for (int k = 0; k < 2; ++k) acc[m][n] = __builtin_amdgcn_mfma_f32_16x16x32_bf16(bfr[n][k], af[m][k], acc[m][n], 0, 0, 0);
        asm volatile("s_waitcnt lgkmcnt(0)" ::: "memory");
    }
    asm volatile("s_waitcnt vmcnt(0)" ::: "memory");
    __builtin_amdgcn_s_barrier();
    asm volatile("" ::: "memory");
#undef G128_STAGE
}
__device__ __forceinline__ void zero128(Acc128& acc) {
#pragma unroll
    for (int m = 0; m < 4; ++m)
#pragma unroll
        for (int n = 0; n < 2; ++n) acc[m][n] = (f32x4){0.f, 0.f, 0.f, 0.f};
}
template <int MODE>
__device__ __forceinline__ void sample_gemm(const Args& a, LAS unsigned char* lds, const bf16_t* A0, const bf16_t* B0, const bf16_t* A1, const bf16_t* B1, const int K, const int N,
                                            const bf16_t* proj, bf16_t* Ob, float* res, const float* ada) {
    const int tid = threadIdx.x, wid = __builtin_amdgcn_readfirstlane(tid >> 6), lane = tid & 63, wr = wid >> 2, wc = wid & 3, fr = lane & 15, fq = lane >> 4;
    constexpr int NSL = (MODE >= 3) ? 8 : 1;
    for (int unit = blockIdx.x; unit < (N / 128) * NSL; unit += gridDim.x) {
        const int n0 = (unit / NSL) * 128, sl = unit % NSL, klen = K / NSL;
        Acc128 acc, acc2;
        zero128(acc);
        gemm128_core(acc, lds, A0 + (size_t)MP * K + sl * klen, B0 + (size_t)n0 * K + sl * klen, K, klen);
        if (MODE == 2) { zero128(acc2); gemm128_core(acc2, lds, A1 + (size_t)MP * K, B1 + (size_t)n0 * K, K, K); }
#pragma unroll
        for (int m = 0; m < 4; ++m) { const int ms = wr * 64 + m * 16 + fr; const size_t row = (size_t)(MP + ms);
#pragma unroll
            for (int n = 0; n < 2; ++n) { const int c = n0 + wc * 32 + n * 16 + 4 * fq; f32x4 v = acc[m][n];
                if (MODE == 0) { *(u32x2*)(Ob + row * INW + c) = (u32x2){pk2(v[0], v[1]), pk2(v[2], v[3])}; }
                else if (MODE == 1) { v = v + *(const f32x4*)(a.b_ff1 + c);
#pragma unroll
                    for (int j = 0; j < 4; ++j) { const float r = fmaxf(v[j], 0.f); v[j] = r * r; }
                    *(u32x2*)(Ob + row * DFF + c) = (u32x2){pk2(v[0], v[1]), pk2(v[2], v[3])}; }
                else if (MODE == 2) {
                    const u32x2 gpw = *(const u32x2*)(proj + row * INW + 4096 + c), gcw = *(const u32x2*)(proj + row * INW + 6144 + c);
                    const float gp[4] = {bflo(gpw.x), bfhi(gpw.x), bflo(gpw.y), bfhi(gpw.y)}, gc[4] = {bflo(gcw.x), bfhi(gcw.x), bflo(gcw.y), bfhi(gcw.y)};
                    float o[4];
#pragma unroll
                    for (int j = 0; j < 4; ++j) o[j] = v[j] / (1.f + __expf(-gp[j])) + acc2[m][n][j] / (1.f + __expf(-gc[j]));
                    *(u32x2*)(Ob + row * D + c) = (u32x2){pk2(o[0], o[1]), pk2(o[2], o[3])}; }
                else { *(f32x4*)(res + ((size_t)sl * NS + ms) * D + c) = v; }
            } }
    }
}

#define XB_TMO      128
#define XB_XCNT(j)  (256  + 64 * (j))
#define XB_XSUB(j)  (1280 + 64 * (j))
#define XB_XGEN(j)  (2304 + 64 * (j))
#define XB_TOP      3328
#define XB_TOPGEN   3392
#define XCD_BAR_WORDS 3456
#define XB_SPIN_CAP (1u << 18)
__device__ __forceinline__ unsigned xb_ld(unsigned* p)              { return __hip_atomic_load(p, __ATOMIC_RELAXED, __HIP_MEMORY_SCOPE_AGENT); }
__device__ __forceinline__ unsigned xb_add(unsigned* p, unsigned v) { return __hip_atomic_fetch_add(p, v, __ATOMIC_RELAXED, __HIP_MEMORY_SCOPE_AGENT); }
__device__ __forceinline__ unsigned xb_xcc_id() { return (unsigned)__builtin_amdgcn_s_getreg((3 << 11) | 20) & 0xFu; }
#define XB_SPIN(cond, bar) do { unsigned _sp = 0; while (cond) { __builtin_amdgcn_s_sleep(1); \
    if ((++_sp & 255u) == 0u) { if (xb_ld(&(bar)[XB_TMO])) break; if (_sp > XB_SPIN_CAP) { atomicAdd(&(bar)[XB_TMO], 1u); break; } } } } while (0)
struct XcdBarrier { unsigned* bar; unsigned x; volatile LAS unsigned* st; };
__device__ __forceinline__ XcdBarrier xcd_barrier_post(unsigned* bar, volatile LAS unsigned* st) {
    XcdBarrier b; b.bar = bar; b.x = xb_xcc_id(); b.st = st;
    if (threadIdx.x == 0) (void)xb_add(&bar[XB_XCNT(b.x)], 1u);
    return b;
}
__device__ __forceinline__ void xcd_barrier_complete(unsigned* bar, unsigned x, unsigned& nloc, unsigned& nx) {
    const unsigned G = gridDim.x * gridDim.y * gridDim.z;
    unsigned sum, cnt, mine, sp = 0u;
    for (;;) {
        sum = 0u; cnt = 0u; mine = 0u;
#pragma unroll
        for (unsigned j = 0; j < 16; ++j) { const unsigned c = xb_ld(&bar[XB_XCNT(j)]); sum += c; cnt += (c > 0u) ? 1u : 0u; mine = (j == x) ? c : mine; }
        if (sum == G) break;
        __builtin_amdgcn_s_sleep(1);
        if ((++sp & 255u) == 0u) { if (xb_ld(&bar[XB_TMO])) break; if (sp > XB_SPIN_CAP) { atomicAdd(&bar[XB_TMO], 1u); break; } }
    }
    nloc = mine > 0u ? mine : 1u; nx = cnt > 0u ? cnt : 1u;
}
__device__ __forceinline__ void xcd_barrier(const XcdBarrier& b) {
    asm volatile("s_waitcnt vmcnt(0)" ::: "memory");
    __syncthreads();
    if (threadIdx.x == 0) {
        unsigned* bar = b.bar;
        __builtin_amdgcn_s_waitcnt(0);
        unsigned nloc = b.st[0], nx = b.st[1];
        if (nloc == 0u) { xcd_barrier_complete(bar, b.x, nloc, nx); b.st[0] = nloc; b.st[1] = nx; }
        const unsigned old = xb_add(&bar[XB_XSUB(b.x)], 1u);
        const unsigned gen = old / nloc;
        if (old + 1u == (gen + 1u) * nloc) {
            __builtin_amdgcn_fence(__ATOMIC_RELEASE, "agent");
            asm volatile("s_waitcnt vmcnt(0)" ::: "memory");
            const unsigned og = xb_add(&bar[XB_TOP], 1u);
            const unsigned tg = og / nx;
            if (og + 1u == (tg + 1u) * nx) xb_add(&bar[XB_TOPGEN], 1u);
            else XB_SPIN(xb_ld(&bar[XB_TOPGEN]) == tg, bar);
            __builtin_amdgcn_fence(__ATOMIC_ACQUIRE, "agent");
            xb_add(&bar[XB_XGEN(b.x)], 1u);
            asm volatile("s_waitcnt vmcnt(0)" ::: "memory");
        } else {
            XB_SPIN(xb_ld(&bar[XB_XGEN(b.x)]) == gen, bar);
            __builtin_amdgcn_fence(__ATOMIC_ACQUIRE, "agent");
            asm volatile("s_waitcnt vmcnt(0)" ::: "memory");
        }
    }
    __syncthreads();
}

constexpr int TB_O = (D / 64) * (INW / 32), TB_C = TB_O + (D / 64) * (D / 32), TB_F1 = TB_C + (CW / 64) * (D / 32), TB_F2 = TB_F1 + (D / 64) * (DFF / 32), TB_END = TB_F2 + (DFF / 64) * (D / 32);
static_assert(TB_O == 8192 && TB_C == 10240 && TB_F1 == 11264 && TB_F2 == 19456 && TB_END == 27648, "item list");
constexpr int TB_F2H = TB_F2 + (TB_END - TB_F2) / 2;
__device__ __forceinline__ void tr_range(const Args& a, LAS unsigned char* lds, int lo1, int n1, int lo2, int n2, int widx, int nw, int wave, int lane) {
    unsigned char* ws = a.ws;
    bf16_t* WinT = (bf16_t*)(ws + WS_WIN); bf16_t* Wff1T = (bf16_t*)(ws + WS_WFF1); bf16_t* Wff2T = (bf16_t*)(ws + WS_WFF2); bf16_t* WoT = (bf16_t*)(ws + WS_WO); bf16_t* WupC = (bf16_t*)(ws + WS_WUPC);
    LAS float* scr = (LAS float*)(lds + wave * 16384);
    for (int v = widx; v < n1 + n2; v += nw) {
        int r = v < n1 ? lo1 + v : lo2 + (v - n1);
        if (r < TB_O) { p0_transpose_item(a.w_in, D, INW, WinT, scr, r, lane); continue; } r -= TB_O;
        if (r < TB_C - TB_O) { p0_transpose_item(a.w_o, D, D, WoT, scr, r, lane); continue; } r -= TB_C - TB_O;
        if (r < TB_F1 - TB_C) { p0_transpose_item(a.w_conv_up, CW, D, WupC, scr, r, lane); continue; } r -= TB_F1 - TB_C;
        if (r < TB_F2 - TB_F1) { p0_transpose_item(a.w_ff1, D, DFF, Wff1T, scr, r, lane); continue; } r -= TB_F2 - TB_F1;
        p0_transpose_item(a.w_ff2, DFF, D, Wff2T, scr, r, lane);
    }
}
__device__ __forceinline__ void tr_tail(const Args& a, LAS unsigned char* lds, int lo, int n, int nunits, int wave, int lane) {
    const int G = gridDim.x, bx = blockIdx.x, ns = nunits < G ? nunits : 0;
    if (bx >= ns) tr_range(a, lds, lo, n, 0, 0, (bx - ns) * 8 + wave, (G - ns) * 8, wave, lane);
}
__device__ __forceinline__ void p0_all(const Args& a, LAS unsigned char* lds, int tid, int lane, int wave, int bx, int G) {
    unsigned char* ws = a.ws;
    float* ada = (float*)(ws + WS_ADA);
    bf16_t* WupP = (bf16_t*)(ws + WS_WUPP);
    const int gw = bx * 8 + wave, NGW = G * 8;
    if (bx & 1) {
    tr_range(a, lds, 0, TB_O, TB_F2H, TB_END - TB_F2H, gw, NGW, wave, lane);
    __syncthreads();
    for (int it = bx; it < NADA / 48; it += G) p0_ada_item(a, ada, lds, it, wave, lane);
    for (int it = bx; it < 512; it += G) p0_weff_item(a, WupP, lds, it, tid);
    } else {
    for (int it = bx; it < NADA / 48; it += G) p0_ada_item(a, ada, lds, it, wave, lane);
    for (int it = bx; it < 512; it += G) p0_weff_item(a, WupP, lds, it, tid);
    tr_range(a, lds, 0, TB_O, TB_F2H, TB_END - TB_F2H, gw, NGW, wave, lane);
    }
}

__global__ void __launch_bounds__(512, 2) fwd_megakernel(Args a) {
    extern __shared__ __attribute__((aligned(16))) unsigned char lds_raw[];
    LAS unsigned char* lds = (LAS unsigned char*)lds_raw;
    const int tid = threadIdx.x, lane = tid & 63, wave = __builtin_amdgcn_readfirstlane(tid >> 6);
    const int G = gridDim.x, bx = blockIdx.x;
    const int gw = bx * 8 + wave, NGW = G * 8;
    unsigned char* ws = a.ws;
    float* ada = (float*)(ws + WS_ADA);
    unsigned* ctr = (unsigned*)(ws + WS_CTL);
    if (tid < 64) ((LAS unsigned*)(lds + MISC_OFF))[tid] = 0u;
    __syncthreads();
    const XcdBarrier xbar = xcd_barrier_post(ctr, (volatile LAS unsigned*)(lds + MISC_OFF));
#define GB() xcd_barrier(xbar)
    bf16_t* WinT = (bf16_t*)(ws + WS_WIN); bf16_t* Wff1T = (bf16_t*)(ws + WS_WFF1); bf16_t* Wff2T = (bf16_t*)(ws + WS_WFF2); bf16_t* WoT = (bf16_t*)(ws + WS_WO);
    bf16_t* WupP = (bf16_t*)(ws + WS_WUPP); bf16_t* WupC = (bf16_t*)(ws + WS_WUPC);
    bf16_t* U = (bf16_t*)(ws + WS_U); bf16_t* PROJ = (bf16_t*)(ws + WS_PROJ); float* RES = (float*)(ws + WS_RES);
    float* PART = (float*)(ws + WS_PART);
    bf16_t* PRE = (bf16_t*)(ws + WS_RES); bf16_t* CIN = (bf16_t*)(ws + WS_RES + WS_CIN_OFF);

    p0_all(a, lds, tid, lane, wave, bx, G);
    GB();
    p1_modulate(a, ada, U, gw, NGW, lane);
    GB();
    { pg8::Order S; S.init(MP, INW, G, bx, 1, U, WinT, U, WinT);
      pg8::EpiBf16<0> E{PROJ, INW, nullptr};
      pg8::gemm_phase(lds, D, S, E); }
    sample_gemm<0>(a, lds, U, WinT, U, WinT, D, INW, PROJ, PROJ, RES, ada);
    tr_tail(a, lds, TB_O, TB_F1 - TB_O, INW / 128, wave, lane);
    GB();
    p3_mixer(a, PROJ, PRE, CIN, tid);
    GB();
    { pg8::Order S; S.init(MP, D, G, bx, 2, PRE, WupP, CIN, WupC);
      pg8::EpiGate E{PROJ, U};
      pg8::gemm_phase(lds, PW, S, E); }
    sample_gemm<2>(a, lds, PRE, WupP, CIN, WupC, PW, D, PROJ, U, RES, ada);
    tr_tail(a, lds, TB_F1, TB_F2 - TB_F1, D / 128, wave, lane);
    GB();
    { pg8::Order S; S.init(MP, D, G, bx, 1, U, WoT, U, WoT);
      pg8::EpiRes E{RES, a.x_prompt, ada, 2 * D, nullptr};
      pg8::gemm_phase(lds, D, S, E); }
    sample_gemm<3>(a, lds, U, WoT, U, WoT, D, D, PROJ, U, PART, ada);
    GB();
    p6_ln1(a, ada, RES, PART, U, gw, NGW, lane);
    GB();
    { pg8::Order S; S.init(MP, DFF, G, bx, 1, U, Wff1T, U, Wff1T);
      pg8::EpiBf16<1> E{PROJ, DFF, a.b_ff1};
      pg8::gemm_phase(lds, D, S, E); }
    sample_gemm<1>(a, lds, U, Wff1T, U, Wff1T, D, DFF, PROJ, PROJ, RES, ada);
    tr_tail(a, lds, TB_F2, TB_F2H - TB_F2, DFF / 128, wave, lane);
    GB();
    { pg8::Order S; S.init(MP, D, G, bx, 1, PROJ, Wff2T, PROJ, Wff2T);
      pg8::EpiRes E{RES, RES, ada, 5 * D, a.b_ff2};
      pg8::gemm_phase(lds, DFF, S, E); }
    sample_gemm<4>(a, lds, PROJ, Wff2T, PROJ, Wff2T, DFF, D, PROJ, U, PART, ada);
    GB();
    p9_ln2(a, ada, RES, PART, gw, NGW, lane);
}

extern "C" void kernel_launch(void* const* d_in, const int* in_sizes, int n_in, void* d_out, int out_size, void* d_ws, size_t ws_size, hipStream_t stream) {
    static int grid = 0;
    if (grid == 0) {
        if (n_in != 23 || ws_size < WS_END) { fprintf(stderr, "kernel_launch: expected 23 inputs and >= %zu bytes of workspace; got %d, %zu\n", (size_t)WS_END, n_in, ws_size); grid = -1; return; }
        int dev = 0, cus = 0, per_cu = 0;
        hipGetDevice(&dev);
        hipDeviceGetAttribute(&cus, hipDeviceAttributeMultiprocessorCount, dev);
        if (hipFuncSetAttribute((const void*)fwd_megakernel, hipFuncAttributeMaxDynamicSharedMemorySize, LDS_BYTES) != hipSuccess) { fprintf(stderr, "kernel_launch: hipFuncSetAttribute failed\n"); grid = -1; return; }
        if (hipOccupancyMaxActiveBlocksPerMultiprocessor(&per_cu, (const void*)fwd_megakernel, 512, LDS_BYTES) != hipSuccess || per_cu < 1) { fprintf(stderr, "kernel_launch: occupancy query says %d blocks per CU\n", per_cu); (void)hipGetLastError(); per_cu = 1; }
        grid = cus;
        fprintf(stderr, "kernel_launch: cus %d per_cu %d grid %d\n", cus, per_cu, grid);
    }
    if (grid < 0) return;
    if (hipMemsetAsync((char*)d_ws + WS_CTL, 0, 16384, stream) != hipSuccess) { fprintf(stderr, "kernel_launch: memset failed\n"); return; }
    Args a{};
    const float** ap = (const float**)&a;
    for (int i = 0; i < 23; ++i) ap[i] = (const float*)d_in[i];
    a.out = (float*)d_out; a.ws = (unsigned char*)d_ws;
    void* args[] = {&a};
    hipError_t e = hipLaunchCooperativeKernel((const void*)fwd_megakernel, dim3(grid), dim3(512), args, LDS_BYTES, stream);
    if (e != hipSuccess) fprintf(stderr, "kernel_launch: cooperative launch failed: %s (grid %d)\n", hipGetErrorString(e), grid);
}
```

```cpp
#include <hip/hip_runtime.h>
#include <cstdio>
#include <cstdint>

#define LAS __attribute__((address_space(3)))
typedef unsigned short bf16_t;
typedef short bf16x8 __attribute__((ext_vector_type(8)));
typedef float f32x4 __attribute__((ext_vector_type(4)));
typedef float f32x2 __attribute__((ext_vector_type(2)));
typedef unsigned u32x4 __attribute__((ext_vector_type(4)));
typedef unsigned u32x2 __attribute__((ext_vector_type(2)));

constexpr int D = 2048, NB = 4, SEQ = 2048, NS = 128;
constexpr int MP = NB * SEQ;
constexpr int MV = MP + NS;
constexpr int MPAD = 8448;
constexpr int PW = 1024, CW = 1024, DFF = 8192, INW = 8192, NADA = 6 * D, NCOND = NB + NS;
constexpr float ALPHA = 1.18920711500272f;
constexpr float LN_EPS = 1e-5f;
constexpr int NADAP = 256 * 64;
__device__ __forceinline__ int adac(int n) { return n + 16 * (n / 48); }

constexpr size_t MiB = 1u << 20;
constexpr size_t WS_CTL = 0;
constexpr size_t WS_ADA = 352 * MiB;
constexpr size_t WS_WIN = 8 * MiB, WS_WFF1 = 40 * MiB, WS_WFF2 = 72 * MiB, WS_WO = 104 * MiB, WS_WUPP = 112 * MiB, WS_WUPC = 116 * MiB;
constexpr size_t WS_U = 120 * MiB;
constexpr size_t WS_PROJ = 153 * MiB;
constexpr size_t WS_RES = 285 * MiB;
constexpr size_t WS_PART = 362 * MiB;
constexpr size_t WS_END = 378 * MiB;
constexpr size_t WS_CIN_OFF = (size_t)MPAD * 1024 * 2;

constexpr size_t O_YP = 0, O_YS = (size_t)MP * D, O_NPP = O_YS + (size_t)NS * D, O_NCP = O_NPP + (size_t)NB * 15 * PW, O_NPS = O_NCP + (size_t)NB * 2 * CW, O_NCS = O_NPS + (size_t)NS * 15 * PW;

constexpr int LDS_BYTES = 131072 + 256, MISC_OFF = 131072;

__device__ __forceinline__ unsigned f2bf(float f) { unsigned u = __builtin_bit_cast(unsigned, f); return (u + 0x7fffu + ((u >> 16) & 1u)) >> 16; }
__device__ __forceinline__ unsigned pk2(float lo, float hi) { return f2bf(lo) | (f2bf(hi) << 16); }
__device__ __forceinline__ unsigned cvt_pk_bf16(float lo, float hi) { unsigned r; asm volatile("v_cvt_pk_bf16_f32 %0, %1, %2" : "=v"(r) : "v"(lo), "v"(hi)); return r; }
__device__ __forceinline__ float bflo(unsigned w) { return __builtin_bit_cast(float, w << 16); }
__device__ __forceinline__ float bfhi(unsigned w) { return __builtin_bit_cast(float, w & 0xffff0000u); }
__device__ __forceinline__ int cond_row(int r) { int s = r - MP; s = s < 0 ? 0 : (s > NS - 1 ? NS - 1 : s); return r < MP ? (r >> 11) : NB + s; }
__device__ __forceinline__ const float* x_rowp(const float* xp, const float* xs, int r) { int s = r - MP; s = s < 0 ? 0 : (s > NS - 1 ? NS - 1 : s); return r < MP ? xp + (size_t)r * D : xs + (size_t)s * D; }

namespace pg8 {
constexpr int BM = 256, BK = 64, HALF = 128, HTB = HALF * BK * 2, NXCD = 8, WGM = 4;
__device__ __forceinline__ int lds_byte(int r, int c) { const int st = (r >> 4) * 2 + (c >> 5), rr = r & 15, cc = c & 31, ob = rr * 64 + cc * 2; return st * 1024 + (ob ^ (((ob >> 9) & 1) << 5)); }
__device__ __forceinline__ void stage_rc(int b, int& R, int& C) { const int st = b / 1024, sb = b % 1024, swz = sb ^ (((sb >> 9) & 1) << 5); R = (st >> 1) * 16 + swz / 64; C = (st & 1) * 32 + (swz % 64) / 2; }
__device__ __forceinline__ int perm32(int rho) { const int n = rho >> 4, i = rho & 15; return 8 * (i >> 2) + 4 * n + (i & 3); }

struct Unit { int pm, pn, grp; };
struct Order {
    int nM, nN, nwg, G, c, rep;
    const char* A0; const char* B0; const char* A1; const char* B1;
    __device__ __forceinline__ void init(int M, int N, int G_, int c_, int rep_, const void* a0, const void* b0, const void* a1, const void* b1) {
        nM = M / BM; nN = N / BM; nwg = nM * nN; G = G_; c = c_; rep = rep_; A0 = (const char*)a0; B0 = (const char*)b0; A1 = (const char*)a1; B1 = (const char*)b1; }
    __device__ __forceinline__ bool next(int i, Unit& u) const {
        const int ti = (rep == 2) ? (i >> 1) : i; u.grp = (rep == 2) ? (i & 1) : 0;
        const long L = (long)ti * G + c; if (L >= nwg) return false;
        int wgid = (int)L; { const int q = nwg / NXCD, r = nwg % NXCD, xcd = wgid % NXCD, off = wgid / NXCD; wgid = (xcd < r ? xcd * (q + 1) : r * (q + 1) + (xcd - r) * q) + off; }
        const int nig = WGM * nN, gid = wgid / nig, fm = gid * WGM, gsz = (nM - fm) < WGM ? (nM - fm) : WGM;
        u.pm = fm + ((wgid % nig) % gsz); u.pn = (wgid % nig) / gsz; return true;
    }
    __device__ __forceinline__ const char* baseA(const Unit& u, size_t tstep) const { return (u.grp ? A1 : A0) + (size_t)u.pm * tstep; }
    __device__ __forceinline__ const char* baseB(const Unit& u, size_t tstep) const { return (u.grp ? B1 : B0) + (size_t)u.pn * tstep; }
};

typedef f32x4 Acc[2][2][4][2];

template <int ACT> struct EpiBf16 {
    static constexpr bool PERM = true;
    bf16_t* O; int ldc; const float* bias;
    __device__ __forceinline__ bool keep(const Unit&) const { return false; }
    __device__ __forceinline__ void operator()(Acc& acc, const Unit& u, int wr, int wc, int fr, int fq) const {
        const int row0 = u.pm * BM + wr * 64 + fr, col0 = u.pn * BM + wc * 32 + 8 * fq;
        f32x4 bv[2][2];
#pragma unroll
        for (int bj = 0; bj < 2; ++bj)
#pragma unroll
            for (int n = 0; n < 2; ++n) bv[bj][n] = bias ? *(const f32x4*)(bias + col0 + bj * HALF + 4 * n) : (f32x4){0.f, 0.f, 0.f, 0.f};
#pragma unroll
        for (int ai = 0; ai < 2; ++ai)
#pragma unroll
            for (int m = 0; m < 4; ++m) { bf16_t* rowp = O + (size_t)(row0 + ai * HALF + m * 16) * ldc + col0;
#pragma unroll
                for (int bj = 0; bj < 2; ++bj) { f32x4 v0 = acc[ai][bj][m][0] + bv[bj][0], v1 = acc[ai][bj][m][1] + bv[bj][1];
                    if (ACT == 1) {
#pragma unroll
                        for (int j = 0; j < 4; ++j) { const float a = fmaxf(v0[j], 0.f), b = fmaxf(v1[j], 0.f); v0[j] = a * a; v1[j] = b * b; } }
                    u32x4 w; w.x = cvt_pk_bf16(v0[0], v0[1]); w.y = cvt_pk_bf16(v0[2], v0[3]); w.z = cvt_pk_bf16(v1[0], v1[1]); w.w = cvt_pk_bf16(v1[2], v1[3]);
                    *(u32x4*)(rowp + bj * HALF) = w; } }
    }
};
__device__ __forceinline__ void unpack8(const u32x4 w, float (&e)[8]) { e[0] = bflo(w.x); e[1] = bfhi(w.x); e[2] = bflo(w.y); e[3] = bfhi(w.y); e[4] = bflo(w.z); e[5] = bfhi(w.z); e[6] = bflo(w.w); e[7] = bfhi(w.w); }
struct EpiGate {
    static constexpr bool PERM = true;
    const bf16_t* proj; bf16_t* O;
    __device__ __forceinline__ bool keep(const Unit& u) const { return u.grp == 0; }
    __device__ __forceinline__ void operator()(Acc& acc, const Unit& u, int wr, int wc, int fr, int fq) const {
        const int row0 = u.pm * BM + wr * 64 + fr, col0 = u.pn * BM + wc * 32 + 8 * fq;
        const bool g0 = (u.grp == 0);
        u32x4 gcw[2], gpw[2];
        { const bf16_t* p = proj + (size_t)row0 * INW + col0; gcw[0] = *(const u32x4*)(p + 6144); gpw[0] = g0 ? *(const u32x4*)(p + 4096) : gcw[0]; }
#pragma unroll
        for (int it = 0; it < 16; ++it) { const int ai = it >> 3, m = (it >> 1) & 3, bj = it & 1;
            const size_t row = (size_t)(row0 + ai * HALF + m * 16); const int col = col0 + bj * HALF;
            if (it < 15) { const int ai2 = (it + 1) >> 3, m2 = ((it + 1) >> 1) & 3, bj2 = (it + 1) & 1;
                const bf16_t* p = proj + (size_t)(row0 + ai2 * HALF + m2 * 16) * INW + col0 + bj2 * HALF;
                gcw[(it + 1) & 1] = *(const u32x4*)(p + 6144); gpw[(it + 1) & 1] = g0 ? *(const u32x4*)(p + 4096) : gcw[(it + 1) & 1]; }
            float ec[8]; unpack8(gcw[it & 1], ec);
#pragma unroll
            for (int j = 0; j < 8; ++j) ec[j] = 1.f + __expf(-fmaxf(ec[j], -30.f));
            if (g0) {
                float ep[8]; unpack8(gpw[it & 1], ep);
#pragma unroll
                for (int j = 0; j < 8; ++j) ep[j] = ec[j] * __builtin_amdgcn_rcpf(1.f + __expf(-ep[j]));
#pragma unroll
                for (int j = 0; j < 4; ++j) { acc[ai][bj][m][0][j] *= ep[j]; acc[ai][bj][m][1][j] *= ep[4 + j]; }
            } else {
                f32x4 v0, v1;
#pragma unroll
                for (int j = 0; j < 4; ++j) { v0[j] = acc[ai][bj][m][0][j] * __builtin_amdgcn_rcpf(ec[j]); v1[j] = acc[ai][bj][m][1][j] * __builtin_amdgcn_rcpf(ec[4 + j]); }
                u32x4 w; w.x = cvt_pk_bf16(v0[0], v0[1]); w.y = cvt_pk_bf16(v0[2], v0[3]); w.z = cvt_pk_bf16(v1[0], v1[1]); w.w = cvt_pk_bf16(v1[2], v1[3]);
                *(u32x4*)(O + row * D + col) = w;
            } }
    }
};
struct EpiRes {
    static constexpr bool PERM = false;
    float* res; const float* base; const float* ada; int gate_off; const float* bias;
    __device__ __forceinline__ bool keep(const Unit&) const { return false; }
    __device__ __forceinline__ void operator()(Acc& acc, const Unit& u, int wr, int wc, int fr, int fq) const {
        const int row0 = u.pm * BM + wr * 64 + fr, col0 = u.pn * BM + wc * 32 + 4 * fq;
        const float* gp = ada + (size_t)(u.pm >> 3) * NADAP;
        f32x4 bv[2][2], gv[2][2], xb[2][2][2];
#pragma unroll
        for (int bj = 0; bj < 2; ++bj)
#pragma unroll
            for (int n = 0; n < 2; ++n) { bv[bj][n] = bias ? *(const f32x4*)(bias + col0 + bj * HALF + n * 16) : (f32x4){0.f, 0.f, 0.f, 0.f}; gv[bj][n] = *(const f32x4*)(gp + adac(gate_off + col0 + bj * HALF + n * 16)); }
#pragma unroll
        for (int bj = 0; bj < 2; ++bj)
#pragma unroll
            for (int n = 0; n < 2; ++n) xb[0][bj][n] = *(const f32x4*)(base + (size_t)row0 * D + col0 + bj * HALF + n * 16);
#pragma unroll
        for (int it = 0; it < 8; ++it) { const int ai = it >> 2, m = it & 3;
            if (it < 7) { const float* bp = base + (size_t)(row0 + ((it + 1) >> 2) * HALF + ((it + 1) & 3) * 16) * D + col0;
#pragma unroll
                for (int bj = 0; bj < 2; ++bj)
#pragma unroll
                    for (int n = 0; n < 2; ++n) xb[(it + 1) & 1][bj][n] = *(const f32x4*)(bp + bj * HALF + n * 16); }
            float* rp = res + (size_t)(row0 + ai * HALF + m * 16) * D + col0;
#pragma unroll
            for (int bj = 0; bj < 2; ++bj)
#pragma unroll
                for (int n = 0; n < 2; ++n) *(f32x4*)(rp + bj * HALF + n * 16) = xb[it & 1][bj][n] * ALPHA + gv[bj][n] * (acc[ai][bj][m][n] + bv[bj][n]); }
    }
};

template <class Epi>
__device__ __forceinline__ void gemm_phase(LAS unsigned char* lds, const int K, const Order& S, const Epi& E) {
    const int tid = threadIdx.x, wid = __builtin_amdgcn_readfirstlane(tid >> 6), lane = tid & 63, wr = wid >> 2, wc = wid & 3, fr = lane & 15, fq = lane >> 4;
    const int nt = K / BK;
    unsigned voffA[2], voffB[2];
#pragma unroll
    for (int i = 0; i < 2; ++i) { int R, C; stage_rc(tid * 16 + i * 8192, R, C); const int Rb = Epi::PERM ? ((R & ~31) + perm32(R & 31)) : R;
        voffA[i] = (unsigned)(R * K + C) * 2u; voffB[i] = (unsigned)(Rb * K + C) * 2u; }
    const size_t kstep = (size_t)(BK * 2);
    const size_t hstep = (size_t)HALF * K * 2;
    const size_t tstep = 2 * hstep;
    const unsigned ldsw = (unsigned)wid * 1024u;
    const int aoff = lds_byte(wr * 64 + fr, fq * 8), boff = lds_byte(wc * 32 + fr, fq * 8);
#define PG8_SA(b, h) (((b) * 2 + (h)) * HTB)
#define PG8_SB(b, h) ((4 + (b) * 2 + (h)) * HTB)
#define PG8_STAGE(bufoff, gbase, voff) do { _Pragma("unroll") for (int _i = 0; _i < 2; ++_i) \
        __builtin_amdgcn_global_load_lds((const unsigned*)((const char*)(gbase) + (voff)[_i]), (LAS unsigned*)(lds + (bufoff) + ldsw + _i * 8192), 16, 0, 0); } while (0)
#define PG8_LDA(dst, b, h) do { _Pragma("unroll") for (int m = 0; m < 4; ++m) _Pragma("unroll") for (int k = 0; k < 2; ++k) dst[m][k] = *(const LAS bf16x8*)(lds + PG8_SA(b, h) + aoff + m * 2048 + k * 1024); } while (0)
#define PG8_LDB(dst, b, h) do { _Pragma("unroll") for (int n = 0; n < 2; ++n) _Pragma("unroll") for (int k = 0; k < 2; ++k) dst[n][k] = *(const LAS bf16x8*)(lds + PG8_SB(b, h) + boff + n * 2048 + k * 1024); } while (0)
#define PG8_MMA(ai, bj, At, Bt) do { __builtin_amdgcn_s_setprio(1); _Pragma("unroll") for (int m = 0; m < 4; ++m) _Pragma("unroll") for (int n = 0; n < 2; ++n) _Pragma("unroll") for (int k = 0; k < 2; ++k) \
        acc[ai][bj][m][n] = __builtin_amdgcn_mfma_f32_16x16x32_bf16(Bt[n][k], At[m][k], acc[ai][bj][m][n], 0, 0, 0); __builtin_amdgcn_s_setprio(0); } while (0)
#define PG8_WAIT_V(n) asm volatile("s_waitcnt vmcnt(" #n ")" ::: "memory")
#define PG8_WAIT_L(n) asm volatile("s_waitcnt lgkmcnt(" #n ")" ::: "memory")
#define PG8_BAR __builtin_amdgcn_s_barrier()
#define PG8_SCHED __builtin_amdgcn_sched_barrier(0)
    Unit cur, nxt; int ui = 0;
    if (!S.next(0, cur)) return;
    Acc acc;
#pragma unroll
    for (int a = 0; a < 2; ++a)
#pragma unroll
        for (int b = 0; b < 2; ++b)
#pragma unroll
            for (int m = 0; m < 4; ++m)
#pragma unroll
                for (int n = 0; n < 2; ++n) acc[a][b][m][n] = (f32x4){0.f, 0.f, 0.f, 0.f};
    bf16x8 At[4][2], B0[2][2], B1[2][2];
    const char* cA = S.baseA(cur, tstep); const char* cB = S.baseB(cur, tstep);
    PG8_STAGE(PG8_SB(0, 0), cB, voffB); PG8_STAGE(PG8_SB(0, 1), cB + hstep, voffB); PG8_STAGE(PG8_SA(0, 0), cA, voffA); PG8_STAGE(PG8_SA(0, 1), cA + hstep, voffA);
    if (wr == 1) PG8_BAR;
    PG8_WAIT_V(2); PG8_BAR;
    PG8_STAGE(PG8_SB(1, 0), cB + kstep, voffB); PG8_STAGE(PG8_SA(1, 0), cA + kstep, voffA); PG8_STAGE(PG8_SB(1, 1), cB + hstep + kstep, voffB);
    PG8_WAIT_V(6); PG8_BAR;
    for (;;) {
        const bool has_next = S.next(ui + 1, nxt);
        const char* nA = has_next ? S.baseA(nxt, tstep) : cA; const char* nB = has_next ? S.baseB(nxt, tstep) : cB;
        for (int t = 0; t < nt; t += 2) {
            const bool last = (t == nt - 2);
            const char* a1 = cA + (size_t)(t + 1) * kstep;
            const char* a2 = last ? nA : cA + (size_t)(t + 2) * kstep; const char* b2 = last ? nB : cB + (size_t)(t + 2) * kstep;
            const char* a3 = a2 + kstep; const char* b3 = b2 + kstep;
            PG8_LDB(B0, 0, 0); PG8_LDB(B1, 0, 1); PG8_SCHED; PG8_LDA(At, 0, 0); PG8_STAGE(PG8_SA(1, 1), a1 + hstep, voffA);
            PG8_WAIT_V(8); PG8_WAIT_L(0); PG8_BAR; PG8_MMA(0, 0, At, B0); PG8_MMA(0, 1, At, B1); PG8_BAR; PG8_SCHED;
            PG8_LDA(At, 0, 1); PG8_STAGE(PG8_SB(0, 0), b2, voffB); PG8_STAGE(PG8_SB(0, 1), b2 + hstep, voffB); PG8_STAGE(PG8_SA(0, 0), a2, voffA);
            PG8_WAIT_V(8); PG8_WAIT_L(0); PG8_BAR; PG8_MMA(1, 0, At, B0); PG8_MMA(1, 1, At, B1); PG8_BAR; PG8_SCHED;
            PG8_LDB(B0, 1, 0); PG8_LDB(B1, 1, 1); PG8_SCHED; PG8_LDA(At, 1, 0); PG8_STAGE(PG8_SA(0, 1), a2 + hstep, voffA);
            PG8_WAIT_V(8); PG8_WAIT_L(0); PG8_BAR; PG8_MMA(0, 0, At, B0); PG8_MMA(0, 1, At, B1); PG8_BAR; PG8_SCHED;
            PG8_LDA(At, 1, 1); PG8_STAGE(PG8_SB(1, 0), b3, voffB); PG8_STAGE(PG8_SB(1, 1), b3 + hstep, voffB); PG8_STAGE(PG8_SA(1, 0), a3, voffA);
            PG8_WAIT_V(8); PG8_WAIT_L(0); PG8_BAR; PG8_MMA(1, 0, At, B0); PG8_MMA(1, 1, At, B1); PG8_BAR; PG8_SCHED;
        }
        if (wr == 0) PG8_BAR;
        E(acc, cur, wr, wc, fr, fq);
        if (!has_next) break;
        if (!E.keep(cur)) {
#pragma unroll
            for (int a = 0; a < 2; ++a)
#pragma unroll
                for (int b = 0; b < 2; ++b)
#pragma unroll
                    for (int m = 0; m < 4; ++m)
#pragma unroll
                        for (int n = 0; n < 2; ++n) acc[a][b][m][n] = (f32x4){0.f, 0.f, 0.f, 0.f};
        }
        cur = nxt; cA = nA; cB = nB; ++ui;
        if (wr == 1) PG8_BAR;
    }
    PG8_WAIT_V(0);
    PG8_BAR;
#undef PG8_SA
#undef PG8_SB
#undef PG8_STAGE
#undef PG8_LDA
#undef PG8_LDB
#undef PG8_MMA
#undef PG8_WAIT_V
#undef PG8_WAIT_L
#undef PG8_BAR
#undef PG8_SCHED
}
}

struct Args {
    const float *x_prompt, *x_sample, *state_pool, *state_conv, *c_prompt, *c_sample, *w_ada, *b_ada, *w_in, *pool_grp_w, *pool_scale, *conv_w, *w_pool_up, *w_conv_up, *w_o,
        *ln1_g, *ln1_b, *w_ff1, *b_ff1, *w_ff2, *b_ff2, *ln2_g, *ln2_b;
    float* out; unsigned char* ws;
};

__device__ __forceinline__ float wave_sum(float v) {
#pragma unroll
    for (int o = 1; o < 64; o <<= 1) v += __shfl_xor(v, o);
    return v;
}

__device__ __forceinline__ void p0_transpose_item(const float* W, int K, int N, bf16_t* WT, LAS float* scr, int item, int lane) {
    const int nblk = N / 32, kb = item / nblk, nb = item % nblk, k0 = 64 * kb, n0 = 32 * nb;
    f32x4 v[8];
#pragma unroll
    for (int i = 0; i < 8; ++i) v[i] = __builtin_nontemporal_load((const f32x4*)(W + (size_t)(k0 + 8 * i + (lane >> 3)) * N + n0 + 4 * (lane & 7)));
#pragma unroll
    for (int i = 0; i < 8; ++i) { LAS float* d = scr + (8 * i + (lane >> 3)) * 33 + 4 * (lane & 7); d[0] = v[i][0]; d[1] = v[i][1]; d[2] = v[i][2]; d[3] = v[i][3]; }
    asm volatile("s_waitcnt lgkmcnt(0)" ::: "memory");
    const int c = lane & 7;
#pragma unroll
    for (int j = 0; j < 4; ++j) { const int n = (lane >> 3) + 8 * j; const LAS float* s = scr + (8 * c) * 33 + n;
        u32x4 o; o.x = pk2(s[0 * 33], s[1 * 33]); o.y = pk2(s[2 * 33], s[3 * 33]); o.z = pk2(s[4 * 33], s[5 * 33]); o.w = pk2(s[6 * 33], s[7 * 33]);
        *(u32x4*)(WT + (size_t)(n0 + n) * K + k0 + 8 * c) = o; }
    asm volatile("s_waitcnt lgkmcnt(0)" ::: "memory");
}

__device__ __forceinline__ void p0_ada_item(const Args& a, float* ada, LAS unsigned char* lds, int item, int wave, int lane) {
    const int n0 = item * 48, fr = lane & 15, kq = lane >> 4;
    f32x4 acc[9][3];
#pragma unroll
    for (int mt = 0; mt < 9; ++mt)
#pragma unroll
        for (int q = 0; q < 3; ++q) acc[mt][q] = (f32x4){0.f, 0.f, 0.f, 0.f};
    const float* const cr0 = fr < NB ? a.c_prompt + (size_t)fr * D : a.c_sample + (size_t)(fr - NB) * D;
    const float* const crm = a.c_sample + (size_t)(fr + 12) * D;
    const float* const cr8 = a.c_sample + (size_t)(124 + fr > NS - 1 ? NS - 1 : 124 + fr) * D;
#pragma unroll 2
    for (int ks = 0; ks < 8; ++ks) {
        const int k0 = wave * 256 + ks * 32 + kq * 8;
        float b[8][3];
#pragma unroll
        for (int j = 0; j < 8; ++j) { const float* p = a.w_ada + (size_t)(k0 + j) * NADA + n0 + 3 * fr; b[j][0] = __builtin_nontemporal_load(p); b[j][1] = __builtin_nontemporal_load(p + 1); b[j][2] = __builtin_nontemporal_load(p + 2); }
        bf16x8 bfr[3];
#pragma unroll
        for (int q = 0; q < 3; ++q) { u32x4 w; w.x = pk2(b[0][q], b[1][q]); w.y = pk2(b[2][q], b[3][q]); w.z = pk2(b[4][q], b[5][q]); w.w = pk2(b[6][q], b[7][q]); bfr[q] = __builtin_bit_cast(bf16x8, w); }
#pragma unroll
        for (int mt = 0; mt < 9; ++mt) {
            const float* cp = (mt == 0) ? cr0 : (mt == 8 ? cr8 : crm + (size_t)(mt - 1) * 16 * D);
            const f32x4 a0 = *(const f32x4*)(cp + k0), a1 = *(const f32x4*)(cp + k0 + 4);
            u32x4 w; w.x = pk2(a0[0], a0[1]); w.y = pk2(a0[2], a0[3]); w.z = pk2(a1[0], a1[1]); w.w = pk2(a1[2], a1[3]);
            const bf16x8 af = __builtin_bit_cast(bf16x8, w);
#pragma unroll
            for (int q = 0; q < 3; ++q) acc[mt][q] = __builtin_amdgcn_mfma_f32_16x16x32_bf16(af, bfr[q], acc[mt][q], 0, 0, 0);
            if (mt % 3 == 2) asm volatile("" ::: "memory");
        }
    }
    LAS float* red = (LAS float*)lds;
#pragma unroll
    for (int s = 4; s >= 1; s >>= 1) {
        if (wave >= s && wave < 2 * s) { LAS float* dst = red + (wave - s) * 6912 + lane;
#pragma unroll
            for (int mt = 0; mt < 9; ++mt)
#pragma unroll
                for (int q = 0; q < 3; ++q)
#pragma unroll
                    for (int j = 0; j < 4; ++j) dst[((mt * 3 + q) * 4 + j) * 64] = acc[mt][q][j]; }
        __syncthreads();
        if (wave < s) { const LAS float* src = red + wave * 6912 + lane;
#pragma unroll
            for (int mt = 0; mt < 9; ++mt)
#pragma unroll
                for (int q = 0; q < 3; ++q)
#pragma unroll
                    for (int j = 0; j < 4; ++j) acc[mt][q][j] += src[((mt * 3 + q) * 4 + j) * 64]; }
        __syncthreads();
    }
    if (wave == 0) {
#pragma unroll
        for (int q = 0; q < 3; ++q) { const int n = n0 + 3 * fr + q; const float bb = a.b_ada[n];
#pragma unroll
            for (int mt = 0; mt < 9; ++mt)
#pragma unroll
                for (int j = 0; j < 4; ++j) { const int r = mt * 16 + kq * 4 + j; if (r < NCOND) ada[(size_t)r * NADAP + item * 64 + 3 * fr + q] = acc[mt][q][j] + bb; } }
    }
}

__device__ __forceinline__ void p0_weff_item(const Args& a, bf16_t* WT, LAS unsigned char* lds, int item, int tid) {
    constexpr int AP = 260, BP = 80;
    const int g = item >> 7, it = (item >> 5) & 3, nt = item & 31, i0 = it * 64, n0 = nt * 64;
    LAS float* As = (LAS float*)lds;
    LAS float* Bs = (LAS float*)(lds + 66560);
#pragma unroll
    for (int r = 0; r < 8; ++r) { const int idx = tid + r * 512, row = idx >> 6, c4 = idx & 63;
        *(LAS f32x4*)(As + row * AP + c4 * 4) = *(const f32x4*)(a.pool_grp_w + ((size_t)(g * 256 + i0 + row)) * 256 + c4 * 4); }
    const int lane = tid & 63, wave = tid >> 6, fr = lane & 15, kq = lane >> 4, mt = wave >> 1, np = (wave & 1) * 2;
    f32x4 acc[2] = {(f32x4){0.f, 0.f, 0.f, 0.f}, (f32x4){0.f, 0.f, 0.f, 0.f}};
#pragma unroll 1
    for (int h = 0; h < 2; ++h) {
        __syncthreads();
#pragma unroll
        for (int r = 0; r < 4; ++r) { const int idx = tid + r * 512, o = idx >> 4, c4 = idx & 15;
            const float sc = a.pool_scale[g * 256 + h * 128 + o];
            *(LAS f32x4*)(Bs + o * BP + c4 * 4) = *(const f32x4*)(a.w_pool_up + (size_t)(g * 256 + h * 128 + o) * D + n0 + c4 * 4) * sc; }
        __syncthreads();
#pragma unroll 8
        for (int o4 = 0; o4 < 32; ++o4) {
            const float av = As[(mt * 16 + fr) * AP + h * 128 + o4 * 4 + kq];
            const float b0 = Bs[(o4 * 4 + kq) * BP + np * 16 + fr], b1 = Bs[(o4 * 4 + kq) * BP + np * 16 + 16 + fr];
            acc[0] = __builtin_amdgcn_mfma_f32_16x16x4f32(av, b0, acc[0], 0, 0, 0);
            acc[1] = __builtin_amdgcn_mfma_f32_16x16x4f32(av, b1, acc[1], 0, 0, 0);
        }
    }
#pragma unroll
    for (int t = 0; t < 2; ++t)
        *(u32x2*)(WT + (size_t)(n0 + (np + t) * 16 + fr) * PW + g * 256 + i0 + mt * 16 + kq * 4) = (u32x2){pk2(acc[t][0], acc[t][1]), pk2(acc[t][2], acc[t][3])};
    __syncthreads();
}

__device__ __forceinline__ void p1_modulate(const Args& a, const float* ada, bf16_t* U, int gw, int NGW, int lane) {
    if (NGW >= 2 * 8 * NS && (gw & 1) == 0 && (gw >> 1) < 8 * NS) {
        const int r = MP + (gw >> 4), c = ((gw >> 1) & 7) * 256 + 4 * lane;
        const float* ar = ada + (size_t)cond_row(r) * NADAP;
        const f32x4 v = *(const f32x4*)(a.x_sample + (size_t)(r - MP) * D + c) * (*(const f32x4*)(ar + adac(D + c)) + 1.f) + *(const f32x4*)(ar + adac(c));
        *(u32x2*)(U + (size_t)r * D + c) = (u32x2){pk2(v[0], v[1]), pk2(v[2], v[3])};
    }
    for (int r = gw; r < (NGW >= 2 * 8 * NS ? MP : MV); r += NGW) {
        u32x2* o8 = (u32x2*)(U + (size_t)r * D) + lane;
        const f32x4* xr = (const f32x4*)x_rowp(a.x_prompt, a.x_sample, r) + lane;
        const float* ar = ada + (size_t)cond_row(r) * NADAP;
#pragma unroll
        for (int j = 0; j < 8; ++j) { const int c = 4 * (lane + 64 * j); const f32x4 v = __builtin_nontemporal_load(xr + 64 * j) * (*(const f32x4*)(ar + adac(D + c)) + 1.f) + *(const f32x4*)(ar + adac(c));
            o8[64 * j] = (u32x2){pk2(v[0], v[1]), pk2(v[2], v[3])}; }
    }
}

__device__ __forceinline__ void p3_mixer(const Args& a, const bf16_t* proj, bf16_t* PRE, bf16_t* CIN, int tid) {
    const int j0 = 2 * tid, wave = tid >> 6, W = 2 << (wave >> 1);
    const f32x2 cw0 = *(const f32x2*)(a.conv_w + j0), cw1 = *(const f32x2*)(a.conv_w + CW + j0), cw2 = *(const f32x2*)(a.conv_w + 2 * CW + j0);
    float* const npp = a.out + O_NPP; float* const ncp = a.out + O_NCP; float* const nps = a.out + O_NPS; float* const ncs = a.out + O_NCS;
    for (int it = blockIdx.x; it < 384; it += gridDim.x) {
        if (it < 256) {
            const int b = it >> 6, q0 = 4 * (tid & 255), sA = (it & 63) * 32 + 16 * (tid >> 8), Wq = 2 << ((tid >> 6) & 3);
            const bf16_t* pb = proj + (size_t)(b * SEQ) * INW + q0;
            const f32x4 c0 = *(const f32x4*)(a.conv_w + q0), c1 = *(const f32x4*)(a.conv_w + CW + q0), c2 = *(const f32x4*)(a.conv_w + 2 * CW + q0);
            f32x4 S = (f32x4){0.f, 0.f, 0.f, 0.f}, v1 = S, v2 = S;
#define UNPK4(w) ((f32x4){bflo((w).x), bfhi((w).x), bflo((w).y), bfhi((w).y)})
            for (int i = 1; i < Wq; ++i) { const int sp = sA - i; if (sp >= 0) { const u32x2 w = *(const u32x2*)(pb + (size_t)sp * INW); S += UNPK4(w); } }
            if (sA >= 1) { const bf16_t* pp = pb + (size_t)(sA - 1) * INW; const u32x2 wx = *(const u32x2*)(pp + 1024), wc = *(const u32x2*)(pp + 3072); v1 = UNPK4(wc) * UNPK4(wx); }
            if (sA >= 2) { const bf16_t* pp = pb + (size_t)(sA - 2) * INW; const u32x2 wx = *(const u32x2*)(pp + 1024), wc = *(const u32x2*)(pp + 3072); v2 = UNPK4(wc) * UNPK4(wx); }
#pragma unroll 4
            for (int sq = sA; sq < sA + 16; ++sq) {
                const bf16_t* pp = pb + (size_t)sq * INW;
                const u32x2 wz = *(const u32x2*)pp, wx = *(const u32x2*)(pp + 1024), wb = *(const u32x2*)(pp + 2048), wc = *(const u32x2*)(pp + 3072);
                const f32x4 z = UNPK4(wz);
                S += z;
                const int cnt = (sq + 1 < Wq) ? sq + 1 : Wq; const float fcn = (float)cnt;
                const f32x4 pl = S / fcn - z;
                const int so = sq - Wq + 1;
                if (so >= 0) { const u32x2 wo = *(const u32x2*)(pb + (size_t)so * INW); S -= UNPK4(wo); }
                const f32x4 vv = UNPK4(wc) * UNPK4(wx);
                const f32x4 y = c0 * v2 + c1 * v1 + c2 * vv, ci = UNPK4(wb) * y;
                const size_t row = (size_t)(b * SEQ + sq);
                *(u32x2*)(PRE + row * PW + q0) = (u32x2){pk2(pl[0], pl[1]), pk2(pl[2], pl[3])};
                *(u32x2*)(CIN + row * CW + q0) = (u32x2){pk2(ci[0], ci[1]), pk2(ci[2], ci[3])};
                if (sq >= SEQ - 15) *(f32x4*)(npp + ((size_t)(b * 15 + sq - (SEQ - 15))) * PW + q0) = z;
                if (sq >= SEQ - 2) *(f32x4*)(ncp + ((size_t)(b * 2 + sq - (SEQ - 2))) * CW + q0) = vv;
                v2 = v1; v1 = vv;
            }
#undef UNPK4
        } else {
            const int b = it - 256; const size_t row = (size_t)(MP + b);
            const bf16_t* p = proj + row * INW + j0;
            const unsigned wz = *(const unsigned*)p, wx = *(const unsigned*)(p + 1024), wb = *(const unsigned*)(p + 2048), wc = *(const unsigned*)(p + 3072);
            const float z0 = bflo(wz), z1 = bfhi(wz);
            const float* sp = a.state_pool + (size_t)b * 15 * PW + j0;
            float S0 = z0, S1 = z1;
            for (int i = 1; i < W; ++i) { const f32x2 h = *(const f32x2*)(sp + (size_t)(15 - i) * PW); S0 += h[0]; S1 += h[1]; }
            const float fc = (float)W;
            *(unsigned*)(PRE + row * PW + j0) = pk2(S0 / fc - z0, S1 / fc - z1);
            const f32x2 h0 = *(const f32x2*)(a.state_conv + (size_t)(b * 2) * CW + j0), h1 = *(const f32x2*)(a.state_conv + (size_t)(b * 2 + 1) * CW + j0);
            const float va = bflo(wc) * bflo(wx), vb = bfhi(wc) * bfhi(wx);
            const float ya = cw0[0] * h0[0] + cw1[0] * h1[0] + cw2[0] * va, yb = cw0[1] * h0[1] + cw1[1] * h1[1] + cw2[1] * vb;
            *(unsigned*)(CIN + row * CW + j0) = pk2(bflo(wb) * ya, bfhi(wb) * yb);
#pragma unroll
            for (int r = 0; r < 14; ++r) *(f32x2*)(nps + ((size_t)(b * 15 + r)) * PW + j0) = *(const f32x2*)(sp + (size_t)(r + 1) * PW);
            *(f32x2*)(nps + ((size_t)(b * 15 + 14)) * PW + j0) = (f32x2){z0, z1};
            *(f32x2*)(ncs + ((size_t)(b * 2)) * CW + j0) = h1;
            *(f32x2*)(ncs + ((size_t)(b * 2 + 1)) * CW + j0) = (f32x2){va, vb};
        }
    }
}

__device__ __forceinline__ void ln_row(f32x4 (&v)[8], const f32x4 (&g4)[8], const f32x4 (&b4)[8]) {
    float s = 0.f;
#pragma unroll
    for (int j = 0; j < 8; ++j) s += (v[j][0] + v[j][1]) + (v[j][2] + v[j][3]);
    const float mean = wave_sum(s) * (1.f / D); float s2 = 0.f;
#pragma unroll
    for (int j = 0; j < 8; ++j) { v[j] = v[j] - mean; s2 += (v[j][0] * v[j][0] + v[j][1] * v[j][1]) + (v[j][2] * v[j][2] + v[j][3] * v[j][3]); }
    const float rstd = 1.f / sqrtf(wave_sum(s2) * (1.f / D) + LN_EPS);
#pragma unroll
    for (int j = 0; j < 8; ++j) v[j] = v[j] * rstd * g4[j] + b4[j];
}
__device__ __forceinline__ void p6_ln1(const Args& a, const float* ada, float* res, const float* part, bf16_t* U, int gw, int NGW, int lane) {
    f32x4 lg[8], lb[8];
#pragma unroll
    for (int j = 0; j < 8; ++j) { lg[j] = ((const f32x4*)a.ln1_g + lane)[64 * j]; lb[j] = ((const f32x4*)a.ln1_b + lane)[64 * j]; }
    for (int r = gw, nr; r >= 0; r = nr) { nr = -1; if (r < MP) { nr = r + NGW; if (nr >= MP) nr = ((gw & 15) == 0 && (gw >> 4) < NS && NGW >= 16 * NS) ? MP + (gw >> 4) : ((NGW >= 16 * NS) ? -1 : (nr < MV ? nr : -1)); } else if (NGW < 16 * NS) { nr = r + NGW; if (nr >= MV) nr = -1; }
        u32x2* o8 = (u32x2*)(U + (size_t)r * D) + lane;
        f32x4* rr = (f32x4*)(res + (size_t)r * D) + lane;
        const float* ar = ada + (size_t)cond_row(r) * NADAP;
        f32x4 v[8];
        if (r < MP) {
#pragma unroll
            for (int j = 0; j < 8; ++j) v[j] = rr[64 * j];
        } else {
            const f32x4* xr = (const f32x4*)(a.x_sample + (size_t)(r - MP) * D) + lane;
#pragma unroll
            for (int j = 0; j < 8; ++j) { f32x4 sum = (f32x4){0.f, 0.f, 0.f, 0.f};
#pragma unroll
                for (int sl = 0; sl < 8; ++sl) sum += ((const f32x4*)(part + ((size_t)sl * NS + (r - MP)) * D) + lane)[64 * j];
                v[j] = xr[64 * j] * ALPHA + *(const f32x4*)(ar + adac(2 * D + 4 * (lane + 64 * j))) * sum; }
        }
        ln_row(v, lg, lb);
#pragma unroll
        for (int j = 0; j < 8; ++j) { const int c = 4 * (lane + 64 * j); rr[64 * j] = v[j]; const f32x4 t = v[j] * (*(const f32x4*)(ar + adac(4 * D + c)) + 1.f) + *(const f32x4*)(ar + adac(3 * D + c));
            o8[64 * j] = (u32x2){pk2(t[0], t[1]), pk2(t[2], t[3])}; }
    }
}
__device__ __forceinline__ void p9_ln2(const Args& a, const float* ada, const float* res, const float* part, int gw, int NGW, int lane) {
    f32x4 lg[8], lb[8];
#pragma unroll
    for (int j = 0; j < 8; ++j) { lg[j] = ((const f32x4*)a.ln2_g + lane)[64 * j]; lb[j] = ((const f32x4*)a.ln2_b + lane)[64 * j]; }
    for (int r = gw, nr; r >= 0; r = nr) { nr = -1; if (r < MP) { nr = r + NGW; if (nr >= MP) nr = ((gw & 15) == 0 && (gw >> 4) < NS && NGW >= 16 * NS) ? MP + (gw >> 4) : ((NGW >= 16 * NS) ? -1 : (nr < MV ? nr : -1)); } else if (NGW < 16 * NS) { nr = r + NGW; if (nr >= MV) nr = -1; }
        const f32x4* rr = (const f32x4*)(res + (size_t)r * D) + lane;
        f32x4 v[8];
#pragma unroll
        for (int j = 0; j < 8; ++j) v[j] = rr[64 * j];
        if (r >= MP) {
            const float* ar = ada + (size_t)cond_row(r) * NADAP;
#pragma unroll
            for (int j = 0; j < 8; ++j) { f32x4 sum = *((const f32x4*)a.b_ff2 + lane + 64 * j);
#pragma unroll
                for (int sl = 0; sl < 8; ++sl) sum += ((const f32x4*)(part + ((size_t)sl * NS + (r - MP)) * D) + lane)[64 * j];
                v[j] = v[j] * ALPHA + *(const f32x4*)(ar + adac(5 * D + 4 * (lane + 64 * j))) * sum; }
        }
        ln_row(v, lg, lb);
        f32x4* o = (f32x4*)(a.out + (r < MP ? O_YP + (size_t)r * D : O_YS + (size_t)(r - MP) * D)) + lane;
#pragma unroll
        for (int j = 0; j < 8; ++j) o[64 * j] = v[j];
    }
}

typedef f32x4 Acc128[4][2];
__device__ __forceinline__ void gemm128_core(Acc128& acc, LAS unsigned char* lds, const bf16_t* A, const bf16_t* Bt, const int K  , const int klen  ) {
    using namespace pg8;
    const int tid = threadIdx.x, wid = __builtin_amdgcn_readfirstlane(tid >> 6), lane = tid & 63, wr = wid >> 2, wc = wid & 3, fr = lane & 15, fq = lane >> 4;
    const int nt = klen / 64;
    unsigned voff[2];
#pragma unroll
    for (int i = 0; i < 2; ++i) { int R, C; stage_rc(tid * 16 + i * 8192, R, C); voff[i] = (unsigned)(R * K + C) * 2u; }
    const unsigned ldsw = (unsigned)wid * 1024u;
    const int aoff = lds_byte(wr * 64 + fr, fq * 8), boff = lds_byte(wc * 32 + fr, fq * 8);
    const char* pa = (const char*)A; const char* pb = (const char*)Bt;
#define G128_STAGE(st, kt) do { _Pragma("unroll") for (int _i = 0; _i < 2; ++_i) { \
        __builtin_amdgcn_global_load_lds((const unsigned*)(pa + (size_t)(kt) * 128 + voff[_i]), (LAS unsigned*)(lds + (st) * 32768 + ldsw + _i * 8192), 16, 0, 0); \
        __builtin_amdgcn_global_load_lds((const unsigned*)(pb + (size_t)(kt) * 128 + voff[_i]), (LAS unsigned*)(lds + (st) * 32768 + 16384 + ldsw + _i * 8192), 16, 0, 0); } } while (0)
    G128_STAGE(0, 0); G128_STAGE(1, 1 < nt ? 1 : nt - 1); G128_STAGE(2, 2 < nt ? 2 : nt - 1);
#pragma unroll 1
    for (int t = 0; t < nt; ++t) {
        asm volatile("s_waitcnt vmcnt(8)" ::: "memory");
        __builtin_amdgcn_s_barrier();
        asm volatile("" ::: "memory");
        { const int kt = t + 3 < nt ? t + 3 : nt - 1; G128_STAGE((t + 3) & 3, kt); }
        const LAS unsigned char* sa = lds + (t & 3) * 32768; const LAS unsigned char* sb = sa + 16384;
        bf16x8 af[4][2], bfr[2][2];
#pragma unroll
        for (int m = 0; m < 4; ++m)
#pragma unroll
            for (int k = 0; k < 2; ++k) af[m][k] = *(const LAS bf16x8*)(sa + aoff + m * 2048 + k * 1024);
#pragma unroll
        for (int n = 0; n < 2; ++n)
#pragma unroll
            for (int k = 0; k < 2; ++k) bfr[n][k] = *(const LAS bf16x8*)(sb + boff + n * 2048 + k * 1024);
#pragma unroll
        for (int m = 0; m < 4; ++m)
#pragma unroll
            for (int n = 0; n < 2; ++n)
#pragma unroll
                for (int k = 0; k < 2; ++k) acc[m][n] = __builtin_amdgcn_mfma_f32_16x16x32_bf16(bfr[n][k], af[m][k], acc[m][n], 0, 0, 0);
        asm volatile("s_waitcnt lgkmcnt(0)" ::: "memory");
    }
    asm volatile("s_waitcnt vmcnt(0)" ::: "memory");
    __builtin_amdgcn_s_barrier();
    asm volatile("" ::: "memory");
#undef G128_STAGE
}
__device__ __forceinline__ void zero128(Acc128& acc) {
#pragma unroll
    for (int m = 0; m < 4; ++m)
#pragma unroll
        for (int n = 0; n < 2; ++n) acc[m][n] = (f32x4){0.f, 0.f, 0.f, 0.f};
}
template <int MODE>
__device__ __forceinline__ void sample_gemm(const Args& a, LAS unsigned char* lds, const bf16_t* A0, const bf16_t* B0, const bf16_t* A1, const bf16_t* B1, const int K, const int N,
                                            const bf16_t* proj, bf16_t* Ob, float* res, const float* ada) {
    const int tid = threadIdx.x, wid = __builtin_amdgcn_readfirstlane(tid >> 6), lane = tid & 63, wr = wid >> 2, wc = wid & 3, fr = lane & 15, fq = lane >> 4;
    constexpr int NSL = (MODE >= 3) ? 8 : 1;
    for (int unit = blockIdx.x; unit < (N / 128) * NSL; unit += gridDim.x) {
        const int n0 = (unit / NSL) * 128, sl = unit % NSL, klen = K / NSL;
        Acc128 acc, acc2;
        zero128(acc);
        gemm128_core(acc, lds, A0 + (size_t)MP * K + sl * klen, B0 + (size_t)n0 * K + sl * klen, K, klen);
        if (MODE == 2) { zero128(acc2); gemm128_core(acc2, lds, A1 + (size_t)MP * K, B1 + (size_t)n0 * K, K, K); }
#pragma unroll
        for (int m = 0; m < 4; ++m) { const int ms = wr * 64 + m * 16 + fr; const size_t row = (size_t)(MP + ms);
#pragma unroll
            for (int n = 0; n < 2; ++n) { const int c = n0 + wc * 32 + n * 16 + 4 * fq; f32x4 v = acc[m][n];
                if (MODE == 0) { *(u32x2*)(Ob + row * INW + c) = (u32x2){pk2(v[0], v[1]), pk2(v[2], v[3])}; }
                else if (MODE == 1) { v = v + *(const f32x4*)(a.b_ff1 + c);
#pragma unroll
                    for (int j = 0; j < 4; ++j) { const float r = fmaxf(v[j], 0.f); v[j] = r * r; }
                    *(u32x2*)(Ob + row * DFF + c) = (u32x2){pk2(v[0], v[1]), pk2(v[2], v[3])}; }
                else if (MODE == 2) {
                    const u32x2 gpw = *(const u32x2*)(proj + row * INW + 4096 + c), gcw = *(const u32x2*)(proj + row * INW + 6144 + c);
                    const float gp[4] = {bflo(gpw.x), bfhi(gpw.x), bflo(gpw.y), bfhi(gpw.y)}, gc[4] = {bflo(gcw.x), bfhi(gcw.x), bflo(gcw.y), bfhi(gcw.y)};
                    float o[4];
#pragma unroll
                    for (int j = 0; j < 4; ++j) o[j] = v[j] / (1.f + __expf(-gp[j])) + acc2[m][n][j] / (1.f + __expf(-gc[j]));
                    *(u32x2*)(Ob + row * D + c) = (u32x2){pk2(o[0], o[1]), pk2(o[2], o[3])}; }
                else { *(f32x4*)(res + ((size_t)sl * NS + ms) * D + c) = v; }
            } }
    }
}

#define XB_TMO      128
#define XB_XCNT(j)  (256  + 64 * (j))
#define XB_XSUB(j)  (1280 + 64 * (j))
#define XB_XGEN(j)  (2304 + 64 * (j))
#define XB_TOP      3328
#define XB_TOPGEN   3392
#define XCD_BAR_WORDS 3456
#define XB_SPIN_CAP (1u << 18)
__device__ __forceinline__ unsigned xb_ld(unsigned* p)              { return __hip_atomic_load(p, __ATOMIC_RELAXED, __HIP_MEMORY_SCOPE_AGENT); }
__device__ __forceinline__ unsigned xb_add(unsigned* p, unsigned v) { return __hip_atomic_fetch_add(p, v, __ATOMIC_RELAXED, __HIP_MEMORY_SCOPE_AGENT); }
__device__ __forceinline__ unsigned xb_xcc_id() { return (unsigned)__builtin_amdgcn_s_getreg((3 << 11) | 20) & 0xFu; }
#define XB_SPIN(cond, bar) do { unsigned _sp = 0; while (cond) { __builtin_amdgcn_s_sleep(1); \
    if ((++_sp & 255u) == 0u) { if (xb_ld(&(bar)[XB_TMO])) break; if (_sp > XB_SPIN_CAP) { atomicAdd(&(bar)[XB_TMO], 1u); break; } } } } while (0)
struct XcdBarrier { unsigned* bar; unsigned x; volatile LAS unsigned* st; };
__device__ __forceinline__ XcdBarrier xcd_barrier_post(unsigned* bar, volatile LAS unsigned* st) {
    XcdBarrier b; b.bar = bar; b.x = xb_xcc_id(); b.st = st;
    if (threadIdx.x == 0) (void)xb_add(&bar[XB_XCNT(b.x)], 1u);
    return b;
}
__device__ __forceinline__ void xcd_barrier_complete(unsigned* bar, unsigned x, unsigned& nloc, unsigned& nx) {
    const unsigned G = gridDim.x * gridDim.y * gridDim.z;
    unsigned sum, cnt, mine, sp = 0u;
    for (;;) {
        sum = 0u; cnt = 0u; mine = 0u;
#pragma unroll
        for (unsigned j = 0; j < 16; ++j) { const unsigned c = xb_ld(&bar[XB_XCNT(j)]); sum += c; cnt += (c > 0u) ? 1u : 0u; mine = (j == x) ? c : mine; }
        if (sum == G) break;
        __builtin_amdgcn_s_sleep(1);
        if ((++sp & 255u) == 0u) { if (xb_ld(&bar[XB_TMO])) break; if (sp > XB_SPIN_CAP) { atomicAdd(&bar[XB_TMO], 1u); break; } }
    }
    nloc = mine > 0u ? mine : 1u; nx = cnt > 0u ? cnt : 1u;
}
__device__ __forceinline__ void xcd_barrier(const XcdBarrier& b) {
    asm volatile("s_waitcnt vmcnt(0)" ::: "memory");
    __syncthreads();
    if (threadIdx.x == 0) {
        unsigned* bar = b.bar;
        __builtin_amdgcn_s_waitcnt(0);
        unsigned nloc = b.st[0], nx = b.st[1];
        if (nloc == 0u) { xcd_barrier_complete(bar, b.x, nloc, nx); b.st[0] = nloc; b.st[1] = nx; }
        const unsigned old = xb_add(&bar[XB_XSUB(b.x)], 1u);
        const unsigned gen = old / nloc;
        if (old + 1u == (gen + 1u) * nloc) {
            __builtin_amdgcn_fence(__ATOMIC_RELEASE, "agent");
            asm volatile("s_waitcnt vmcnt(0)" ::: "memory");
            const unsigned og = xb_add(&bar[XB_TOP], 1u);
            const unsigned tg = og / nx;
            if (og + 1u == (tg + 1u) * nx) xb_add(&bar[XB_TOPGEN], 1u);
            else XB_SPIN(xb_ld(&bar[XB_TOPGEN]) == tg, bar);
            __builtin_amdgcn_fence(__ATOMIC_ACQUIRE, "agent");
            xb_add(&bar[XB_XGEN(b.x)], 1u);
            asm volatile("s_waitcnt vmcnt(0)" ::: "memory");
        } else {
            XB_SPIN(xb_ld(&bar[XB_XGEN(b.x)]) == gen, bar);
            __builtin_amdgcn_fence(__ATOMIC_ACQUIRE, "agent");
            asm volatile("s_waitcnt vmcnt(0)" ::: "memory");
        }
    }
    __syncthreads();
}

constexpr int TB_O = (D / 64) * (INW / 32), TB_C = TB_O + (D / 64) * (D / 32), TB_F1 = TB_C + (CW / 64) * (D / 32), TB_F2 = TB_F1 + (D / 64) * (DFF / 32), TB_END = TB_F2 + (DFF / 64) * (D / 32);
static_assert(TB_O == 8192 && TB_C == 10240 && TB_F1 == 11264 && TB_F2 == 19456 && TB_END == 27648, "item list");
constexpr int TB_F2H = TB_F2 + (TB_END - TB_F2) / 2;
__device__ __forceinline__ void tr_range(const Args& a, LAS unsigned char* lds, int lo1, int n1, int lo2, int n2, int widx, int nw, int wave, int lane) {
    unsigned char* ws = a.ws;
    bf16_t* WinT = (bf16_t*)(ws + WS_WIN); bf16_t* Wff1T = (bf16_t*)(ws + WS_WFF1); bf16_t* Wff2T = (bf16_t*)(ws + WS_WFF2); bf16_t* WoT = (bf16_t*)(ws + WS_WO); bf16_t* WupC = (bf16_t*)(ws + WS_WUPC);
    LAS float* scr = (LAS float*)(lds + wave * 16384);
    for (int v = widx; v < n1 + n2; v += nw) {
        int r = v < n1 ? lo1 + v : lo2 + (v - n1);
        if (r < TB_O) { p0_transpose_item(a.w_in, D, INW, WinT, scr, r, lane); continue; } r -= TB_O;
        if (r < TB_C - TB_O) { p0_transpose_item(a.w_o, D, D, WoT, scr, r, lane); continue; } r -= TB_C - TB_O;
        if (r < TB_F1 - TB_C) { p0_transpose_item(a.w_conv_up, CW, D, WupC, scr, r, lane); continue; } r -= TB_F1 - TB_C;
        if (r < TB_F2 - TB_F1) { p0_transpose_item(a.w_ff1, D, DFF, Wff1T, scr, r, lane); continue; } r -= TB_F2 - TB_F1;
        p0_transpose_item(a.w_ff2, DFF, D, Wff2T, scr, r, lane);
    }
}
__device__ __forceinline__ void tr_tail(const Args& a, LAS unsigned char* lds, int lo, int n, int nunits, int wave, int lane) {
    const int G = gridDim.x, bx = blockIdx.x, ns = nunits < G ? nunits : 0;
    if (bx >= ns) tr_range(a, lds, lo, n, 0, 0, (bx - ns) * 8 + wave, (G - ns) * 8, wave, lane);
}
__device__ __forceinline__ void p0_all(const Args& a, LAS unsigned char* lds, int tid, int lane, int wave, int bx, int G) {
    unsigned char* ws = a.ws;
    float* ada = (float*)(ws + WS_ADA);
    bf16_t* WupP = (bf16_t*)(ws + WS_WUPP);
    const int gw = bx * 8 + wave, NGW = G * 8;
    if (bx & 1) {
    tr_range(a, lds, 0, TB_O, TB_F2H, TB_END - TB_F2H, gw, NGW, wave, lane);
    __syncthreads();
    for (int it = bx; it < NADA / 48; it += G) p0_ada_item(a, ada, lds, it, wave, lane);
    for (int it = bx; it < 512; it += G) p0_weff_item(a, WupP, lds, it, tid);
    } else {
    for (int it = bx; it < NADA / 48; it += G) p0_ada_item(a, ada, lds, it, wave, lane);
    for (int it = bx; it < 512; it += G) p0_weff_item(a, WupP, lds, it, tid);
    tr_range(a, lds, 0, TB_O, TB_F2H, TB_END - TB_F2H, gw, NGW, wave, lane);
    }
}

__global__ void __launch_bounds__(512, 2) fwd_megakernel(Args a) {
    extern __shared__ __attribute__((aligned(16))) unsigned char lds_raw[];
    LAS unsigned char* lds = (LAS unsigned char*)lds_raw;
    const int tid = threadIdx.x, lane = tid & 63, wave = __builtin_amdgcn_readfirstlane(tid >> 6);
    const int G = gridDim.x, bx = blockIdx.x;
    const int gw = bx * 8 + wave, NGW = G * 8;
    unsigned char* ws = a.ws;
    float* ada = (float*)(ws + WS_ADA);
    unsigned* ctr = (unsigned*)(ws + WS_CTL);
    if (tid < 64) ((LAS unsigned*)(lds + MISC_OFF))[tid] = 0u;
    __syncthreads();
    const XcdBarrier xbar = xcd_barrier_post(ctr, (volatile LAS unsigned*)(lds + MISC_OFF));
#define GB() xcd_barrier(xbar)
    bf16_t* WinT = (bf16_t*)(ws + WS_WIN); bf16_t* Wff1T = (bf16_t*)(ws + WS_WFF1); bf16_t* Wff2T = (bf16_t*)(ws + WS_WFF2); bf16_t* WoT = (bf16_t*)(ws + WS_WO);
    bf16_t* WupP = (bf16_t*)(ws + WS_WUPP); bf16_t* WupC = (bf16_t*)(ws + WS_WUPC);
    bf16_t* U = (bf16_t*)(ws + WS_U); bf16_t* PROJ = (bf16_t*)(ws + WS_PROJ); float* RES = (float*)(ws + WS_RES);
    float* PART = (float*)(ws + WS_PART);
    bf16_t* PRE = (bf16_t*)(ws + WS_RES); bf16_t* CIN = (bf16_t*)(ws + WS_RES + WS_CIN_OFF);

    p0_all(a, lds, tid, lane, wave, bx, G);
    GB();
    p1_modulate(a, ada, U, gw, NGW, lane);
    GB();
    { pg8::Order S; S.init(MP, INW, G, bx, 1, U, WinT, U, WinT);
      pg8::EpiBf16<0> E{PROJ, INW, nullptr};
      pg8::gemm_phase(lds, D, S, E); }
    sample_gemm<0>(a, lds, U, WinT, U, WinT, D, INW, PROJ, PROJ, RES, ada);
    tr_tail(a, lds, TB_O, TB_F1 - TB_O, INW / 128, wave, lane);
    GB();
    p3_mixer(a, PROJ, PRE, CIN, tid);
    GB();
    { pg8::Order S; S.init(MP, D, G, bx, 2, PRE, WupP, CIN, WupC);
      pg8::EpiGate E{PROJ, U};
      pg8::gemm_phase(lds, PW, S, E); }
    sample_gemm<2>(a, lds, PRE, WupP, CIN, WupC, PW, D, PROJ, U, RES, ada);
    tr_tail(a, lds, TB_F1, TB_F2 - TB_F1, D / 128, wave, lane);
    GB();
    { pg8::Order S; S.init(MP, D, G, bx, 1, U, WoT, U, WoT);
      pg8::EpiRes E{RES, a.x_prompt, ada, 2 * D, nullptr};
      pg8::gemm_phase(lds, D, S, E); }
    sample_gemm<3>(a, lds, U, WoT, U, WoT, D, D, PROJ, U, PART, ada);
    GB();
    p6_ln1(a, ada, RES, PART, U, gw, NGW, lane);
    GB();
    { pg8::Order S; S.init(MP, DFF, G, bx, 1, U, Wff1T, U, Wff1T);
      pg8::EpiBf16<1> E{PROJ, DFF, a.b_ff1};
      pg8::gemm_phase(lds, D, S, E); }
    sample_gemm<1>(a, lds, U, Wff1T, U, Wff1T, D, DFF, PROJ, PROJ, RES, ada);
    tr_tail(a, lds, TB_F2, TB_F2H - TB_F2, DFF / 128, wave, lane);
    GB();
    { pg8::Order S; S.init(MP, D, G, bx, 1, PROJ, Wff2T, PROJ, Wff2T);
      pg8::EpiRes E{RES, RES, ada, 5 * D, a.b_ff2};
      pg8::gemm_phase(lds, DFF, S, E); }
    sample_gemm<4>(a, lds, PROJ, Wff2T, PROJ, Wff2T, DFF, D, PROJ, U, PART, ada);
    GB();
    p9_ln2(a, ada, RES, PART, gw, NGW, lane);
}

extern "C" void kernel_launch(void* const* d_in, const int* in_sizes, int n_in, void* d_out, int out_size, void* d_ws, size_t ws_size, hipStream_t stream) {
    static int grid = 0;
    if (grid == 0) {
        if (n_in != 23 || ws_size < WS_END) { fprintf(stderr, "kernel_launch: expected 23 inputs and >= %zu bytes of workspace; got %d, %zu\n", (size_t)WS_END, n_in, ws_size); grid = -1; return; }
        int dev = 0, cus = 0, per_cu = 0;
        hipGetDevice(&dev);
        hipDeviceGetAttribute(&cus, hipDeviceAttributeMultiprocessorCount, dev);
        if (hipFuncSetAttribute((const void*)fwd_megakernel, hipFuncAttributeMaxDynamicSharedMemorySize, LDS_BYTES) != hipSuccess) { fprintf(stderr, "kernel_launch: hipFuncSetAttribute failed\n"); grid = -1; return; }
        if (hipOccupancyMaxActiveBlocksPerMultiprocessor(&per_cu, (const void*)fwd_megakernel, 512, LDS_BYTES) != hipSuccess || per_cu < 1) { fprintf(stderr, "kernel_launch: occupancy query says %d blocks per CU\n", per_cu); (void)hipGetLastError(); per_cu = 1; }
        grid = cus;
        fprintf(stderr, "kernel_launch: cus %d per_cu %d grid %d\n", cus, per_cu, grid);
    }
    if (grid < 0) return;
    if (hipMemsetAsync((char*)d_ws + WS_CTL, 0, 16384, stream) != hipSuccess) { fprintf(stderr, "kernel_launch: memset failed\n"); return; }
    Args a{};
    const float** ap = (const float**)&a;
    for (int i = 0; i < 23; ++i) ap[i] = (const float*)d_in[i];
    a.out = (float*)d_out; a.ws = (unsigned char*)d_ws;
    void* args[] = {&a};
    hipError_t e = hipLaunchCooperativeKernel((const void*)fwd_megakernel, dim3(grid), dim3(512), args, LDS_BYTES, stream);
    if (e != hipSuccess) fprintf(stderr, "kernel_launch: cooperative launch failed: %s (grid %d)\n", hipGetErrorString(e), grid);
}
```
